# Optimizing an MI355X kernel written in HIP

```python
import jax, jax.numpy as jnp
from jax import lax
import numpy as np

D_MODEL = 1024
BATCH = 8
SEQ = 2048
DEPTH = 2

CTX_LEN = 256
GRID_W = 64
NORM_EPS = 1e-6

N_HEADS = 8
N_KV_HEADS = 2
HEAD_DIM = 64
Q_GROUP = N_HEADS // N_KV_HEADS
Q_WIDTH = N_HEADS * HEAD_DIM
KV_WIDTH = N_KV_HEADS * HEAD_DIM
ROPE_THETA = 10000.0
AXIS_PAIRS = HEAD_DIM // 4
Q_BLOCK = 128

SC_WIDTH = 256
FOURIER_GROUPS = 4
FOURIER_WIDTH = 256
FOURIER_GROUP = FOURIER_WIDTH // FOURIER_GROUPS
POOL_WINDOWS = (2, 4, 8, 16)
POOL_WIDTH = 256
POOL_GROUP = POOL_WIDTH // len(POOL_WINDOWS)

N_BRANCHES = 4
D_FF = 2816

OFF_Q = 0
OFF_K = OFF_Q + Q_WIDTH
OFF_V = OFF_K + KV_WIDTH
OFF_SC = OFF_V + KV_WIDTH
OFF_F = OFF_SC + 3 * SC_WIDTH
OFF_P = OFF_F + FOURIER_WIDTH
OFF_G = OFF_P + POOL_WIDTH
IN_WIDTH = OFF_G + N_BRANCHES * D_MODEL

kernel_name = "hybrid_parallel_gated_diffusion_block"


def rmsnorm(x, g):
    xf = x.astype(jnp.float32)
    y = xf * lax.rsqrt(jnp.mean(xf * xf, axis=-1, keepdims=True) + NORM_EPS)
    return (y * g.astype(jnp.float32)).astype(x.dtype)


def adaln(cvec, w_mod, b_mod):
    m = jax.nn.silu(cvec) @ w_mod + b_mod
    return m.reshape(cvec.shape[0], 6, D_MODEL)


def modulate(h, shift, scale):
    return h * (1.0 + scale[:, None, :]) + shift[:, None, :]


def dwconv3(x, w):
    xp = jnp.pad(x, ((0, 0), (1, 1), (0, 0)))
    return xp[:, :-2] * w[0] + xp[:, 1:-1] * w[1] + xp[:, 2:] * w[2]


def axial_rope(n):
    rows = n // GRID_W
    row = jnp.repeat(jnp.arange(rows), GRID_W).astype(jnp.float32)
    col = jnp.tile(jnp.arange(GRID_W), rows).astype(jnp.float32)
    inv = ROPE_THETA ** (-jnp.arange(AXIS_PAIRS, dtype=jnp.float32) / AXIS_PAIRS)
    ang = jnp.stack([row[:, None] * inv, col[:, None] * inv], axis=1)
    ang = ang[None, :, None, :, None, :]
    return jnp.cos(ang), jnp.sin(ang)


def apply_rope(x, cos, sin):
    b, n, h, _ = x.shape
    xr = x.astype(jnp.float32).reshape(b, n, h, 2, 2, AXIS_PAIRS)
    rot = jnp.concatenate([-xr[..., 1:2, :], xr[..., 0:1, :]], axis=-2)
    return (xr * cos + rot * sin).reshape(b, n, h, HEAD_DIM).astype(x.dtype)


def kv_heads(z_kv, k_gain):
    b, n, _ = z_kv.shape
    k = rmsnorm(z_kv[..., :KV_WIDTH].reshape(b, n, N_KV_HEADS, HEAD_DIM), k_gain)
    v = z_kv[..., KV_WIDTH:].reshape(b, n, N_KV_HEADS, HEAD_DIM)
    return k, v


def attend_blocked(q, k, v):
    b, n, _, _ = q.shape
    nb = n // Q_BLOCK
    qb = q.reshape(b, nb, Q_BLOCK, N_KV_HEADS, Q_GROUP, HEAD_DIM).transpose(1, 0, 2, 3, 4, 5)
    scale = HEAD_DIM ** -0.5

    def one_block(qq):
        s = jnp.einsum("bqkgd,bskd->bkgqs", qq, k).astype(jnp.float32) * scale
        p = jax.nn.softmax(s, axis=-1).astype(v.dtype)
        return jnp.einsum("bkgqs,bskd->bqkgd", p, v)

    o = lax.map(one_block, qb)
    return o.transpose(1, 0, 2, 3, 4, 5).reshape(b, n, Q_WIDTH)


def pool_minus_identity(x):
    _, n, _ = x.shape
    xf = x.astype(jnp.float32)
    cs = jnp.pad(jnp.cumsum(xf, axis=1), ((0, 0), (1, 0), (0, 0)))
    t = jnp.arange(n)
    outs = []
    for gi, w in enumerate(POOL_WINDOWS):
        left, right = (w - 1) // 2, w // 2
        lo = jnp.maximum(t - left, 0)
        hi = jnp.minimum(t + right + 1, n)
        sl = slice(gi * POOL_GROUP, (gi + 1) * POOL_GROUP)
        csg = cs[..., sl]
        cnt = (hi - lo).astype(jnp.float32)[None, :, None]
        mean = (jnp.take(csg, hi, axis=1) - jnp.take(csg, lo, axis=1)) / cnt
        outs.append(mean - xf[..., sl])
    return jnp.concatenate(outs, axis=-1).astype(x.dtype)


def token_mixers(z, k, v, q_gain, conv_sc, pool_mat, pool_scale,
                 w_br_attn, w_br_sc, w_br_f, w_br_p, w_out, rope, ctx_kv):
    b, n, _ = z.shape
    q = rmsnorm(z[..., OFF_Q:OFF_K].reshape(b, n, N_HEADS, HEAD_DIM), q_gain)
    if rope is not None:
        cos, sin = rope
        q = apply_rope(q, cos, sin)
        k = apply_rope(k, cos, sin)
    if ctx_kv is not None:
        k = jnp.concatenate([k, ctx_kv[0]], axis=1)
        v = jnp.concatenate([v, ctx_kv[1]], axis=1)
    o_attn = attend_blocked(q, k, v) @ w_br_attn
    zs = z[..., OFF_SC:OFF_F]
    gb, gc, xs = zs[..., :SC_WIDTH], zs[..., SC_WIDTH:2 * SC_WIDTH], zs[..., 2 * SC_WIDTH:]
    o_sc = (gb * dwconv3(gc * xs, conv_sc)) @ w_br_sc
    xg = z[..., OFF_F:OFF_P].astype(jnp.float32).reshape(b, n, FOURIER_GROUPS, FOURIER_GROUP)
    xfour = jnp.fft.fft2(xg, axes=(1, 3), norm="ortho").real.astype(z.dtype).reshape(b, n, FOURIER_WIDTH)
    o_f = xfour @ w_br_f
    pooled = pool_minus_identity(z[..., OFF_P:OFF_G]).reshape(b, n, len(POOL_WINDOWS), POOL_GROUP)
    yp = jnp.einsum("bngc,gcd->bngd", pooled, pool_mat).reshape(b, n, POOL_WIDTH) * pool_scale
    o_p = yp @ w_br_p
    g = jax.nn.sigmoid(z[..., OFF_G:].reshape(b, n, N_BRANCHES, D_MODEL))
    y = g[:, :, 0] * o_attn + g[:, :, 1] * o_sc + g[:, :, 2] * o_f + g[:, :, 3] * o_p
    return y @ w_out


def conv_ffn(h, w_up, conv_w, w_down):
    u = dwconv3(h @ w_up, conv_w)
    a, bval = u[..., :D_FF], u[..., D_FF:]
    return (jax.nn.silu(a) * bval) @ w_down


def setup_inputs(seed: int = 0) -> dict:
    key = jax.random.key(seed)
    ks = jax.random.split(key, 24)
    f32 = jnp.float32

    def nrm(k, shape, scale):
        return jax.random.normal(k, shape, f32) * scale

    L, D = DEPTH, D_MODEL
    return {
        "x": nrm(ks[0], (BATCH, SEQ, D), 1.0),
        "c": nrm(ks[1], (BATCH, D), 1.0),
        "ctx": nrm(ks[2], (BATCH, CTX_LEN, D), 1.0),
        "c_ctx": nrm(ks[3], (D,), 1.0),
        "w_mod": nrm(ks[4], (L, D, 6 * D), 0.5 * D ** -0.5),
        "b_mod": nrm(ks[5], (L, 6 * D), 0.02),
        "norm1": 1.0 + nrm(ks[6], (L, D), 0.02),
        "norm2": 1.0 + nrm(ks[7], (L, D), 0.02),
        "w_in": nrm(ks[8], (L, D, IN_WIDTH), D ** -0.5),
        "conv_sc": nrm(ks[9], (L, 3, SC_WIDTH), 3 ** -0.5),
        "qk_gain": 1.0 + nrm(ks[10], (L, 2, HEAD_DIM), 0.02),
        "pool_mat": nrm(ks[11], (L, len(POOL_WINDOWS), POOL_GROUP, POOL_GROUP), POOL_GROUP ** -0.5),
        "pool_scale": 1.0 + nrm(ks[12], (L, POOL_WIDTH), 0.02),
        "w_br_attn": nrm(ks[13], (L, Q_WIDTH, D), Q_WIDTH ** -0.5),
        "w_br_sc": nrm(ks[14], (L, SC_WIDTH, D), SC_WIDTH ** -0.5),
        "w_br_f": nrm(ks[15], (L, FOURIER_WIDTH, D), FOURIER_WIDTH ** -0.5),
        "w_br_p": nrm(ks[16], (L, POOL_WIDTH, D), POOL_WIDTH ** -0.5),
        "w_out": nrm(ks[17], (L, D, D), D ** -0.5),
        "w_up": nrm(ks[18], (L, D, 2 * D_FF), D ** -0.5),
        "w_conv_ffn": nrm(ks[19], (L, 3, 2 * D_FF), 3 ** -0.5),
        "w_down": nrm(ks[20], (L, D_FF, D), D_FF ** -0.5),
        "final_norm": 1.0 + nrm(ks[21], (D,), 0.02),
    }


def reference(x, c, ctx, c_ctx, w_mod, b_mod, norm1, norm2, w_in, conv_sc, qk_gain, pool_mat,
              pool_scale, w_br_attn, w_br_sc, w_br_f, w_br_p, w_out, w_up, w_conv_ffn, w_down, final_norm):
    rope = axial_rope(x.shape[1])
    lat, cx = x, ctx
    for l in range(DEPTH):
        m_lat = adaln(c, w_mod[l], b_mod[l])
        m_ctx = adaln(c_ctx[None], w_mod[l], b_mod[l])
        q_gain, k_gain = qk_gain[l, 0], qk_gain[l, 1]
        mixer_params = (q_gain, conv_sc[l], pool_mat[l], pool_scale[l],
                        w_br_attn[l], w_br_sc[l], w_br_f[l], w_br_p[l], w_out[l])
        last = l == DEPTH - 1

        hc = modulate(rmsnorm(cx, norm1[l]), m_ctx[:, 0], m_ctx[:, 1])
        if last:
            kc, vc = kv_heads(hc @ w_in[l][:, OFF_K:OFF_SC], k_gain)
        else:
            zc = hc @ w_in[l]
            kc, vc = kv_heads(zc[..., OFF_K:OFF_SC], k_gain)

        hl = modulate(rmsnorm(lat, norm1[l]), m_lat[:, 0], m_lat[:, 1])
        zl = hl @ w_in[l]
        kl, vl = kv_heads(zl[..., OFF_K:OFF_SC], k_gain)
        lat = lat + m_lat[:, 2][:, None, :] * token_mixers(zl, kl, vl, *mixer_params, rope, (kc, vc))
        hf = modulate(rmsnorm(lat, norm2[l]), m_lat[:, 3], m_lat[:, 4])
        lat = lat + m_lat[:, 5][:, None, :] * conv_ffn(hf, w_up[l], w_conv_ffn[l], w_down[l])

        if not last:
            cx = cx + m_ctx[:, 2][:, None, :] * token_mixers(zc, kc, vc, *mixer_params, None, None)
            hfc = modulate(rmsnorm(cx, norm2[l]), m_ctx[:, 3], m_ctx[:, 4])
            cx = cx + m_ctx[:, 5][:, None, :] * conv_ffn(hfc, w_up[l], w_conv_ffn[l], w_down[l])
    return rmsnorm(lat, final_norm)
```

```cpp
#include <hip/hip_runtime.h>
#include <hip/hip_cooperative_groups.h>
#include <cstdio>
#include <cstdint>
namespace cg = cooperative_groups;

#define LAS __attribute__((address_space(3)))
#define DI __device__ __forceinline__
typedef unsigned short bf16_t;
typedef short bf16x8 __attribute__((ext_vector_type(8)));
typedef short s16x4 __attribute__((ext_vector_type(4)));
typedef float f32x4 __attribute__((ext_vector_type(4)));
typedef float f32x2_t __attribute__((ext_vector_type(2)));
typedef float f32x16 __attribute__((ext_vector_type(16)));
typedef unsigned u32x4 __attribute__((ext_vector_type(4)));
typedef unsigned u32x2 __attribute__((ext_vector_type(2)));
typedef __bf16 bf16x2_t __attribute__((ext_vector_type(2)));

constexpr int D = 1024, SEQ = 2048, NB = 8, CTXL = 256;
constexpr int ML = NB * SEQ;
constexpr int MC = NB * CTXL;
constexpr int MT = ML + MC;
constexpr int INW = 6144, DFF = 2816, UPW = 5632;
constexpr int NZ = 6400;
constexpr int SKV = SEQ + CTXL;
constexpr float EPS = 1e-6f;

constexpr size_t MiB = 1u << 20;
constexpr size_t WS_MODS = 64 * 1024;
constexpr size_t MODS_BYTES = 2 * 9 * 6144 * 4;
constexpr size_t WS_ROPE = 1 * MiB;
constexpr size_t WS_CX = 2 * MiB;
constexpr size_t WS_FML = 10 * MiB;
constexpr size_t WS_FMC = 26 * MiB;
constexpr size_t WS_WIN = 27 * MiB;
constexpr size_t WS_WBR = WS_WIN + (size_t)NZ * 1024 * 2;
constexpr size_t WS_WOUT = 42 * MiB;
constexpr size_t WS_H = 44 * MiB;
constexpr size_t WS_ACT4 = 44 * MiB;
constexpr size_t WS_ZQ = 89 * MiB;
constexpr size_t WS_ZS = 107 * MiB;
constexpr size_t WS_ZP = 134 * MiB;
constexpr size_t WS_KB = 143 * MiB;
constexpr size_t WS_VT = WS_KB + (size_t)NB * 2 * SKV * 64 * 2;
constexpr size_t WS_YTL = 152 * MiB;
constexpr size_t WS_YTC = 168 * MiB;
constexpr size_t WS_G8 = 170 * MiB;
constexpr size_t WS_PY = 134 * MiB;
constexpr size_t WS_Y = 89 * MiB;
constexpr size_t WS_ACT = 89 * MiB;
constexpr size_t WS_WUP = 226 * MiB;
constexpr size_t WS_WDN = 237 * MiB;
constexpr size_t WS_RAW = 243 * MiB;
constexpr size_t WS_END = 256 * MiB;
static_assert(WS_WBR + 1024 * 1280 * 2 <= WS_WOUT && WS_VT + (size_t)NB * 2 * SKV * 64 * 2 <= WS_YTL, "ws map");
static_assert(WS_G8 + (size_t)MT * 4096 <= WS_WDN + 6 * MiB && WS_RAW + 288ull * 4 * UPW * 2 <= WS_END, "ws map");
static_assert(WS_ACT + (size_t)MT * DFF * 2 <= WS_WUP, "ws map");

constexpr int LDS_BYTES = 131072 + 4096;

DI unsigned cvtpk(float lo, float hi) { f32x2_t v = {lo, hi}; bf16x2_t b = __builtin_convertvector(v, bf16x2_t); return __builtin_bit_cast(unsigned, b); }
DI float bflo(unsigned u) { return __uint_as_float(u << 16); }
DI float bfhi(unsigned u) { return __uint_as_float(u & 0xffff0000u); }
DI float wave_sum(float v) {
#pragma unroll
    for (int o = 1; o < 64; o <<= 1) v += __shfl_xor(v, o);
    return v;
}
DI int tid_() { int t; asm volatile("v_mov_b32 %0, %1" : "=v"(t) : "v"((int)threadIdx.x)); return t; }
DI float sigmoidf_(float v) { return 1.0f / (1.0f + __expf(-v)); }

struct Params { const float* in[22]; float* out; unsigned char* ws; };
typedef const __attribute__((address_space(4))) Params* KP;
DI KP getp() { KP q = (KP)__builtin_amdgcn_kernarg_segment_ptr(); asm volatile("" : "+s"(q)); return q; }

namespace pg8 {
constexpr int BM = 256, BK = 64, HALF = 128, HTB = HALF * BK * 2, STAGE_BYTES = 8 * HTB, NXCD = 8, WGM = 8;
DI int lds_byte(int r, int c) { const int st = (r >> 4) * 2 + (c >> 5), rr = r & 15, cc = c & 31, ob = rr * 64 + cc * 2; return st * 1024 + (ob ^ (((ob >> 9) & 1) << 5)); }
DI void stage_rc(int b, int& R, int& C) { const int st = b / 1024, sb = b % 1024, swz = sb ^ (((sb >> 9) & 1) << 5); R = (st >> 1) * 16 + swz / 64; C = (st & 1) * 32 + (swz % 64) / 2; }
DI int perm32(int rho) { const int n = rho >> 4, i = rho & 15; return 8 * (i >> 2) + 4 * n + (i & 3); }

struct Unit { int pm, pn, koff, nt, tag; };
struct Gemm { const bf16_t* A; const bf16_t* Bt; int lda, ldb; };

struct Sched {
    int nM, nN, nwg, G, c, nx, xpm0, xpn, sub, nt;
    DI void init(int nM_, int nN_, int G_, int c_, int nt_) { nM = nM_; nN = nN_; nwg = nM * nN; G = G_; c = c_; nx = 0; xpm0 = 0; xpn = 0; sub = 1; nt = nt_; }
    DI bool next(int i, Unit& u) const {
        int ti = i, s = 0;
        if (sub == 4) { ti = i >> 2; s = i & 3; }
        const long L = (long)ti * G + c;
        if (L < nwg) {
            int wgid = (int)L; { const int q = nwg / NXCD, r = nwg % NXCD, xcd = wgid % NXCD, off = wgid / NXCD; wgid = (xcd < r ? xcd * (q + 1) : r * (q + 1) + (xcd - r) * q) + off; }
            const int nig = WGM * nN, gid = wgid / nig, fm = gid * WGM, gsz = (nM - fm) < WGM ? (nM - fm) : WGM;
            u.pm = fm + ((wgid % nig) % gsz); u.pn = (wgid % nig) / gsz;
        } else if (L - nwg < nx) { u.pm = xpm0 + (int)(L - nwg); u.pn = xpn; }
        else return false;
        if (sub == 4) { u.tag = s; u.koff = (s == 0) ? 0 : 256 + 256 * s; u.nt = (s == 0) ? 8 : 4; }
        else { u.tag = 0; u.koff = 0; u.nt = nt; }
        return true;
    }
};

typedef f32x4 Acc[2][2][4][2];
DI void zero_acc(Acc& acc) {
#pragma unroll
    for (int a = 0; a < 2; ++a)
#pragma unroll
        for (int b = 0; b < 2; ++b)
#pragma unroll
            for (int m = 0; m < 4; ++m)
#pragma unroll
                for (int n = 0; n < 2; ++n) acc[a][b][m][n] = (f32x4){0.f, 0.f, 0.f, 0.f};
}

template <class Epi, bool ALIGN_EPI>
DI void gemm_phase(LAS unsigned char* lds, const Gemm g, const Sched& S, const Epi& E) {
    int tid; asm volatile("v_mov_b32 %0, %1" : "=v"(tid) : "v"((int)threadIdx.x));
    const int wid = __builtin_amdgcn_readfirstlane(tid >> 6), lane = tid & 63, wr = wid >> 2, wc = wid & 3, fr = lane & 15, fq = lane >> 4;
    unsigned voffA[2], voffB[2];
#pragma unroll
    for (int i = 0; i < 2; ++i) { int R, C; stage_rc(tid * 16 + i * 8192, R, C); const int Rb = Epi::PERM ? ((R & ~31) + perm32(R & 31)) : R;
        voffA[i] = (unsigned)(R * g.lda + C) * 2u; voffB[i] = (unsigned)(Rb * g.ldb + C) * 2u; }
    const size_t kstep = (size_t)(BK * 2);
    const size_t hstepA = (size_t)HALF * g.lda * 2, hstepB = (size_t)HALF * g.ldb * 2;
    const size_t tstepA = 2 * hstepA, tstepB = 2 * hstepB;
    const unsigned ldsw = (unsigned)wid * 1024u;
    const int aoff = lds_byte(wr * 64 + fr, fq * 8), boff = lds_byte(wc * 32 + fr, fq * 8);
#define PG8_SA(b, h) (((b) * 2 + (h)) * HTB)
#define PG8_SB(b, h) ((4 + (b) * 2 + (h)) * HTB)
#define PG8_STAGE(bufoff, gbase, voff) do { _Pragma("unroll") for (int _i = 0; _i < 2; ++_i) \
        __builtin_amdgcn_global_load_lds((const unsigned*)((const char*)(gbase) + (voff)[_i]), (LAS unsigned*)(lds + (bufoff) + ldsw + _i * 8192), 16, 0, 0); } while (0)
#define PG8_LDA(dst, b, h) do { _Pragma("unroll") for (int m = 0; m < 4; ++m) _Pragma("unroll") for (int k = 0; k < 2; ++k) dst[m][k] = *(const LAS bf16x8*)(lds + PG8_SA(b, h) + aoff + m * 2048 + k * 1024); } while (0)
#define PG8_LDB(dst, b, h) do { _Pragma("unroll") for (int n = 0; n < 2; ++n) _Pragma("unroll") for (int k = 0; k < 2; ++k) dst[n][k] = *(const LAS bf16x8*)(lds + PG8_SB(b, h) + boff + n * 2048 + k * 1024); } while (0)
#define PG8_MMA(ai, bj, At, Bt) do { __builtin_amdgcn_s_setprio(1); _Pragma("unroll") for (int m = 0; m < 4; ++m) _Pragma("unroll") for (int n = 0; n < 2; ++n) _Pragma("unroll") for (int k = 0; k < 2; ++k) \
        acc[ai][bj][m][n] = __builtin_amdgcn_mfma_f32_16x16x32_bf16(Bt[n][k], At[m][k], acc[ai][bj][m][n], 0, 0, 0); __builtin_amdgcn_s_setprio(0); } while (0)
#define PG8_WAIT_V(n) asm volatile("s_waitcnt vmcnt(" #n ")" ::: "memory")
#define PG8_WAIT_L(n) asm volatile("s_waitcnt lgkmcnt(" #n ")" ::: "memory")
#define PG8_BAR __builtin_amdgcn_s_barrier()
#define PG8_SCHED __builtin_amdgcn_sched_barrier(0)
    Unit cur, nxt; int ui = 0;
    if (!S.next(0, cur)) return;
    Acc acc;
    { int l2; asm volatile("v_mov_b32 %0, %1" : "=v"(l2) : "v"(lane)); E.init(acc, cur, wr, wc, l2 & 15, l2 >> 4); }
    PG8_WAIT_V(0);
    bf16x8 At[4][2], B0[2][2], B1[2][2];
    const char* cA = (const char*)g.A + (size_t)cur.pm * tstepA + (size_t)cur.koff * 2; const char* cB = (const char*)g.Bt + (size_t)cur.pn * tstepB + (size_t)cur.koff * 2;
    PG8_STAGE(PG8_SB(0, 0), cB, voffB); PG8_STAGE(PG8_SB(0, 1), cB + hstepB, voffB); PG8_STAGE(PG8_SA(0, 0), cA, voffA); PG8_STAGE(PG8_SA(0, 1), cA + hstepA, voffA);
    if (wr == 1) PG8_BAR;
    PG8_WAIT_V(2); PG8_BAR;
    PG8_STAGE(PG8_SB(1, 0), cB + kstep, voffB); PG8_STAGE(PG8_SA(1, 0), cA + kstep, voffA); PG8_STAGE(PG8_SB(1, 1), cB + hstepB + kstep, voffB);
    PG8_WAIT_V(6); PG8_BAR;
    for (;;) {
        const bool has_next = S.next(ui + 1, nxt);
        const char* nA = has_next ? (const char*)g.A + (size_t)nxt.pm * tstepA + (size_t)nxt.koff * 2 : cA;
        const char* nB = has_next ? (const char*)g.Bt + (size_t)nxt.pn * tstepB + (size_t)nxt.koff * 2 : cB;
        const int nt = cur.nt;
        for (int t = 0; t < nt; t += 2) {
            const bool last = (t == nt - 2);
            const char* a1 = cA + (size_t)(t + 1) * kstep;
            const char* a2 = last ? nA : cA + (size_t)(t + 2) * kstep; const char* b2 = last ? nB : cB + (size_t)(t + 2) * kstep;
            const char* a3 = a2 + kstep; const char* b3 = b2 + kstep;
            PG8_LDB(B0, 0, 0); PG8_LDB(B1, 0, 1); PG8_SCHED; PG8_LDA(At, 0, 0); PG8_STAGE(PG8_SA(1, 1), a1 + hstepA, voffA);
            PG8_WAIT_V(8); PG8_WAIT_L(0); PG8_BAR; PG8_MMA(0, 0, At, B0); PG8_MMA(0, 1, At, B1); PG8_BAR; PG8_SCHED;
            PG8_LDA(At, 0, 1); PG8_STAGE(PG8_SB(0, 0), b2, voffB); PG8_STAGE(PG8_SB(0, 1), b2 + hstepB, voffB); PG8_STAGE(PG8_SA(0, 0), a2, voffA);
            PG8_WAIT_V(8); PG8_WAIT_L(0); PG8_BAR; PG8_MMA(1, 0, At, B0); PG8_MMA(1, 1, At, B1); PG8_BAR; PG8_SCHED;
            PG8_LDB(B0, 1, 0); PG8_LDB(B1, 1, 1); PG8_SCHED; PG8_LDA(At, 1, 0); PG8_STAGE(PG8_SA(0, 1), a2 + hstepA, voffA);
            PG8_WAIT_V(8); PG8_WAIT_L(0); PG8_BAR; PG8_MMA(0, 0, At, B0); PG8_MMA(0, 1, At, B1); PG8_BAR; PG8_SCHED;
            PG8_LDA(At, 1, 1); PG8_STAGE(PG8_SB(1, 0), b3, voffB); PG8_STAGE(PG8_SB(1, 1), b3 + hstepB, voffB); PG8_STAGE(PG8_SA(1, 0), a3, voffA);
            PG8_WAIT_V(8); PG8_WAIT_L(0); PG8_BAR; PG8_MMA(1, 0, At, B0); PG8_MMA(1, 1, At, B1); PG8_BAR; PG8_SCHED;
        }
        if constexpr (ALIGN_EPI) { if (wr == 0) PG8_BAR; }
        int l2; asm volatile("v_mov_b32 %0, %1" : "=v"(l2) : "v"(lane));
        E(acc, cur, wr, wc, l2 & 15, l2 >> 4);
        if (!has_next) break;
        E.init(acc, nxt, wr, wc, l2 & 15, l2 >> 4);
        PG8_WAIT_V(0);
        cur = nxt; cA = nA; cB = nB; ++ui;
        if constexpr (ALIGN_EPI) { if (wr == 1) PG8_BAR; }
    }
    PG8_WAIT_V(0);
    if constexpr (!ALIGN_EPI) { if (wr == 0) PG8_BAR; }
    PG8_BAR;
#undef PG8_SA
#undef PG8_SB
#undef PG8_STAGE
#undef PG8_LDA
#undef PG8_LDB
#undef PG8_MMA
#undef PG8_WAIT_V
#undef PG8_WAIT_L
#undef PG8_BAR
#undef PG8_SCHED
}
}
using pg8::Acc; using pg8::Unit;

struct EpiZ {
    static constexpr bool PERM = false;
    bf16_t *ZQ, *ZS, *ZP, *KB, *VT, *YTL, *YTC; unsigned char* G8;
    const float *ropec, *ropes, *qg, *kg;
    DI void init(Acc& acc, const Unit&, int, int, int, int) const { pg8::zero_acc(acc); }
    DI void operator()(Acc& acc, const Unit& u, int wr, int wc, int fr, int fq) const {
        const bool isctx = u.pm >= 64;
        const int pn = u.pn;
        if (pn <= 2) {
            if (pn == 2 && wc >= 2) {
                const int g = wc - 2;
#pragma unroll
                for (int ai = 0; ai < 2; ++ai)
#pragma unroll
                    for (int m = 0; m < 4; ++m) {
                        const int r = u.pm * 256 + ai * 128 + wr * 64 + m * 16 + fr;
                        int b, pos; if (!isctx) { b = r >> 11; pos = r & 2047; } else { const int rc = r - ML; b = rc >> 8; pos = SEQ + (rc & 255); }
                        bf16_t* vb = VT + ((size_t)(b * 2 + g) * 64) * SKV + pos;
#pragma unroll
                        for (int bj = 0; bj < 2; ++bj)
#pragma unroll
                            for (int n = 0; n < 2; ++n) {
                                const f32x4 v = acc[ai][bj][m][n];
                                const unsigned p0 = cvtpk(v[0], v[1]), p1 = cvtpk(v[2], v[3]);
                                const int e = 32 * bj + 16 * n + 4 * fq;
                                vb[(size_t)(e + 0) * SKV] = (bf16_t)(p0 & 0xffff); vb[(size_t)(e + 1) * SKV] = (bf16_t)(p0 >> 16);
                                vb[(size_t)(e + 2) * SKV] = (bf16_t)(p1 & 0xffff); vb[(size_t)(e + 3) * SKV] = (bf16_t)(p1 >> 16);
                            }
                    }
                return;
            }
            const bool isq = pn < 2;
            const float* gain = isq ? qg : kg;
            const float osc = isq ? (0.125f * 1.4426950408889634f) : 1.0f;
#pragma unroll
            for (int ai = 0; ai < 2; ++ai)
#pragma unroll
                for (int m = 0; m < 4; ++m) {
                    const int r = u.pm * 256 + ai * 128 + wr * 64 + m * 16 + fr;
                    float ss = 0.f;
#pragma unroll
                    for (int bj = 0; bj < 2; ++bj)
#pragma unroll
                        for (int n = 0; n < 2; ++n) { const f32x4 v = acc[ai][bj][m][n]; ss += (v[0] * v[0] + v[1] * v[1]) + (v[2] * v[2] + v[3] * v[3]); }
                    ss += __shfl_xor(ss, 16); ss += __shfl_xor(ss, 32);
                    const float rinv = rsqrtf(ss * (1.0f / 64.0f) + EPS) * osc;
                    int b, pos, t = 0; if (!isctx) { b = r >> 11; pos = r & 2047; t = pos; } else { const int rc = r - ML; b = rc >> 8; pos = SEQ + (rc & 255); }
                    bf16_t* dst;
                    if (isq) dst = ZQ + (size_t)r * 512 + (pn * 4 + wc) * 64;
                    else dst = KB + ((size_t)(b * 2 + wc) * SKV + pos) * 64;
#pragma unroll
                    for (int bj = 0; bj < 2; ++bj) {
                        const f32x4 g0 = *(const f32x4*)(gain + 32 * bj + 4 * fq), g1 = *(const f32x4*)(gain + 32 * bj + 16 + 4 * fq);
                        f32x4 x0 = acc[ai][bj][m][0] * rinv * g0, x1 = acc[ai][bj][m][1] * rinv * g1;
                        if (!isctx) {
                            const f32x4 cs = *(const f32x4*)(ropec + (t * 2 + bj) * 16 + 4 * fq), sn = *(const f32x4*)(ropes + (t * 2 + bj) * 16 + 4 * fq);
                            const f32x4 o0 = x0 * cs - x1 * sn, o1 = x1 * cs + x0 * sn; x0 = o0; x1 = o1;
                        }
                        u32x2 w0, w1; w0.x = cvtpk(x0[0], x0[1]); w0.y = cvtpk(x0[2], x0[3]); w1.x = cvtpk(x1[0], x1[1]); w1.y = cvtpk(x1[2], x1[3]);
                        *(u32x2*)(dst + 32 * bj + 4 * fq) = w0; *(u32x2*)(dst + 32 * bj + 16 + 4 * fq) = w1;
                    }
                }
            return;
        }
#pragma unroll
        for (int ai = 0; ai < 2; ++ai)
#pragma unroll
            for (int m = 0; m < 4; ++m) {
                const int r = u.pm * 256 + ai * 128 + wr * 64 + m * 16 + fr;
                int b, t; if (!isctx) { b = r >> 11; t = r & 2047; } else { const int rc = r - ML; b = rc >> 8; t = rc & 255; }
#pragma unroll
                for (int bj = 0; bj < 2; ++bj)
#pragma unroll
                    for (int n = 0; n < 2; ++n) {
                        const f32x4 v = acc[ai][bj][m][n];
                        const int c = 128 * bj + 32 * wc + 16 * n + 4 * fq;
                        if (pn >= 9) {
                            unsigned w = 0;
#pragma unroll
                            for (int x = 0; x < 4; ++x) { const float s = sigmoidf_(v[x]); int q = (int)(s * 256.0f); q = q > 255 ? 255 : (q < 0 ? 0 : q); w |= (unsigned)q << (8 * x); }
                            *(unsigned*)(G8 + (size_t)r * 4096 + (pn - 9) * 256 + c) = w;
                        } else if (pn <= 5) {
                            u32x2 w; w.x = cvtpk(v[0], v[1]); w.y = cvtpk(v[2], v[3]);
                            *(u32x2*)(ZS + (size_t)r * 768 + (pn - 3) * 256 + c) = w;
                        } else if (pn == 8) {
                            u32x2 w; w.x = cvtpk(v[0], v[1]); w.y = cvtpk(v[2], v[3]);
                            *(u32x2*)(ZP + (size_t)r * 256 + c) = w;
                        } else {
                            const int cs = pn - 6;
                            const unsigned p0 = cvtpk(v[0], v[1]), p1 = cvtpk(v[2], v[3]);
                            bf16_t* y; size_t st;
                            if (!isctx) { y = YTL + ((size_t)(b * 256 + c) * 4096) + cs * 2048 + t; st = 4096; }
                            else { y = YTC + ((size_t)(b * 256 + c) * 512) + cs * 256 + t; st = 512; }
                            y[0] = (bf16_t)(p0 & 0xffff); y[st] = (bf16_t)(p0 >> 16); y[2 * st] = (bf16_t)(p1 & 0xffff); y[3 * st] = (bf16_t)(p1 >> 16);
                        }
                    }
            }
    }
};

struct EpiDft {
    static constexpr bool PERM = true;
    bf16_t* ACT4; int rowbase, nrows;
    DI void init(Acc& acc, const Unit&, int, int, int, int) const { pg8::zero_acc(acc); }
    DI void operator()(Acc& acc, const Unit& u, int wr, int wc, int fr, int fq) const {
#pragma unroll
        for (int ai = 0; ai < 2; ++ai)
#pragma unroll
            for (int m = 0; m < 4; ++m) {
                const int r = rowbase + u.pn * nrows + u.pm * 256 + ai * 128 + wr * 64 + m * 16 + fr;
#pragma unroll
                for (int bj = 0; bj < 2; ++bj) {
                    const f32x4 v0 = acc[ai][bj][m][0], v1 = acc[ai][bj][m][1];
                    u32x4 w; w.x = cvtpk(v0[0], v0[1]); w.y = cvtpk(v0[2], v0[3]); w.z = cvtpk(v1[0], v1[1]); w.w = cvtpk(v1[2], v1[3]);
                    *(u32x4*)(ACT4 + (size_t)r * 1280 + 768 + 128 * bj + 32 * wc + 8 * fq) = w;
                }
            }
    }
};

struct EpiBr {
    static constexpr bool PERM = true;
    const unsigned char* G8; bf16_t* Y; unsigned char* PY;
    DI void init(Acc& acc, const Unit&, int, int, int, int) const { pg8::zero_acc(acc); }
    DI void operator()(Acc& acc, const Unit& u, int wr, int wc, int fr, int fq) const {
        const unsigned char* ub = G8 + ((size_t)u.pm * 256 + wr * 64) * 4096 + u.tag * 1024 + u.pn * 256 + 32 * wc;
        const unsigned lo = (unsigned)(fr * 4096 + 8 * fq);
        unsigned char* pyb = PY + (size_t)((wr * 4 + wc) * 64 + fr + 16 * fq) * 16;
        bf16_t* yb = Y + ((size_t)u.pm * 256 + wr * 64) * 1024 + u.pn * 256 + 32 * wc;
        const unsigned yo = (unsigned)(fr * 1024 + 8 * fq);
#pragma unroll
        for (int ai = 0; ai < 2; ++ai) {
            u32x2 gw[4][2];
#pragma unroll
            for (int m = 0; m < 4; ++m)
#pragma unroll
                for (int bj = 0; bj < 2; ++bj) gw[m][bj] = *(const u32x2*)(ub + ((ai * 128 + m * 16) * 4096 + bj * 128) + lo);
#pragma unroll
            for (int m = 0; m < 4; ++m)
#pragma unroll
                for (int bj = 0; bj < 2; ++bj) {
                    f32x4 v[2];
#pragma unroll
                    for (int n = 0; n < 2; ++n) { const unsigned w = n ? gw[m][bj].y : gw[m][bj].x;
#pragma unroll
                        for (int x = 0; x < 4; ++x) { const float gq = ((float)((w >> (8 * x)) & 255u) + 0.5f) * (1.0f / 256.0f); v[n][x] = acc[ai][bj][m][n][x] * gq; } }
                    unsigned char* pp = pyb + (size_t)(((ai * 4 + m) * 2 + bj) * 512) * 16;
                    if (u.tag != 0) {
                        const u32x4 pv = *(const u32x4*)pp;
                        v[0][0] += bflo(pv.x); v[0][1] += bfhi(pv.x); v[0][2] += bflo(pv.y); v[0][3] += bfhi(pv.y);
                        v[1][0] += bflo(pv.z); v[1][1] += bfhi(pv.z); v[1][2] += bflo(pv.w); v[1][3] += bfhi(pv.w);
                    }
                    u32x4 w; w.x = cvtpk(v[0][0], v[0][1]); w.y = cvtpk(v[0][2], v[0][3]); w.z = cvtpk(v[1][0], v[1][1]); w.w = cvtpk(v[1][2], v[1][3]);
                    if (u.tag != 3) *(u32x4*)pp = w;
                    else *(u32x4*)(yb + ((ai * 128 + m * 16) * 1024 + bj * 128) + yo) = w;
                }
        }
    }
};

struct EpiRes {
    static constexpr bool PERM = false;
    const float* srcL; float* dstL; const float* srcC; float* dstC; const float* gates;
    DI void init(Acc& acc, const Unit&, int, int, int, int) const { pg8::zero_acc(acc); }
    DI void operator()(Acc& acc, const Unit& u, int wr, int wc, int fr, int fq) const {
        const bool isctx = u.pm >= 64;
        const size_t rb = isctx ? ((size_t)(u.pm - 64) * 256 + wr * 64) : ((size_t)u.pm * 256 + wr * 64);
        const float* sb = (isctx ? srcC : srcL) + rb * D + u.pn * 256 + 32 * wc;
        float* db = (isctx ? dstC : dstL) + rb * D + u.pn * 256 + 32 * wc;
        const float* gb = gates + (size_t)(isctx ? 8 : (u.pm >> 3)) * 6144 + u.pn * 256 + 32 * wc;
        const unsigned lo = (unsigned)(fr * D + 4 * fq), go = (unsigned)(4 * fq);
#pragma unroll
        for (int ai = 0; ai < 2; ++ai)
#pragma unroll
            for (int m = 0; m < 4; ++m) {
#pragma unroll
                for (int bj = 0; bj < 2; ++bj)
#pragma unroll
                    for (int n = 0; n < 2; ++n) {
                        const int co = (ai * 128 + m * 16) * D + bj * 128 + n * 16;
                        const f32x4 s = *(const f32x4*)(sb + co + lo), gg = *(const f32x4*)(gb + (bj * 128 + n * 16) + go);
                        *(f32x4*)(db + co + lo) = s + gg * acc[ai][bj][m][n];
                    }
                if (m == 3) asm volatile("" ::: "memory");
            }
    }
};

struct EpiUp {
    static constexpr bool PERM = true;
    bf16_t* ACT; bf16_t* RAW; const float* wconv;
    DI void init(Acc& acc, const Unit&, int, int, int, int) const { pg8::zero_acc(acc); }
    DI void operator()(Acc& acc, const Unit& u, int wr, int wc, int fr, int fq) const {
        const int lane = fr + 16 * fq;
        const int srcR = (lane & 48) | ((fr + 15) & 15), srcLn = (lane & 48) | ((fr + 1) & 15);
        const int jl = 32 * wc + 8 * fq;
        const int ja = u.pn * 128 + jl;
        bf16_t* ab = ACT + ((size_t)u.pm * 256 + wr * 64) * DFF + u.pn * 128 + 32 * wc;
        const unsigned alo = (unsigned)(fr * DFF + 8 * fq);
#pragma unroll
        for (int ai = 0; ai < 2; ++ai) {
            const int rbase = u.pm * 256 + ai * 128 + wr * 64;
#pragma unroll
            for (int m = 0; m < 4; m += 3) {
                const bool dump = (m == 0) ? (fr < 2) : (fr >= 14);
                if (dump) {
                    const int slot = (m == 0) ? (2 + fr) : (fr - 14);
                    bf16_t* rw = RAW + ((size_t)(rbase >> 6) * 4 + slot) * UPW;
#pragma unroll
                    for (int bj = 0; bj < 2; ++bj) {
                        const f32x4 v0 = acc[ai][bj][m][0], v1 = acc[ai][bj][m][1];
                        u32x4 w; w.x = cvtpk(v0[0], v0[1]); w.y = cvtpk(v0[2], v0[3]); w.z = cvtpk(v1[0], v1[1]); w.w = cvtpk(v1[2], v1[3]);
                        *(u32x4*)(rw + bj * DFF + ja) = w;
                    }
                }
            }
#pragma unroll
            for (int n = 0; n < 2; ++n) {
#pragma unroll
                for (int xp = 0; xp < 2; ++xp) {
                    float act[4][2];
#pragma unroll
                    for (int xx = 0; xx < 2; ++xx) {
                        const int x = 2 * xp + xx;
                        float ca[4], cb[4];
#pragma unroll
                        for (int bj = 0; bj < 2; ++bj) {
                            const float* wp = wconv + bj * DFF + ja + 4 * n + x;
                            const float w0 = wp[0], w1 = wp[UPW], w2 = wp[2 * UPW];
                            float R[4], L[4];
#pragma unroll
                            for (int m = 0; m < 4; ++m) { const float v = acc[ai][bj][m][n][x]; R[m] = __shfl(v, srcR); L[m] = __shfl(v, srcLn); }
#pragma unroll
                            for (int m = 0; m < 4; ++m) {
                                const float up = (fr > 0) ? R[m] : (m > 0 ? R[m > 0 ? m - 1 : 0] : 0.f);
                                const float dn = (fr < 15) ? L[m] : (m < 3 ? L[m < 3 ? m + 1 : 3] : 0.f);
                                const float cv = w0 * up + w1 * acc[ai][bj][m][n][x] + w2 * dn;
                                if (bj == 0) ca[m] = cv; else cb[m] = cv;
                            }
                        }
#pragma unroll
                        for (int m = 0; m < 4; ++m) act[m][xx] = ca[m] * sigmoidf_(ca[m]) * cb[m];
                    }
#pragma unroll
                    for (int m = 0; m < 4; ++m) {
                        const bool skip = (m == 0 && fr == 0) || (m == 3 && fr == 15);
                        if (!skip) *(unsigned*)(ab + ((ai * 128 + m * 16) * DFF + 4 * n + 2 * xp) + alo) = cvtpk(act[m][0], act[m][1]);
                    }
                    asm volatile("" ::: "memory");
                }
            }
        }
    }
};

DI void transpose_item(const float* W, int ldn, int k0, int n0, bf16_t* WT, int drow0, int ldd, int koff, LAS float* scr, int lane) {
#pragma unroll 8
    for (int i = 0; i < 32; ++i) { const int kk = 2 * i + (lane >> 5); scr[kk * 33 + (lane & 31)] = W[(size_t)(k0 + kk) * ldn + n0 + (lane & 31)]; }
    asm volatile("s_waitcnt lgkmcnt(0)" ::: "memory");
    const int c = lane & 7;
#pragma unroll
    for (int j = 0; j < 4; ++j) { const int n = (lane >> 3) + 8 * j; const LAS float* s = scr + (8 * c) * 33 + n;
        u32x4 o; o.x = cvtpk(s[0 * 33], s[1 * 33]); o.y = cvtpk(s[2 * 33], s[3 * 33]); o.z = cvtpk(s[4 * 33], s[5 * 33]); o.w = cvtpk(s[6 * 33], s[7 * 33]);
        *(u32x4*)(WT + (size_t)(drow0 + n) * ldd + koff + k0 + 8 * c) = o; }
    asm volatile("s_waitcnt lgkmcnt(0)" ::: "memory");
}
DI int win_dest(int n0) {
    if (n0 < 768) { const int tile = n0 >> 8, within = n0 & 255, hd = within >> 6, e = within & 63; return tile * 256 + 128 * (e >> 5) + 32 * hd + (e & 31); }
    if (n0 < 1536) return n0;
    if (n0 < 1792) return -1;
    return n0 + 256;
}
DI int wup_dest(int n0) { if (n0 < DFF) return 256 * (n0 >> 7) + (n0 & 127); const int j = n0 - DFF; return 256 * (j >> 7) + 128 + (j & 127); }

DI void conv_mixer(int l, LAS unsigned char* lds, int G) {
    KP q = getp(); unsigned char* ws = q->ws;
    const int tid = tid_(), lane = tid & 63, wave = tid >> 6;
    const int gw = blockIdx.x * 8 + wave, NGW = G * 8;
    LAS float* scr = (LAS float*)(lds + wave * 8448);
    bf16_t* WinT = (bf16_t*)(ws + WS_WIN); bf16_t* WbrT = (bf16_t*)(ws + WS_WBR); bf16_t* WoutT = (bf16_t*)(ws + WS_WOUT);
    const float* w_in = q->in[8] + (size_t)l * D * INW;
    constexpr int I_IN = 16 * 192, I_BA = 8 * 32, I_BS = 4 * 32, I_O = 16 * 32;
    constexpr int NIT = I_IN + I_BA + 2 * I_BS + I_O;
    for (int it = gw; it < NIT; it += NGW) {
        int r = it;
        if (r < I_IN) { const int kb = r / 192, nb = r % 192, n0 = nb * 32, d = win_dest(n0); if (d >= 0) transpose_item(w_in, INW, kb * 64, n0, WinT, d, 1024, 0, scr, lane); continue; } r -= I_IN;
        if (r < I_BA) { const int kb = r / 32, nb = r % 32; transpose_item(q->in[13] + (size_t)l * 512 * D, D, kb * 64, nb * 32, WbrT, nb * 32, 1280, 0, scr, lane); continue; } r -= I_BA;
        if (r < I_BS) { const int kb = r / 32, nb = r % 32; transpose_item(q->in[14] + (size_t)l * 256 * D, D, kb * 64, nb * 32, WbrT, nb * 32, 1280, 512, scr, lane); continue; } r -= I_BS;
        if (r < I_BS) { const int kb = r / 32, nb = r % 32; transpose_item(q->in[15] + (size_t)l * 256 * D, D, kb * 64, nb * 32, WbrT, nb * 32, 1280, 768, scr, lane); continue; } r -= I_BS;
        { const int kb = r / 32, nb = r % 32; transpose_item(q->in[17] + (size_t)l * D * D, D, kb * 64, nb * 32, WoutT, nb * 32, 1024, 0, scr, lane); }
    }
    __syncthreads();
    LAS float* tab = (LAS float*)(lds + 8 * 8448);
    if (tid < 64) { float s, c; sincospif((float)tid * (1.0f / 32.0f), &s, &c); tab[tid] = c; tab[64 + tid] = s; }
    __syncthreads();
    const int gt = blockIdx.x * 512 + tid, NGT = G * 512;
    for (int e = gt; e < 512 * 1024; e += NGT) {
        const int k = e & 1023, nrow = e >> 10, cs = nrow >> 8, g = (nrow >> 6) & 3, k2 = nrow & 63;
        const float* src = w_in + (size_t)k * INW + 1536 + g * 64;
        const LAS float* tb = tab + cs * 64;
        float a = 0.f;
#pragma unroll 4
        for (int c4 = 0; c4 < 16; ++c4) { const f32x4 v = *(const f32x4*)(src + 4 * c4);
#pragma unroll
            for (int x = 0; x < 4; ++x) a += v[x] * tb[(k2 * (4 * c4 + x)) & 63]; }
        WinT[(size_t)(1536 + nrow) * 1024 + k] = (bf16_t)(cvtpk(a * 0.125f, 0.f) & 0xffff);
    }
    const float* pm = q->in[11] + (size_t)l * 4 * 64 * 64; const float* psc = q->in[12] + (size_t)l * 256; const float* wp = q->in[16] + (size_t)l * 256 * D;
    for (int e = gt; e < 256 * 1024; e += NGT) {
        const int n = e & 1023, gc = e >> 10, g = gc >> 6;
        float a = 0.f;
#pragma unroll 8
        for (int d = 0; d < 64; ++d) a += pm[(size_t)gc * 64 + d] * psc[g * 64 + d] * wp[(size_t)(g * 64 + d) * D + n];
        WbrT[(size_t)n * 1280 + 1024 + gc] = (bf16_t)(cvtpk(a, 0.f) & 0xffff);
    }
    __syncthreads();
}

DI void conv_ffn(int l, LAS unsigned char* lds, int G) {
    KP q = getp(); unsigned char* ws = q->ws;
    const int tid = tid_(), lane = tid & 63, wave = tid >> 6;
    const int gw = blockIdx.x * 8 + wave, NGW = G * 8;
    LAS float* scr = (LAS float*)(lds + wave * 8448);
    bf16_t* WupT = (bf16_t*)(ws + WS_WUP); bf16_t* WdnT = (bf16_t*)(ws + WS_WDN);
    constexpr int I_U = 16 * 176, I_D = 44 * 32;
    for (int it = gw; it < I_U + I_D; it += NGW) {
        int r = it;
        if (r < I_U) { const int kb = r / 176, nb = r % 176, n0 = nb * 32; transpose_item(q->in[18] + (size_t)l * D * UPW, UPW, kb * 64, n0, WupT, wup_dest(n0), 1024, 0, scr, lane); continue; } r -= I_U;
        { const int kb = r / 32, nb = r % 32; transpose_item(q->in[20] + (size_t)l * DFF * D, D, kb * 64, nb * 32, WdnT, nb * 32, DFF, 0, scr, lane); }
    }
}

DI void norm_row(const float* xrow, const float* gain, const float* shift, const float* scale, bf16_t* orow, int lane) {
    const f32x4* xr = (const f32x4*)xrow + lane;
    f32x4 v[4]; float s = 0.f;
#pragma unroll
    for (int j = 0; j < 4; ++j) { v[j] = xr[64 * j]; s += (v[j][0] * v[j][0] + v[j][1] * v[j][1]) + (v[j][2] * v[j][2] + v[j][3] * v[j][3]); }
    const float rstd = rsqrtf(wave_sum(s) * (1.0f / D) + EPS);
#pragma unroll
    for (int j = 0; j < 4; ++j) {
        const int c = 256 * j + 4 * lane;
        const f32x4 g = *(const f32x4*)(gain + c), sh = *(const f32x4*)(shift + c), sc = *(const f32x4*)(scale + c);
        const f32x4 y = (v[j] * rstd) * g;
        const f32x4 h = y * (1.0f + sc) + sh;
        u32x2 w; w.x = cvtpk(h[0], h[1]); w.y = cvtpk(h[2], h[3]);
        *(u32x2*)(orow + c) = w;
    }
}
DI void norm_phase(const float* srcL, const float* srcC, bool do_ctx, const float* gain, const float* mods, int si, bf16_t* H, int G) {
    const int tid = tid_(), lane = tid & 63, wave = tid >> 6;
    const int gw = blockIdx.x * 8 + wave, NGW = G * 8;
    const int nrows = do_ctx ? MT : ML;
    for (int r = gw; r < nrows; r += NGW) {
        const float* x; const float* md;
        if (r < ML) { x = srcL + (size_t)r * D; md = mods + (size_t)(r >> 11) * 6144; }
        else { x = srcC + (size_t)(r - ML) * D; md = mods + (size_t)8 * 6144; }
        norm_row(x, gain, md + si * 1024, md + (si + 1) * 1024, H + (size_t)r * D, lane);
    }
}

DI void attn_unit(LAS unsigned char* lds, const bf16_t* ZQ, const bf16_t* KB, const bf16_t* VT, bf16_t* ACT4, int b, int g, int qrow0, int key0, int nkt) {
    const int tid = tid_(), wave = tid >> 6, lane = tid & 63, r32 = lane & 31, h = lane >> 5;
    const int head = g * 4 + (wave >> 1);
    const int qrow = qrow0 + (wave & 1) * 32 + r32;
    constexpr int PITCH = 144, TB = 64 * PITCH;
    bf16x8 qf[4];
#pragma unroll
    for (int s = 0; s < 4; ++s) qf[s] = *(const bf16x8*)(ZQ + (size_t)qrow * 512 + head * 64 + 16 * s + 8 * h);
    f32x16 o0, o1;
#pragma unroll
    for (int i = 0; i < 16; ++i) { o0[i] = 0.f; o1[i] = 0.f; }
    float m_run = -1e30f, l_run = 0.f;
    const bf16_t* kbase = KB + ((size_t)(b * 2 + g) * SKV + key0) * 64;
    const bf16_t* vbase = VT + ((size_t)(b * 2 + g) * 64) * SKV + key0;
    const int srow = tid >> 3, sch = tid & 7;
    u32x4 kreg = *(const u32x4*)(kbase + (size_t)srow * 64 + sch * 8);
    u32x4 vreg = *(const u32x4*)(vbase + (size_t)srow * SKV + sch * 8);
    __syncthreads();
    *(LAS u32x4*)(lds + srow * PITCH + sch * 16) = kreg;
    *(LAS u32x4*)(lds + 2 * TB + srow * PITCH + sch * 16) = vreg;
    __syncthreads();
    for (int t = 0; t < nkt; ++t) {
        const int cur = t & 1;
        if (t + 1 < nkt) {
            kreg = *(const u32x4*)(kbase + ((size_t)(t + 1) * 64 + srow) * 64 + sch * 8);
            vreg = *(const u32x4*)(vbase + (size_t)srow * SKV + (t + 1) * 64 + sch * 8);
        }
        const LAS unsigned char* kl = lds + cur * TB;
        const LAS unsigned char* vl = lds + 2 * TB + cur * TB;
        f32x16 p0, p1;
#pragma unroll
        for (int i = 0; i < 16; ++i) { p0[i] = 0.f; p1[i] = 0.f; }
#pragma unroll
        for (int s = 0; s < 4; ++s) {
            const bf16x8 ka = *(const LAS bf16x8*)(kl + r32 * PITCH + (16 * s + 8 * h) * 2);
            const bf16x8 kb2 = *(const LAS bf16x8*)(kl + (32 + r32) * PITCH + (16 * s + 8 * h) * 2);
            p0 = __builtin_amdgcn_mfma_f32_32x32x16_bf16(ka, qf[s], p0, 0, 0, 0);
            p1 = __builtin_amdgcn_mfma_f32_32x32x16_bf16(kb2, qf[s], p1, 0, 0, 0);
        }
        float mx = p0[0];
#pragma unroll
        for (int i = 1; i < 16; ++i) mx = fmaxf(mx, p0[i]);
#pragma unroll
        for (int i = 0; i < 16; ++i) mx = fmaxf(mx, p1[i]);
        mx = fmaxf(mx, __shfl_xor(mx, 32));
        const float m_new = fmaxf(m_run, mx);
        const float alpha = __builtin_amdgcn_exp2f(m_run - m_new);
        m_run = m_new;
        float rs = 0.f;
#pragma unroll
        for (int i = 0; i < 16; ++i) { p0[i] = __builtin_amdgcn_exp2f(p0[i] - m_new); p1[i] = __builtin_amdgcn_exp2f(p1[i] - m_new); rs += p0[i] + p1[i]; }
        l_run = l_run * alpha + rs;
#pragma unroll
        for (int i = 0; i < 16; ++i) { o0[i] *= alpha; o1[i] *= alpha; }
#pragma unroll
        for (int kb = 0; kb < 2; ++kb)
#pragma unroll
            for (int s2 = 0; s2 < 2; ++s2) {
                u32x4 pw;
                if (kb == 0) { pw.x = cvtpk(p0[8 * s2 + 0], p0[8 * s2 + 1]); pw.y = cvtpk(p0[8 * s2 + 2], p0[8 * s2 + 3]); pw.z = cvtpk(p0[8 * s2 + 4], p0[8 * s2 + 5]); pw.w = cvtpk(p0[8 * s2 + 6], p0[8 * s2 + 7]); }
                else { pw.x = cvtpk(p1[8 * s2 + 0], p1[8 * s2 + 1]); pw.y = cvtpk(p1[8 * s2 + 2], p1[8 * s2 + 3]); pw.z = cvtpk(p1[8 * s2 + 4], p1[8 * s2 + 5]); pw.w = cvtpk(p1[8 * s2 + 6], p1[8 * s2 + 7]); }
                const bf16x8 pb = __builtin_bit_cast(bf16x8, pw);
                const int kk = 32 * kb + 16 * s2 + 4 * h;
                {
                    const u32x2 lo = *(const LAS u32x2*)(vl + r32 * PITCH + kk * 2), hi = *(const LAS u32x2*)(vl + r32 * PITCH + (kk + 8) * 2);
                    u32x4 vw; vw.x = lo.x; vw.y = lo.y; vw.z = hi.x; vw.w = hi.y;
                    o0 = __builtin_amdgcn_mfma_f32_32x32x16_bf16(__builtin_bit_cast(bf16x8, vw), pb, o0, 0, 0, 0);
                }
                {
                    const u32x2 lo = *(const LAS u32x2*)(vl + (32 + r32) * PITCH + kk * 2), hi = *(const LAS u32x2*)(vl + (32 + r32) * PITCH + (kk + 8) * 2);
                    u32x4 vw; vw.x = lo.x; vw.y = lo.y; vw.z = hi.x; vw.w = hi.y;
                    o1 = __builtin_amdgcn_mfma_f32_32x32x16_bf16(__builtin_bit_cast(bf16x8, vw), pb, o1, 0, 0, 0);
                }
            }
        if (t + 1 < nkt) {
            *(LAS u32x4*)(lds + (cur ^ 1) * TB + srow * PITCH + sch * 16) = kreg;
            *(LAS u32x4*)(lds + 2 * TB + (cur ^ 1) * TB + srow * PITCH + sch * 16) = vreg;
        }
        __syncthreads();
    }
    const float lt = l_run + __shfl_xor(l_run, 32);
    const float inv = 1.0f / lt;
    bf16_t* orow = ACT4 + (size_t)qrow * 1280 + head * 64;
#pragma unroll
    for (int g4 = 0; g4 < 4; ++g4) {
        u32x2 w; w.x = cvtpk(o0[4 * g4] * inv, o0[4 * g4 + 1] * inv); w.y = cvtpk(o0[4 * g4 + 2] * inv, o0[4 * g4 + 3] * inv);
        *(u32x2*)(orow + 8 * g4 + 4 * h) = w;
        u32x2 w2; w2.x = cvtpk(o1[4 * g4] * inv, o1[4 * g4 + 1] * inv); w2.y = cvtpk(o1[4 * g4 + 2] * inv, o1[4 * g4 + 3] * inv);
        *(u32x2*)(orow + 32 + 8 * g4 + 4 * h) = w2;
    }
}

DI void scpool_phase(const bf16_t* ZS, const bf16_t* ZP, bf16_t* ACT4, const float* convw, int nrows, int G) {
    const int tid = tid_(), lane = tid & 63, wave = tid >> 6;
    const int gw = blockIdx.x * 8 + wave, NGW = G * 8;
    for (int r = gw; r < nrows; r += NGW) {
        int t, N; if (r < ML) { t = r & 2047; N = SEQ; } else { t = (r - ML) & 255; N = CTXL; }
        if (lane < 32) {
            const int c = lane * 8;
            float a[8];
#pragma unroll
            for (int j = 0; j < 8; ++j) a[j] = 0.f;
#pragma unroll
            for (int dt = -1; dt <= 1; ++dt) {
                if (t + dt >= 0 && t + dt < N) {
                    const bf16_t* row = ZS + (size_t)(r + dt) * 768;
                    const u32x4 gc = *(const u32x4*)(row + 256 + c), xs = *(const u32x4*)(row + 512 + c);
                    const f32x4 w0 = *(const f32x4*)(convw + (dt + 1) * 256 + c), w1 = *(const f32x4*)(convw + (dt + 1) * 256 + c + 4);
                    a[0] += w0[0] * bflo(gc.x) * bflo(xs.x); a[1] += w0[1] * bfhi(gc.x) * bfhi(xs.x);
                    a[2] += w0[2] * bflo(gc.y) * bflo(xs.y); a[3] += w0[3] * bfhi(gc.y) * bfhi(xs.y);
                    a[4] += w1[0] * bflo(gc.z) * bflo(xs.z); a[5] += w1[1] * bfhi(gc.z) * bfhi(xs.z);
                    a[6] += w1[2] * bflo(gc.w) * bflo(xs.w); a[7] += w1[3] * bfhi(gc.w) * bfhi(xs.w);
                }
            }
            const u32x4 gb = *(const u32x4*)(ZS + (size_t)r * 768 + c);
            u32x4 w; w.x = cvtpk(bflo(gb.x) * a[0], bfhi(gb.x) * a[1]); w.y = cvtpk(bflo(gb.y) * a[2], bfhi(gb.y) * a[3]);
            w.z = cvtpk(bflo(gb.z) * a[4], bfhi(gb.z) * a[5]); w.w = cvtpk(bflo(gb.w) * a[6], bfhi(gb.w) * a[7]);
            *(u32x4*)(ACT4 + (size_t)r * 1280 + 512 + c) = w;
        } else {
            const int c = (lane - 32) * 8, gi = c >> 6, wdw = 2 << gi, left = (wdw - 1) >> 1, right = wdw >> 1;
            const int lo = (t - left) > 0 ? (t - left) : 0, hi = (t + right + 1) < N ? (t + right + 1) : N;
            float a[8];
#pragma unroll
            for (int j = 0; j < 8; ++j) a[j] = 0.f;
            for (int tt = lo; tt < hi; ++tt) {
                const u32x4 v = *(const u32x4*)(ZP + (size_t)(r - t + tt) * 256 + c);
                a[0] += bflo(v.x); a[1] += bfhi(v.x); a[2] += bflo(v.y); a[3] += bfhi(v.y); a[4] += bflo(v.z); a[5] += bfhi(v.z); a[6] += bflo(v.w); a[7] += bfhi(v.w);
            }
            const float ic = 1.0f / (float)(hi - lo);
            const u32x4 x = *(const u32x4*)(ZP + (size_t)r * 256 + c);
            u32x4 w; w.x = cvtpk(a[0] * ic - bflo(x.x), a[1] * ic - bfhi(x.x)); w.y = cvtpk(a[2] * ic - bflo(x.y), a[3] * ic - bfhi(x.y));
            w.z = cvtpk(a[4] * ic - bflo(x.z), a[5] * ic - bfhi(x.z)); w.w = cvtpk(a[6] * ic - bflo(x.w), a[7] * ic - bfhi(x.w));
            *(u32x4*)(ACT4 + (size_t)r * 1280 + 1024 + c) = w;
        }
    }
}

DI void fixup_phase(const bf16_t* RAW, bf16_t* ACT, const float* wconv, int nchunks, int G) {
    const int tid = tid_();
    for (int it = blockIdx.x; it < nchunks * 2; it += G) {
        const int ch = it >> 1, which = it & 1;
        const int r = ch * 64 + (which ? 63 : 0);
        int t, N; if (r < ML) { t = r & 2047; N = SEQ; } else { t = (r - ML) & 255; N = CTXL; }
        const bf16_t *up, *mid, *dn;
        if (!which) { up = (t > 0) ? RAW + ((size_t)(ch - 1) * 4 + 1) * UPW : nullptr; mid = RAW + ((size_t)ch * 4 + 2) * UPW; dn = RAW + ((size_t)ch * 4 + 3) * UPW; }
        else { up = RAW + ((size_t)ch * 4 + 0) * UPW; mid = RAW + ((size_t)ch * 4 + 1) * UPW; dn = (t < N - 1) ? RAW + ((size_t)(ch + 1) * 4 + 2) * UPW : nullptr; }
        for (int j = tid; j < DFF; j += 512) {
            const float ua = up ? bflo(up[j]) : 0.f, ub = up ? bflo(up[DFF + j]) : 0.f;
            const float ma = bflo(mid[j]), mb = bflo(mid[DFF + j]);
            const float da = dn ? bflo(dn[j]) : 0.f, db = dn ? bflo(dn[DFF + j]) : 0.f;
            const float ca = wconv[j] * ua + wconv[UPW + j] * ma + wconv[2 * UPW + j] * da;
            const float cb = wconv[DFF + j] * ub + wconv[UPW + DFF + j] * mb + wconv[2 * UPW + DFF + j] * db;
            ACT[(size_t)r * DFF + j] = (bf16_t)(cvtpk(ca * sigmoidf_(ca) * cb, 0.f) & 0xffff);
        }
    }
}

DI void ph0(LAS unsigned char* lds) {
    KP q = getp(); unsigned char* ws = q->ws;
    const int tid = tid_(), G = gridDim.x, cu = blockIdx.x, gt = cu * 512 + tid, NGT = G * 512;
    float* MODS = (float*)(ws + WS_MODS);
    float* ROPEC = (float*)(ws + WS_ROPE); float* ROPES = ROPEC + 2048 * 32;
    bf16_t* FML = (bf16_t*)(ws + WS_FML); bf16_t* FMC = (bf16_t*)(ws + WS_FMC);
    LAS float* sm = (LAS float*)lds;
    const float* cvec = q->in[1]; const float* cctx = q->in[3]; const float* w_mod = q->in[4]; const float* b_mod = q->in[5];
    for (int it = cu; it < 192; it += G) {
        const int l = it / 96, rem = it % 96, kc = rem / 12, cb = rem % 12;
        __syncthreads();
        for (int e = tid; e < 9 * 128; e += 512) { const int v = e >> 7, k = kc * 128 + (e & 127); const float cv = (v < 8) ? cvec[v * D + k] : cctx[k]; sm[e] = cv / (1.0f + __expf(-cv)); }
        __syncthreads();
        const int j = cb * 512 + tid;
        float a[9];
#pragma unroll
        for (int v = 0; v < 9; ++v) a[v] = 0.f;
        const float* wp = w_mod + ((size_t)l * D + kc * 128) * INW + j;
#pragma unroll 4
        for (int k = 0; k < 128; ++k) { const float w = wp[(size_t)k * INW];
#pragma unroll
            for (int v = 0; v < 9; ++v) a[v] += sm[v * 128 + k] * w; }
        const float bm = (kc == 0) ? b_mod[l * INW + j] : 0.f;
#pragma unroll
        for (int v = 0; v < 9; ++v) atomicAdd(&MODS[(size_t)(l * 9 + v) * INW + j], a[v] + bm);
    }
    for (int e = gt; e < 2048 * 32; e += NGT) {
        const int t = e >> 5, ax = (e >> 4) & 1, i = e & 15;
        const float pos = (float)(ax ? (t & 63) : (t >> 6));
        const float inv = powf(10000.0f, -(float)i * (1.0f / 16.0f));
        float sn, cs; sincosf(pos * inv, &sn, &cs);
        ROPEC[e] = cs; ROPES[e] = sn;
    }
    for (int e = gt; e < 2048 * 512; e += NGT) {
        const int k1 = e >> 9, c8 = e & 511, part = c8 >> 8, n0 = (c8 & 255) * 8;
        float v[8];
#pragma unroll
        for (int j = 0; j < 8; ++j) { const int mm = (k1 * (n0 + j)) & 2047; float sn, cs; sincospif((float)mm * (1.0f / 1024.0f), &sn, &cs); v[j] = (part ? -sn : cs) * 0.022097086912079608f; }
        u32x4 w; w.x = cvtpk(v[0], v[1]); w.y = cvtpk(v[2], v[3]); w.z = cvtpk(v[4], v[5]); w.w = cvtpk(v[6], v[7]);
        *(u32x4*)(FML + (size_t)k1 * 4096 + part * 2048 + n0) = w;
    }
    for (int e = gt; e < 256 * 64; e += NGT) {
        const int k1 = e >> 6, c8 = e & 63, part = c8 >> 5, n0 = (c8 & 31) * 8;
        float v[8];
#pragma unroll
        for (int j = 0; j < 8; ++j) { const int mm = (k1 * (n0 + j)) & 255; float sn, cs; sincospif((float)mm * (1.0f / 128.0f), &sn, &cs); v[j] = (part ? -sn : cs) * 0.0625f; }
        u32x4 w; w.x = cvtpk(v[0], v[1]); w.y = cvtpk(v[2], v[3]); w.z = cvtpk(v[4], v[5]); w.w = cvtpk(v[6], v[7]);
        *(u32x4*)(FMC + (size_t)k1 * 512 + part * 256 + n0) = w;
    }
}
DI void ph_norm(int l, int which, bool do_ctx) {
    KP q = getp(); unsigned char* ws = q->ws;
    const float* MODS = (const float*)(ws + WS_MODS);
    const float* srcL = (l == 0 && which == 0) ? q->in[0] : (const float*)q->out;
    const float* srcC = (l == 0 && which == 0) ? q->in[2] : (const float*)(ws + WS_CX);
    norm_phase(srcL, srcC, do_ctx, q->in[which ? 7 : 6] + l * D, MODS + (size_t)l * 9 * INW, which ? 3 : 0, (bf16_t*)(ws + WS_H), gridDim.x);
}
DI void ph2(int l, LAS unsigned char* lds) {
    KP q = getp(); unsigned char* ws = q->ws;
    const int G = gridDim.x, cu = blockIdx.x;
    pg8::Gemm g{(const bf16_t*)(ws + WS_H), (const bf16_t*)(ws + WS_WIN), 1024, 1024};
    pg8::Sched S;
    if (l == 0) S.init(72, 25, G, cu, 16);
    else { S.init(64, 25, G, cu, 16); S.nx = 8; S.xpm0 = 64; S.xpn = 2; }
    float* ROPEC = (float*)(ws + WS_ROPE);
    EpiZ E{(bf16_t*)(ws + WS_ZQ), (bf16_t*)(ws + WS_ZS), (bf16_t*)(ws + WS_ZP), (bf16_t*)(ws + WS_KB), (bf16_t*)(ws + WS_VT), (bf16_t*)(ws + WS_YTL), (bf16_t*)(ws + WS_YTC), ws + WS_G8,
           ROPEC, ROPEC + 2048 * 32, q->in[10] + l * 128, q->in[10] + l * 128 + 64};
    pg8::gemm_phase<EpiZ, true>(lds, g, S, E);
}
DI void ph3_dft(int l, LAS unsigned char* lds) {
    KP q = getp(); unsigned char* ws = q->ws;
    const int G = gridDim.x, cu = blockIdx.x;
    const int nsub = (l == 0) ? 2 : 1;
#pragma nounroll
    for (int j = 0; j < nsub; ++j) {
        pg8::Gemm g; pg8::Sched S; EpiDft E;
        if (j == 0) { g = pg8::Gemm{(const bf16_t*)(ws + WS_FML), (const bf16_t*)(ws + WS_YTL), 4096, 4096}; S.init(8, 8, G, cu, 64); E = EpiDft{(bf16_t*)(ws + WS_ACT4), 0, SEQ}; }
        else { g = pg8::Gemm{(const bf16_t*)(ws + WS_FMC), (const bf16_t*)(ws + WS_YTC), 512, 512}; S.init(1, 8, G, (cu + G - 64) % G, 8); E = EpiDft{(bf16_t*)(ws + WS_ACT4), ML, CTXL}; }
        pg8::gemm_phase<EpiDft, true>(lds, g, S, E);
    }
}
DI void ph3_attn(int l, LAS unsigned char* lds) {
    KP q = getp(); unsigned char* ws = q->ws;
    const int G = gridDim.x, cu = blockIdx.x;
    const bf16_t* ZQ = (const bf16_t*)(ws + WS_ZQ); const bf16_t* KB = (const bf16_t*)(ws + WS_KB); const bf16_t* VT = (const bf16_t*)(ws + WS_VT); bf16_t* ACT4 = (bf16_t*)(ws + WS_ACT4);
    int a0, step;
    if (G > 64) { if (cu < 64) { a0 = cu; step = 1 << 20; } else { a0 = cu; step = G - 64; } } else { a0 = cu; step = G; }
#pragma nounroll
    for (int a = a0; a < 512; a += step) attn_unit(lds, ZQ, KB, VT, ACT4, a >> 6, (a >> 5) & 1, (a >> 6) * SEQ + (a & 31) * 64, 0, 36);
    if (l == 0) {
#pragma nounroll
        for (int a = (cu + 64) % G; a < 64; a += G) attn_unit(lds, ZQ, KB, VT, ACT4, a >> 3, (a >> 2) & 1, ML + (a >> 3) * CTXL + (a & 3) * 64, SEQ, 4);
    }
}
DI void ph3_scpool(int l) {
    KP q = getp(); unsigned char* ws = q->ws;
    scpool_phase((const bf16_t*)(ws + WS_ZS), (const bf16_t*)(ws + WS_ZP), (bf16_t*)(ws + WS_ACT4), q->in[9] + l * 768, l == 0 ? MT : ML, gridDim.x);
}
DI void ph4(int l, LAS unsigned char* lds) {
    KP q = getp(); unsigned char* ws = q->ws;
    const int G = gridDim.x, cu = blockIdx.x;
    pg8::Gemm g{(const bf16_t*)(ws + WS_ACT4), (const bf16_t*)(ws + WS_WBR), 1280, 1280};
    pg8::Sched S; S.init(l == 0 ? 72 : 64, 4, G, cu, 8); S.sub = 4;
    EpiBr E{ws + WS_G8, (bf16_t*)(ws + WS_Y), ws + WS_PY + (size_t)cu * 131072};
    pg8::gemm_phase<EpiBr, true>(lds, g, S, E);
}
DI void ph_res(int l, int which, LAS unsigned char* lds) {
    KP q = getp(); unsigned char* ws = q->ws;
    const int G = gridDim.x, cu = blockIdx.x;
    const float* mods = (const float*)(ws + WS_MODS) + (size_t)l * 9 * INW;
    float* OUT = q->out; float* CX = (float*)(ws + WS_CX);
    pg8::Gemm g; pg8::Sched S; EpiRes E;
    if (which == 0) {
        g = pg8::Gemm{(const bf16_t*)(ws + WS_Y), (const bf16_t*)(ws + WS_WOUT), 1024, 1024}; S.init(l == 0 ? 72 : 64, 4, G, cu, 16);
        E = EpiRes{(l == 0) ? q->in[0] : (const float*)OUT, OUT, (l == 0) ? q->in[2] : (const float*)CX, CX, mods + 2 * 1024};
    } else {
        g = pg8::Gemm{(const bf16_t*)(ws + WS_ACT), (const bf16_t*)(ws + WS_WDN), DFF, DFF}; S.init(l == 0 ? 72 : 64, 4, G, cu, 44);
        E = EpiRes{OUT, OUT, CX, CX, mods + 5 * 1024};
    }
    pg8::gemm_phase<EpiRes, true>(lds, g, S, E);
}
DI void ph7(int l, LAS unsigned char* lds) {
    KP q = getp(); unsigned char* ws = q->ws;
    const int G = gridDim.x, cu = blockIdx.x;
    pg8::Gemm g{(const bf16_t*)(ws + WS_H), (const bf16_t*)(ws + WS_WUP), 1024, 1024};
    pg8::Sched S; S.init(l == 0 ? 72 : 64, 22, G, cu, 16);
    EpiUp E{(bf16_t*)(ws + WS_ACT), (bf16_t*)(ws + WS_RAW), q->in[19] + (size_t)l * 3 * UPW};
    pg8::gemm_phase<EpiUp, true>(lds, g, S, E);
}
DI void ph7b(int l) {
    KP q = getp(); unsigned char* ws = q->ws;
    fixup_phase((const bf16_t*)(ws + WS_RAW), (bf16_t*)(ws + WS_ACT), q->in[19] + (size_t)l * 3 * UPW, l == 0 ? 288 : 256, gridDim.x);
}
DI void ph_final() {
    KP q = getp();
    const int tid = tid_(), lane = tid & 63, gw = blockIdx.x * 8 + (tid >> 6), NGW = gridDim.x * 8;
    const float* fg = q->in[21]; float* OUT = q->out;
    for (int r = gw; r < ML; r += NGW) {
        f32x4* xr = (f32x4*)(OUT + (size_t)r * D) + lane;
        f32x4 v[4]; float s = 0.f;
#pragma unroll
        for (int j = 0; j < 4; ++j) { v[j] = xr[64 * j]; s += (v[j][0] * v[j][0] + v[j][1] * v[j][1]) + (v[j][2] * v[j][2] + v[j][3] * v[j][3]); }
        const float rstd = rsqrtf(wave_sum(s) * (1.0f / D) + EPS);
#pragma unroll
        for (int j = 0; j < 4; ++j) { const f32x4 gg = *(const f32x4*)(fg + 256 * j + 4 * lane); xr[64 * j] = (v[j] * rstd) * gg; }
    }
}

__global__ void __launch_bounds__(512, 2) mega(Params p) {
    extern __shared__ __attribute__((aligned(16))) unsigned char lds_raw[];
    LAS unsigned char* lds = (LAS unsigned char*)lds_raw;
    cg::grid_group grid = cg::this_grid();
    ph0(lds);
    grid.sync();
    ph_norm(0, 0, true);
    conv_mixer(0, lds, gridDim.x);
    grid.sync();
#pragma nounroll
    for (int l = 0; l < 2; ++l) {
        ph2(l, lds);
        grid.sync();
        ph3_dft(l, lds);
        ph3_attn(l, lds);
        ph3_scpool(l);
        grid.sync();
        ph4(l, lds);
        grid.sync();
        ph_res(l, 0, lds);
        grid.sync();
        ph_norm(l, 1, l == 0);
        conv_ffn(l, lds, gridDim.x);
        if (l == 0) conv_mixer(1, lds, gridDim.x);
        grid.sync();
        ph7(l, lds);
        grid.sync();
        ph7b(l);
        grid.sync();
        ph_res(l, 1, lds);
        grid.sync();
        if (l == 0) { ph_norm(1, 0, true); grid.sync(); }
        else ph_final();
    }
}

extern "C" void kernel_launch(void* const* d_in, const int* in_sizes, int n_in, void* d_out, int out_size, void* d_ws, size_t ws_size, hipStream_t stream) {
    static int grid_blocks = 0;
    if (grid_blocks == 0) {
        if (n_in != 22 || ws_size < WS_END) { fprintf(stderr, "kernel_launch: unexpected inputs (n_in %d, ws %zu)\n", n_in, ws_size); grid_blocks = -1; return; }
        int dev = 0, cus = 0, per_cu = 0;
        hipGetDevice(&dev);
        hipDeviceGetAttribute(&cus, hipDeviceAttributeMultiprocessorCount, dev);
        if (hipFuncSetAttribute((const void*)mega, hipFuncAttributeMaxDynamicSharedMemorySize, LDS_BYTES) != hipSuccess) { fprintf(stderr, "kernel_launch: hipFuncSetAttribute failed\n"); }
        if (hipOccupancyMaxActiveBlocksPerMultiprocessor(&per_cu, (const void*)mega, 512, LDS_BYTES) != hipSuccess || per_cu < 1) { fprintf(stderr, "kernel_launch: occupancy query gave %d\n", per_cu); per_cu = 1; }
        (void)hipGetLastError();
        grid_blocks = cus * 1;
        fprintf(stderr, "kernel_launch: cus %d per_cu %d grid %d ws %zu\n", cus, per_cu, grid_blocks, ws_size);
    }
    if (grid_blocks < 0) return;
    hipMemsetAsync((char*)d_ws + WS_MODS, 0, MODS_BYTES, stream);
    Params p{};
    for (int i = 0; i < 22; ++i) p.in[i] = (const float*)d_in[i];
    p.out = (float*)d_out; p.ws = (unsigned char*)d_ws;
    void* args[] = {&p};
    hipError_t e = hipLaunchCooperativeKernel((void*)mega, dim3(grid_blocks), dim3(512), args, LDS_BYTES, stream);
    if (e != hipSuccess) fprintf(stderr, "cooperative launch failed: %s (grid %d)\n", hipGetErrorString(e), grid_blocks);
}
```

```cpp
#include <hip/hip_runtime.h>
#include <hip/hip_cooperative_groups.h>
#include <cstdio>
#include <cstdint>
namespace cg = cooperative_groups;

#define LAS __attribute__((address_space(3)))
#define DI __device__ __forceinline__
typedef unsigned short bf16_t;
typedef short bf16x8 __attribute__((ext_vector_type(8)));
typedef short s16x4 __attribute__((ext_vector_type(4)));
typedef float f32x4 __attribute__((ext_vector_type(4)));
typedef float f32x2_t __attribute__((ext_vector_type(2)));
typedef float f32x16 __attribute__((ext_vector_type(16)));
typedef unsigned u32x4 __attribute__((ext_vector_type(4)));
typedef unsigned u32x2 __attribute__((ext_vector_type(2)));
typedef __bf16 bf16x2_t __attribute__((ext_vector_type(2)));

constexpr int D = 1024, SEQ = 2048, NB = 8, CTXL = 256;
constexpr int ML = NB * SEQ;
constexpr int MC = NB * CTXL;
constexpr int MT = ML + MC;
constexpr int INW = 6144, DFF = 2816, UPW = 5632;
constexpr int NZ = 6400;
constexpr int SKV = SEQ + CTXL;
constexpr float EPS = 1e-6f;

constexpr size_t MiB = 1u << 20;
constexpr size_t WS_CTL = 0;
constexpr size_t WS_MODS = 64 * 1024;
constexpr size_t MODS_BYTES = 2 * 9 * 6144 * 4;
constexpr size_t WS_ROPE = 1 * MiB;
constexpr size_t WS_CX = 2 * MiB;
constexpr size_t WS_FML = 10 * MiB;
constexpr size_t WS_FMC = 26 * MiB;
constexpr size_t WS_WIN = 27 * MiB;
constexpr size_t WS_WBR = WS_WIN + (size_t)NZ * 1024 * 2;
constexpr size_t WS_WOUT = 42 * MiB;
constexpr size_t WS_H = 44 * MiB;
constexpr size_t WS_ACT4 = 44 * MiB;
constexpr size_t WS_ZQ = 89 * MiB;
constexpr size_t WS_ZS = 107 * MiB;
constexpr size_t WS_ZP = 134 * MiB;
constexpr size_t WS_KB = 143 * MiB;
constexpr size_t WS_VT = WS_KB + (size_t)NB * 2 * SKV * 64 * 2;
constexpr size_t WS_YTL = 152 * MiB;
constexpr size_t WS_YTC = 168 * MiB;
constexpr size_t WS_G8 = 170 * MiB;
constexpr size_t WS_PY = 134 * MiB;
constexpr size_t WS_Y = 89 * MiB;
constexpr size_t WS_ACT = 89 * MiB;
constexpr size_t WS_WUP = 226 * MiB;
constexpr size_t WS_WDN = 237 * MiB;
constexpr size_t WS_RAW = 243 * MiB;
constexpr size_t WS_END = 256 * MiB;
static_assert(WS_WBR + 1024 * 1280 * 2 <= WS_WOUT && WS_VT + (size_t)NB * 2 * SKV * 64 * 2 <= WS_YTL, "ws map");
static_assert(WS_G8 + (size_t)MT * 4096 <= WS_WDN + 6 * MiB && WS_RAW + 288ull * 4 * UPW * 2 <= WS_END, "ws map");
static_assert(WS_ACT + (size_t)MT * DFF * 2 <= WS_WUP, "ws map");

constexpr int LDS_BYTES = 131072 + 4096;

DI unsigned cvtpk(float lo, float hi) { f32x2_t v = {lo, hi}; bf16x2_t b = __builtin_convertvector(v, bf16x2_t); return __builtin_bit_cast(unsigned, b); }
DI float bflo(unsigned u) { return __uint_as_float(u << 16); }
DI float bfhi(unsigned u) { return __uint_as_float(u & 0xffff0000u); }
DI float wave_sum(float v) {
#pragma unroll
    for (int o = 1; o < 64; o <<= 1) v += __shfl_xor(v, o);
    return v;
}
DI int tid_() { int t; asm volatile("v_mov_b32 %0, %1" : "=v"(t) : "v"((int)threadIdx.x)); return t; }
DI float sigmoidf_(float v) { return 1.0f / (1.0f + __expf(-v)); }

struct Params { const float* in[22]; float* out; unsigned char* ws; };
typedef const __attribute__((address_space(4))) Params* KP;
DI KP getp() { KP q = (KP)__builtin_amdgcn_kernarg_segment_ptr(); asm volatile("" : "+s"(q)); return q; }

namespace pg8 {
constexpr int BM = 256, BK = 64, HALF = 128, HTB = HALF * BK * 2, STAGE_BYTES = 8 * HTB, NXCD = 8, WGM = 8;
DI int lds_byte(int r, int c) { const int st = (r >> 4) * 2 + (c >> 5), rr = r & 15, cc = c & 31, ob = rr * 64 + cc * 2; return st * 1024 + (ob ^ (((ob >> 9) & 1) << 5)); }
DI void stage_rc(int b, int& R, int& C) { const int st = b / 1024, sb = b % 1024, swz = sb ^ (((sb >> 9) & 1) << 5); R = (st >> 1) * 16 + swz / 64; C = (st & 1) * 32 + (swz % 64) / 2; }
DI int perm32(int rho) { const int n = rho >> 4, i = rho & 15; return 8 * (i >> 2) + 4 * n + (i & 3); }

struct Unit { int pm, pn, koff, nt, tag; };
struct Gemm { const bf16_t* A; const bf16_t* Bt; int lda, ldb; };

struct Sched {
    int nM, nN, nwg, G, c, nx, xpm0, xpn, sub, nt;
    DI void init(int nM_, int nN_, int G_, int c_, int nt_) { nM = nM_; nN = nN_; nwg = nM * nN; G = G_; c = c_; nx = 0; xpm0 = 0; xpn = 0; sub = 1; nt = nt_; }
    DI bool next(int i, Unit& u) const {
        int ti = i, s = 0;
        if (sub == 4) { ti = i >> 2; s = i & 3; }
        const long L = (long)ti * G + c;
        if (L < nwg) {
            int wgid = (int)L; { const int q = nwg / NXCD, r = nwg % NXCD, xcd = wgid % NXCD, off = wgid / NXCD; wgid = (xcd < r ? xcd * (q + 1) : r * (q + 1) + (xcd - r) * q) + off; }
            const int nig = WGM * nN, gid = wgid / nig, fm = gid * WGM, gsz = (nM - fm) < WGM ? (nM - fm) : WGM;
            u.pm = fm + ((wgid % nig) % gsz); u.pn = (wgid % nig) / gsz;
        } else if (L - nwg < nx) { u.pm = xpm0 + (int)(L - nwg); u.pn = xpn; }
        else return false;
        if (sub == 4) { u.tag = s; u.koff = (s == 0) ? 0 : 256 + 256 * s; u.nt = (s == 0) ? 8 : 4; }
        else { u.tag = 0; u.koff = 0; u.nt = nt; }
        return true;
    }
};

typedef f32x4 Acc[2][2][4][2];
DI void zero_acc(Acc& acc) {
#pragma unroll
    for (int a = 0; a < 2; ++a)
#pragma unroll
        for (int b = 0; b < 2; ++b)
#pragma unroll
            for (int m = 0; m < 4; ++m)
#pragma unroll
                for (int n = 0; n < 2; ++n) acc[a][b][m][n] = (f32x4){0.f, 0.f, 0.f, 0.f};
}

template <class Epi, bool ALIGN_EPI>
DI void gemm_phase(LAS unsigned char* lds, const Gemm g, const Sched& S, const Epi& E) {
    int tid; asm volatile("v_mov_b32 %0, %1" : "=v"(tid) : "v"((int)threadIdx.x));
    const int wid = __builtin_amdgcn_readfirstlane(tid >> 6), lane = tid & 63, wr = wid >> 2, wc = wid & 3, fr = lane & 15, fq = lane >> 4;
    unsigned voffA[2], voffB[2];
#pragma unroll
    for (int i = 0; i < 2; ++i) { int R, C; stage_rc(tid * 16 + i * 8192, R, C); const int Rb = Epi::PERM ? ((R & ~31) + perm32(R & 31)) : R;
        voffA[i] = (unsigned)(R * g.lda + C) * 2u; voffB[i] = (unsigned)(Rb * g.ldb + C) * 2u; }
    const size_t kstep = (size_t)(BK * 2);
    const size_t hstepA = (size_t)HALF * g.lda * 2, hstepB = (size_t)HALF * g.ldb * 2;
    const size_t tstepA = 2 * hstepA, tstepB = 2 * hstepB;
    const unsigned ldsw = (unsigned)wid * 1024u;
    const int aoff = lds_byte(wr * 64 + fr, fq * 8), boff = lds_byte(wc * 32 + fr, fq * 8);
#define PG8_SA(b, h) (((b) * 2 + (h)) * HTB)
#define PG8_SB(b, h) ((4 + (b) * 2 + (h)) * HTB)
#define PG8_STAGE(bufoff, gbase, voff) do { _Pragma("unroll") for (int _i = 0; _i < 2; ++_i) \
        __builtin_amdgcn_global_load_lds((const unsigned*)((const char*)(gbase) + (voff)[_i]), (LAS unsigned*)(lds + (bufoff) + ldsw + _i * 8192), 16, 0, 0); } while (0)
#define PG8_LDA(dst, b, h) do { _Pragma("unroll") for (int m = 0; m < 4; ++m) _Pragma("unroll") for (int k = 0; k < 2; ++k) dst[m][k] = *(const LAS bf16x8*)(lds + PG8_SA(b, h) + aoff + m * 2048 + k * 1024); } while (0)
#define PG8_LDB(dst, b, h) do { _Pragma("unroll") for (int n = 0; n < 2; ++n) _Pragma("unroll") for (int k = 0; k < 2; ++k) dst[n][k] = *(const LAS bf16x8*)(lds + PG8_SB(b, h) + boff + n * 2048 + k * 1024); } while (0)
#define PG8_MMA(ai, bj, At, Bt) do { __builtin_amdgcn_s_setprio(1); _Pragma("unroll") for (int m = 0; m < 4; ++m) _Pragma("unroll") for (int n = 0; n < 2; ++n) _Pragma("unroll") for (int k = 0; k < 2; ++k) \
        acc[ai][bj][m][n] = __builtin_amdgcn_mfma_f32_16x16x32_bf16(Bt[n][k], At[m][k], acc[ai][bj][m][n], 0, 0, 0); __builtin_amdgcn_s_setprio(0); } while (0)
#define PG8_WAIT_V(n) asm volatile("s_waitcnt vmcnt(" #n ")" ::: "memory")
#define PG8_WAIT_L(n) asm volatile("s_waitcnt lgkmcnt(" #n ")" ::: "memory")
#define PG8_BAR __builtin_amdgcn_s_barrier()
#define PG8_SCHED __builtin_amdgcn_sched_barrier(0)
    Unit cur, nxt; int ui = 0;
    if (!S.next(0, cur)) return;
    Acc acc;
    { int l2; asm volatile("v_mov_b32 %0, %1" : "=v"(l2) : "v"(lane)); E.init(acc, cur, wr, wc, l2 & 15, l2 >> 4); }
    PG8_WAIT_V(0);
    bf16x8 At[4][2], B0[2][2], B1[2][2];
    const char* cA = (const char*)g.A + (size_t)cur.pm * tstepA + (size_t)cur.koff * 2; const char* cB = (const char*)g.Bt + (size_t)cur.pn * tstepB + (size_t)cur.koff * 2;
    PG8_STAGE(PG8_SB(0, 0), cB, voffB); PG8_STAGE(PG8_SB(0, 1), cB + hstepB, voffB); PG8_STAGE(PG8_SA(0, 0), cA, voffA); PG8_STAGE(PG8_SA(0, 1), cA + hstepA, voffA);
    if (wr == 1) PG8_BAR;
    PG8_WAIT_V(2); PG8_BAR;
    PG8_STAGE(PG8_SB(1, 0), cB + kstep, voffB); PG8_STAGE(PG8_SA(1, 0), cA + kstep, voffA); PG8_STAGE(PG8_SB(1, 1), cB + hstepB + kstep, voffB);
    PG8_WAIT_V(6); PG8_BAR;
    for (;;) {
        const bool has_next = S.next(ui + 1, nxt);
        const char* nA = has_next ? (const char*)g.A + (size_t)nxt.pm * tstepA + (size_t)nxt.koff * 2 : cA;
        const char* nB = has_next ? (const char*)g.Bt + (size_t)nxt.pn * tstepB + (size_t)nxt.koff * 2 : cB;
        const int nt = cur.nt;
        for (int t = 0; t < nt; t += 2) {
            const bool last = (t == nt - 2);
            const char* a1 = cA + (size_t)(t + 1) * kstep;
            const char* a2 = last ? nA : cA + (size_t)(t + 2) * kstep; const char* b2 = last ? nB : cB + (size_t)(t + 2) * kstep;
            const char* a3 = a2 + kstep; const char* b3 = b2 + kstep;
            PG8_LDB(B0, 0, 0); PG8_LDB(B1, 0, 1); PG8_SCHED; PG8_LDA(At, 0, 0); PG8_STAGE(PG8_SA(1, 1), a1 + hstepA, voffA);
            PG8_WAIT_V(8); PG8_WAIT_L(0); PG8_BAR; PG8_MMA(0, 0, At, B0); PG8_MMA(0, 1, At, B1); PG8_BAR; PG8_SCHED;
            PG8_LDA(At, 0, 1); PG8_STAGE(PG8_SB(0, 0), b2, voffB); PG8_STAGE(PG8_SB(0, 1), b2 + hstepB, voffB); PG8_STAGE(PG8_SA(0, 0), a2, voffA);
            PG8_WAIT_V(8); PG8_WAIT_L(0); PG8_BAR; PG8_MMA(1, 0, At, B0); PG8_MMA(1, 1, At, B1); PG8_BAR; PG8_SCHED;
            PG8_LDB(B0, 1, 0); PG8_LDB(B1, 1, 1); PG8_SCHED; PG8_LDA(At, 1, 0); PG8_STAGE(PG8_SA(0, 1), a2 + hstepA, voffA);
            PG8_WAIT_V(8); PG8_WAIT_L(0); PG8_BAR; PG8_MMA(0, 0, At, B0); PG8_MMA(0, 1, At, B1); PG8_BAR; PG8_SCHED;
            PG8_LDA(At, 1, 1); PG8_STAGE(PG8_SB(1, 0), b3, voffB); PG8_STAGE(PG8_SB(1, 1), b3 + hstepB, voffB); PG8_STAGE(PG8_SA(1, 0), a3, voffA);
            PG8_WAIT_V(8); PG8_WAIT_L(0); PG8_BAR; PG8_MMA(1, 0, At, B0); PG8_MMA(1, 1, At, B1); PG8_BAR; PG8_SCHED;
        }
        if constexpr (ALIGN_EPI) { if (wr == 0) PG8_BAR; }
        int l2; asm volatile("v_mov_b32 %0, %1" : "=v"(l2) : "v"(lane));
        E(acc, cur, wr, wc, l2 & 15, l2 >> 4);
        if (!has_next) break;
        E.init(acc, nxt, wr, wc, l2 & 15, l2 >> 4);
        PG8_WAIT_V(0);
        cur = nxt; cA = nA; cB = nB; ++ui;
        if constexpr (ALIGN_EPI) { if (wr == 1) PG8_BAR; }
    }
    PG8_WAIT_V(0);
    if constexpr (!ALIGN_EPI) { if (wr == 0) PG8_BAR; }
    PG8_BAR;
#undef PG8_SA
#undef PG8_SB
#undef PG8_STAGE
#undef PG8_LDA
#undef PG8_LDB
#undef PG8_MMA
#undef PG8_WAIT_V
#undef PG8_WAIT_L
#undef PG8_BAR
#undef PG8_SCHED
}
}
using pg8::Acc; using pg8::Unit;

struct EpiZ {
    static constexpr bool PERM = false;
    bf16_t *ZQ, *ZS, *ZP, *KB, *VT, *YTL, *YTC; unsigned char* G8;
    const float *ropec, *ropes, *qg, *kg;
    DI void init(Acc& acc, const Unit&, int, int, int, int) const { pg8::zero_acc(acc); }
    DI void operator()(Acc& acc, const Unit& u, int wr, int wc, int fr, int fq) const {
        const bool isctx = u.pm >= 64;
        const int pn = u.pn;
        if (pn <= 2) {
            if (pn == 2 && wc >= 2) {
                const int g = wc - 2;
#pragma unroll
                for (int ai = 0; ai < 2; ++ai)
#pragma unroll
                    for (int m = 0; m < 4; ++m) {
                        const int r = u.pm * 256 + ai * 128 + wr * 64 + m * 16 + fr;
                        int b, pos; if (!isctx) { b = r >> 11; pos = r & 2047; } else { const int rc = r - ML; b = rc >> 8; pos = SEQ + (rc & 255); }
                        bf16_t* vb = VT + ((size_t)(b * 2 + g) * 64) * SKV + pos;
#pragma unroll
                        for (int bj = 0; bj < 2; ++bj)
#pragma unroll
                            for (int n = 0; n < 2; ++n) {
                                const f32x4 v = acc[ai][bj][m][n];
                                const unsigned p0 = cvtpk(v[0], v[1]), p1 = cvtpk(v[2], v[3]);
                                const int e = 32 * bj + 16 * n + 4 * fq;
                                vb[(size_t)(e + 0) * SKV] = (bf16_t)(p0 & 0xffff); vb[(size_t)(e + 1) * SKV] = (bf16_t)(p0 >> 16);
                                vb[(size_t)(e + 2) * SKV] = (bf16_t)(p1 & 0xffff); vb[(size_t)(e + 3) * SKV] = (bf16_t)(p1 >> 16);
                            }
                    }
                return;
            }
            const bool isq = pn < 2;
            const float* gain = isq ? qg : kg;
            const float osc = isq ? (0.125f * 1.4426950408889634f) : 1.0f;
#pragma unroll
            for (int ai = 0; ai < 2; ++ai)
#pragma unroll
                for (int m = 0; m < 4; ++m) {
                    const int r = u.pm * 256 + ai * 128 + wr * 64 + m * 16 + fr;
                    float ss = 0.f;
#pragma unroll
                    for (int bj = 0; bj < 2; ++bj)
#pragma unroll
                        for (int n = 0; n < 2; ++n) { const f32x4 v = acc[ai][bj][m][n]; ss += (v[0] * v[0] + v[1] * v[1]) + (v[2] * v[2] + v[3] * v[3]); }
                    ss += __shfl_xor(ss, 16); ss += __shfl_xor(ss, 32);
                    const float rinv = rsqrtf(ss * (1.0f / 64.0f) + EPS) * osc;
                    int b, pos, t = 0; if (!isctx) { b = r >> 11; pos = r & 2047; t = pos; } else { const int rc = r - ML; b = rc >> 8; pos = SEQ + (rc & 255); }
                    bf16_t* dst;
                    if (isq) dst = ZQ + (size_t)r * 512 + (pn * 4 + wc) * 64;
                    else dst = KB + ((size_t)(b * 2 + wc) * SKV + pos) * 64;
#pragma unroll
                    for (int bj = 0; bj < 2; ++bj) {
                        const f32x4 g0 = *(const f32x4*)(gain + 32 * bj + 4 * fq), g1 = *(const f32x4*)(gain + 32 * bj + 16 + 4 * fq);
                        f32x4 x0 = acc[ai][bj][m][0] * rinv * g0, x1 = acc[ai][bj][m][1] * rinv * g1;
                        if (!isctx) {
                            const f32x4 cs = *(const f32x4*)(ropec + (t * 2 + bj) * 16 + 4 * fq), sn = *(const f32x4*)(ropes + (t * 2 + bj) * 16 + 4 * fq);
                            const f32x4 o0 = x0 * cs - x1 * sn, o1 = x1 * cs + x0 * sn; x0 = o0; x1 = o1;
                        }
                        u32x2 w0, w1; w0.x = cvtpk(x0[0], x0[1]); w0.y = cvtpk(x0[2], x0[3]); w1.x = cvtpk(x1[0], x1[1]); w1.y = cvtpk(x1[2], x1[3]);
                        *(u32x2*)(dst + 32 * bj + 4 * fq) = w0; *(u32x2*)(dst + 32 * bj + 16 + 4 * fq) = w1;
                    }
                }
            return;
        }
#pragma unroll
        for (int ai = 0; ai < 2; ++ai)
#pragma unroll
            for (int m = 0; m < 4; ++m) {
                const int r = u.pm * 256 + ai * 128 + wr * 64 + m * 16 + fr;
                int b, t; if (!isctx) { b = r >> 11; t = r & 2047; } else { const int rc = r - ML; b = rc >> 8; t = rc & 255; }
#pragma unroll
                for (int bj = 0; bj < 2; ++bj)
#pragma unroll
                    for (int n = 0; n < 2; ++n) {
                        const f32x4 v = acc[ai][bj][m][n];
                        const int c = 128 * bj + 32 * wc + 16 * n + 4 * fq;
                        if (pn >= 9) {
                            unsigned w = 0;
#pragma unroll
                            for (int x = 0; x < 4; ++x) { const float s = sigmoidf_(v[x]); int q = (int)(s * 256.0f); q = q > 255 ? 255 : (q < 0 ? 0 : q); w |= (unsigned)q << (8 * x); }
                            *(unsigned*)(G8 + (size_t)r * 4096 + (pn - 9) * 256 + c) = w;
                        } else if (pn <= 5) {
                            u32x2 w; w.x = cvtpk(v[0], v[1]); w.y = cvtpk(v[2], v[3]);
                            *(u32x2*)(ZS + (size_t)r * 768 + (pn - 3) * 256 + c) = w;
                        } else if (pn == 8) {
                            u32x2 w; w.x = cvtpk(v[0], v[1]); w.y = cvtpk(v[2], v[3]);
                            *(u32x2*)(ZP + (size_t)r * 256 + c) = w;
                        } else {
                            const int cs = pn - 6;
                            const unsigned p0 = cvtpk(v[0], v[1]), p1 = cvtpk(v[2], v[3]);
                            bf16_t* y; size_t st;
                            if (!isctx) { y = YTL + ((size_t)(b * 256 + c) * 4096) + cs * 2048 + t; st = 4096; }
                            else { y = YTC + ((size_t)(b * 256 + c) * 512) + cs * 256 + t; st = 512; }
                            y[0] = (bf16_t)(p0 & 0xffff); y[st] = (bf16_t)(p0 >> 16); y[2 * st] = (bf16_t)(p1 & 0xffff); y[3 * st] = (bf16_t)(p1 >> 16);
                        }
                    }
            }
    }
};

struct EpiDft {
    static constexpr bool PERM = true;
    bf16_t* ACT4; int rowbase, nrows;
    DI void init(Acc& acc, const Unit&, int, int, int, int) const { pg8::zero_acc(acc); }
    DI void operator()(Acc& acc, const Unit& u, int wr, int wc, int fr, int fq) const {
#pragma unroll
        for (int ai = 0; ai < 2; ++ai)
#pragma unroll
            for (int m = 0; m < 4; ++m) {
                const int r = rowbase + u.pn * nrows + u.pm * 256 + ai * 128 + wr * 64 + m * 16 + fr;
#pragma unroll
                for (int bj = 0; bj < 2; ++bj) {
                    const f32x4 v0 = acc[ai][bj][m][0], v1 = acc[ai][bj][m][1];
                    u32x4 w; w.x = cvtpk(v0[0], v0[1]); w.y = cvtpk(v0[2], v0[3]); w.z = cvtpk(v1[0], v1[1]); w.w = cvtpk(v1[2], v1[3]);
                    *(u32x4*)(ACT4 + (size_t)r * 1280 + 768 + 128 * bj + 32 * wc + 8 * fq) = w;
                }
            }
    }
};

struct EpiBr {
    static constexpr bool PERM = true;
    const unsigned char* G8; bf16_t* Y; unsigned char* PY;
    DI void init(Acc& acc, const Unit&, int, int, int, int) const { pg8::zero_acc(acc); }
    DI void operator()(Acc& acc, const Unit& u, int wr, int wc, int fr, int fq) const {
        const unsigned char* ub = G8 + ((size_t)u.pm * 256 + wr * 64) * 4096 + u.tag * 1024 + u.pn * 256 + 32 * wc;
        const unsigned lo = (unsigned)(fr * 4096 + 8 * fq);
        unsigned char* pyb = PY + (size_t)((wr * 4 + wc) * 64 + fr + 16 * fq) * 16;
        bf16_t* yb = Y + ((size_t)u.pm * 256 + wr * 64) * 1024 + u.pn * 256 + 32 * wc;
        const unsigned yo = (unsigned)(fr * 1024 + 8 * fq);
#pragma unroll
        for (int ai = 0; ai < 2; ++ai) {
            u32x2 gw[4][2];
#pragma unroll
            for (int m = 0; m < 4; ++m)
#pragma unroll
                for (int bj = 0; bj < 2; ++bj) gw[m][bj] = *(const u32x2*)(ub + ((ai * 128 + m * 16) * 4096 + bj * 128) + lo);
#pragma unroll
            for (int m = 0; m < 4; ++m)
#pragma unroll
                for (int bj = 0; bj < 2; ++bj) {
                    f32x4 v[2];
#pragma unroll
                    for (int n = 0; n < 2; ++n) { const unsigned w = n ? gw[m][bj].y : gw[m][bj].x;
#pragma unroll
                        for (int x = 0; x < 4; ++x) { const float gq = ((float)((w >> (8 * x)) & 255u) + 0.5f) * (1.0f / 256.0f); v[n][x] = acc[ai][bj][m][n][x] * gq; } }
                    unsigned char* pp = pyb + (size_t)(((ai * 4 + m) * 2 + bj) * 512) * 16;
                    if (u.tag != 0) {
                        const u32x4 pv = *(const u32x4*)pp;
                        v[0][0] += bflo(pv.x); v[0][1] += bfhi(pv.x); v[0][2] += bflo(pv.y); v[0][3] += bfhi(pv.y);
                        v[1][0] += bflo(pv.z); v[1][1] += bfhi(pv.z); v[1][2] += bflo(pv.w); v[1][3] += bfhi(pv.w);
                    }
                    u32x4 w; w.x = cvtpk(v[0][0], v[0][1]); w.y = cvtpk(v[0][2], v[0][3]); w.z = cvtpk(v[1][0], v[1][1]); w.w = cvtpk(v[1][2], v[1][3]);
                    if (u.tag != 3) *(u32x4*)pp = w;
                    else *(u32x4*)(yb + ((ai * 128 + m * 16) * 1024 + bj * 128) + yo) = w;
                }
        }
    }
};

struct EpiRes {
    static constexpr bool PERM = false;
    const float* srcL; float* dstL; const float* srcC; float* dstC; const float* gates;
    DI void init(Acc& acc, const Unit&, int, int, int, int) const { pg8::zero_acc(acc); }
    DI void operator()(Acc& acc, const Unit& u, int wr, int wc, int fr, int fq) const {
        const bool isctx = u.pm >= 64;
        const size_t rb = isctx ? ((size_t)(u.pm - 64) * 256 + wr * 64) : ((size_t)u.pm * 256 + wr * 64);
        const float* sb = (isctx ? srcC : srcL) + rb * D + u.pn * 256 + 32 * wc;
        float* db = (isctx ? dstC : dstL) + rb * D + u.pn * 256 + 32 * wc;
        const float* gb = gates + (size_t)(isctx ? 8 : (u.pm >> 3)) * 6144 + u.pn * 256 + 32 * wc;
        const unsigned lo = (unsigned)(fr * D + 4 * fq), go = (unsigned)(4 * fq);
#pragma unroll
        for (int ai = 0; ai < 2; ++ai)
#pragma unroll
            for (int m = 0; m < 4; ++m) {
#pragma unroll
                for (int bj = 0; bj < 2; ++bj)
#pragma unroll
                    for (int n = 0; n < 2; ++n) {
                        const int co = (ai * 128 + m * 16) * D + bj * 128 + n * 16;
                        const f32x4 s = *(const f32x4*)(sb + co + lo), gg = *(const f32x4*)(gb + (bj * 128 + n * 16) + go);
                        *(f32x4*)(db + co + lo) = s + gg * acc[ai][bj][m][n];
                    }
                if (m == 3) asm volatile("" ::: "memory");
            }
    }
};

struct EpiUp {
    static constexpr bool PERM = true;
    bf16_t* ACT; bf16_t* RAW; const float* wconv;
    DI void init(Acc& acc, const Unit&, int, int, int, int) const { pg8::zero_acc(acc); }
    DI void operator()(Acc& acc, const Unit& u, int wr, int wc, int fr, int fq) const {
        const int lane = fr + 16 * fq;
        const int srcR = (lane & 48) | ((fr + 15) & 15), srcLn = (lane & 48) | ((fr + 1) & 15);
        const int jl = 32 * wc + 8 * fq;
        const int ja = u.pn * 128 + jl;
        bf16_t* ab = ACT + ((size_t)u.pm * 256 + wr * 64) * DFF + u.pn * 128 + 32 * wc;
        const unsigned alo = (unsigned)(fr * DFF + 8 * fq);
#pragma unroll
        for (int ai = 0; ai < 2; ++ai) {
            const int rbase = u.pm * 256 + ai * 128 + wr * 64;
#pragma unroll
            for (int m = 0; m < 4; m += 3) {
                const bool dump = (m == 0) ? (fr < 2) : (fr >= 14);
                if (dump) {
                    const int slot = (m == 0) ? (2 + fr) : (fr - 14);
                    bf16_t* rw = RAW + ((size_t)(rbase >> 6) * 4 + slot) * UPW;
#pragma unroll
                    for (int bj = 0; bj < 2; ++bj) {
                        const f32x4 v0 = acc[ai][bj][m][0], v1 = acc[ai][bj][m][1];
                        u32x4 w; w.x = cvtpk(v0[0], v0[1]); w.y = cvtpk(v0[2], v0[3]); w.z = cvtpk(v1[0], v1[1]); w.w = cvtpk(v1[2], v1[3]);
                        *(u32x4*)(rw + bj * DFF + ja) = w;
                    }
                }
            }
#pragma unroll
            for (int n = 0; n < 2; ++n) {
#pragma unroll
                for (int xp = 0; xp < 2; ++xp) {
                    float act[4][2];
#pragma unroll
                    for (int xx = 0; xx < 2; ++xx) {
                        const int x = 2 * xp + xx;
                        float ca[4], cb[4];
#pragma unroll
                        for (int bj = 0; bj < 2; ++bj) {
                            const float* wp = wconv + bj * DFF + ja + 4 * n + x;
                            const float w0 = wp[0], w1 = wp[UPW], w2 = wp[2 * UPW];
                            float R[4], L[4];
#pragma unroll
                            for (int m = 0; m < 4; ++m) { const float v = acc[ai][bj][m][n][x]; R[m] = __shfl(v, srcR); L[m] = __shfl(v, srcLn); }
#pragma unroll
                            for (int m = 0; m < 4; ++m) {
                                const float up = (fr > 0) ? R[m] : (m > 0 ? R[m > 0 ? m - 1 : 0] : 0.f);
                                const float dn = (fr < 15) ? L[m] : (m < 3 ? L[m < 3 ? m + 1 : 3] : 0.f);
                                const float cv = w0 * up + w1 * acc[ai][bj][m][n][x] + w2 * dn;
                                if (bj == 0) ca[m] = cv; else cb[m] = cv;
                            }
                        }
#pragma unroll
                        for (int m = 0; m < 4; ++m) act[m][xx] = ca[m] * sigmoidf_(ca[m]) * cb[m];
                    }
#pragma unroll
                    for (int m = 0; m < 4; ++m) {
                        const bool skip = (m == 0 && fr == 0) || (m == 3 && fr == 15);
                        if (!skip) *(unsigned*)(ab + ((ai * 128 + m * 16) * DFF + 4 * n + 2 * xp) + alo) = cvtpk(act[m][0], act[m][1]);
                    }
                    asm volatile("" ::: "memory");
                }
            }
        }
    }
};

DI void transpose_item(const float* W, int ldn, int k0, int n0, bf16_t* WT, int drow0, int ldd, int koff, LAS float* scr, int lane) {
#pragma unroll 8
    for (int i = 0; i < 32; ++i) { const int kk = 2 * i + (lane >> 5); scr[kk * 33 + (lane & 31)] = W[(size_t)(k0 + kk) * ldn + n0 + (lane & 31)]; }
    asm volatile("s_waitcnt lgkmcnt(0)" ::: "memory");
    const int c = lane & 7;
#pragma unroll
    for (int j = 0; j < 4; ++j) { const int n = (lane >> 3) + 8 * j; const LAS float* s = scr + (8 * c) * 33 + n;
        u32x4 o; o.x = cvtpk(s[0 * 33], s[1 * 33]); o.y = cvtpk(s[2 * 33], s[3 * 33]); o.z = cvtpk(s[4 * 33], s[5 * 33]); o.w = cvtpk(s[6 * 33], s[7 * 33]);
        *(u32x4*)(WT + (size_t)(drow0 + n) * ldd + koff + k0 + 8 * c) = o; }
    asm volatile("s_waitcnt lgkmcnt(0)" ::: "memory");
}
DI int win_dest(int n0) {
    if (n0 < 768) { const int tile = n0 >> 8, within = n0 & 255, hd = within >> 6, e = within & 63; return tile * 256 + 128 * (e >> 5) + 32 * hd + (e & 31); }
    if (n0 < 1536) return n0;
    if (n0 < 1792) return -1;
    return n0 + 256;
}
DI int wup_dest(int n0) { if (n0 < DFF) return 256 * (n0 >> 7) + (n0 & 127); const int j = n0 - DFF; return 256 * (j >> 7) + 128 + (j & 127); }

DI void conv_mixer(int l, LAS unsigned char* lds, int G) {
    KP q = getp(); unsigned char* ws = q->ws;
    const int tid = tid_(), lane = tid & 63, wave = tid >> 6;
    const int gw = blockIdx.x * 8 + wave, NGW = G * 8;
    LAS float* scr = (LAS float*)(lds + wave * 8448);
    bf16_t* WinT = (bf16_t*)(ws + WS_WIN); bf16_t* WbrT = (bf16_t*)(ws + WS_WBR); bf16_t* WoutT = (bf16_t*)(ws + WS_WOUT);
    const float* w_in = q->in[8] + (size_t)l * D * INW;
    constexpr int I_IN = 16 * 192, I_BA = 8 * 32, I_BS = 4 * 32, I_O = 16 * 32;
    constexpr int NIT = I_IN + I_BA + 2 * I_BS + I_O;
    for (int it = gw; it < NIT; it += NGW) {
        int r = it;
        if (r < I_IN) { const int kb = r / 192, nb = r % 192, n0 = nb * 32, d = win_dest(n0); if (d >= 0) transpose_item(w_in, INW, kb * 64, n0, WinT, d, 1024, 0, scr, lane); continue; } r -= I_IN;
        if (r < I_BA) { const int kb = r / 32, nb = r % 32; transpose_item(q->in[13] + (size_t)l * 512 * D, D, kb * 64, nb * 32, WbrT, nb * 32, 1280, 0, scr, lane); continue; } r -= I_BA;
        if (r < I_BS) { const int kb = r / 32, nb = r % 32; transpose_item(q->in[14] + (size_t)l * 256 * D, D, kb * 64, nb * 32, WbrT, nb * 32, 1280, 512, scr, lane); continue; } r -= I_BS;
        if (r < I_BS) { const int kb = r / 32, nb = r % 32; transpose_item(q->in[15] + (size_t)l * 256 * D, D, kb * 64, nb * 32, WbrT, nb * 32, 1280, 768, scr, lane); continue; } r -= I_BS;
        { const int kb = r / 32, nb = r % 32; transpose_item(q->in[17] + (size_t)l * D * D, D, kb * 64, nb * 32, WoutT, nb * 32, 1024, 0, scr, lane); }
    }
    __syncthreads();
    LAS float* tab = (LAS float*)(lds + 8 * 8448);
    if (tid < 64) { float s, c; sincospif((float)tid * (1.0f / 32.0f), &s, &c); tab[tid] = c; tab[64 + tid] = s; }
    __syncthreads();
    const int gt = blockIdx.x * 512 + tid, NGT = G * 512;
    for (int e = gt; e < 512 * 1024; e += NGT) {
        const int k = e & 1023, nrow = e >> 10, cs = nrow >> 8, g = (nrow >> 6) & 3, k2 = nrow & 63;
        const float* src = w_in + (size_t)k * INW + 1536 + g * 64;
        const LAS float* tb = tab + cs * 64;
        float a = 0.f;
#pragma unroll 4
        for (int c4 = 0; c4 < 16; ++c4) { const f32x4 v = *(const f32x4*)(src + 4 * c4);
#pragma unroll
            for (int x = 0; x < 4; ++x) a += v[x] * tb[(k2 * (4 * c4 + x)) & 63]; }
        WinT[(size_t)(1536 + nrow) * 1024 + k] = (bf16_t)(cvtpk(a * 0.125f, 0.f) & 0xffff);
    }
    const float* pm = q->in[11] + (size_t)l * 4 * 64 * 64; const float* psc = q->in[12] + (size_t)l * 256; const float* wp = q->in[16] + (size_t)l * 256 * D;
    for (int e = gt; e < 256 * 1024; e += NGT) {
        const int n = e & 1023, gc = e >> 10, g = gc >> 6;
        float a = 0.f;
#pragma unroll 8
        for (int d = 0; d < 64; ++d) a += pm[(size_t)gc * 64 + d] * psc[g * 64 + d] * wp[(size_t)(g * 64 + d) * D + n];
        WbrT[(size_t)n * 1280 + 1024 + gc] = (bf16_t)(cvtpk(a, 0.f) & 0xffff);
    }
    __syncthreads();
}

DI void conv_ffn(int l, LAS unsigned char* lds, int G) {
    KP q = getp(); unsigned char* ws = q->ws;
    const int tid = tid_(), lane = tid & 63, wave = tid >> 6;
    const int gw = blockIdx.x * 8 + wave, NGW = G * 8;
    LAS float* scr = (LAS float*)(lds + wave * 8448);
    bf16_t* WupT = (bf16_t*)(ws + WS_WUP); bf16_t* WdnT = (bf16_t*)(ws + WS_WDN);
    constexpr int I_U = 16 * 176, I_D = 44 * 32;
    for (int it = gw; it < I_U + I_D; it += NGW) {
        int r = it;
        if (r < I_U) { const int kb = r / 176, nb = r % 176, n0 = nb * 32; transpose_item(q->in[18] + (size_t)l * D * UPW, UPW, kb * 64, n0, WupT, wup_dest(n0), 1024, 0, scr, lane); continue; } r -= I_U;
        { const int kb = r / 32, nb = r % 32; transpose_item(q->in[20] + (size_t)l * DFF * D, D, kb * 64, nb * 32, WdnT, nb * 32, DFF, 0, scr, lane); }
    }
}

DI void norm_row(const float* xrow, const float* gain, const float* shift, const float* scale, bf16_t* orow, int lane) {
    const f32x4* xr = (const f32x4*)xrow + lane;
    f32x4 v[4]; float s = 0.f;
#pragma unroll
    for (int j = 0; j < 4; ++j) { v[j] = xr[64 * j]; s += (v[j][0] * v[j][0] + v[j][1] * v[j][1]) + (v[j][2] * v[j][2] + v[j][3] * v[j][3]); }
    const float rstd = rsqrtf(wave_sum(s) * (1.0f / D) + EPS);
#pragma unroll
    for (int j = 0; j < 4; ++j) {
        const int c = 256 * j + 4 * lane;
        const f32x4 g = *(const f32x4*)(gain + c), sh = *(const f32x4*)(shift + c), sc = *(const f32x4*)(scale + c);
        const f32x4 y = (v[j] * rstd) * g;
        const f32x4 h = y * (1.0f + sc) + sh;
        u32x2 w; w.x = cvtpk(h[0], h[1]); w.y = cvtpk(h[2], h[3]);
        *(u32x2*)(orow + c) = w;
    }
}
DI void norm_phase(const float* srcL, const float* srcC, bool do_ctx, const float* gain, const float* mods, int si, bf16_t* H, int G) {
    const int tid = tid_(), lane = tid & 63, wave = tid >> 6;
    const int gw = blockIdx.x * 8 + wave, NGW = G * 8;
    const int nrows = do_ctx ? MT : ML;
    for (int r = gw; r < nrows; r += NGW) {
        const float* x; const float* md;
        if (r < ML) { x = srcL + (size_t)r * D; md = mods + (size_t)(r >> 11) * 6144; }
        else { x = srcC + (size_t)(r - ML) * D; md = mods + (size_t)8 * 6144; }
        norm_row(x, gain, md + si * 1024, md + (si + 1) * 1024, H + (size_t)r * D, lane);
    }
}

DI void attn_unit(LAS unsigned char* lds, const bf16_t* ZQ, const bf16_t* KB, const bf16_t* VT, bf16_t* ACT4, int b, int g, int qrow0, int key0, int nkt) {
    const int tid = tid_(), wave = tid >> 6, lane = tid & 63, r32 = lane & 31, h = lane >> 5;
    const int head = g * 4 + (wave >> 1);
    const int qrow = qrow0 + (wave & 1) * 32 + r32;
    constexpr int PITCH = 144, TB = 64 * PITCH;
    bf16x8 qf[4];
#pragma unroll
    for (int s = 0; s < 4; ++s) qf[s] = *(const bf16x8*)(ZQ + (size_t)qrow * 512 + head * 64 + 16 * s + 8 * h);
    f32x16 o0, o1;
#pragma unroll
    for (int i = 0; i < 16; ++i) { o0[i] = 0.f; o1[i] = 0.f; }
    float m_run = -1e30f, l_run = 0.f;
    const bf16_t* kbase = KB + ((size_t)(b * 2 + g) * SKV + key0) * 64;
    const bf16_t* vbase = VT + ((size_t)(b * 2 + g) * 64) * SKV + key0;
    const int srow = tid >> 3, sch = tid & 7;
    u32x4 kreg = *(const u32x4*)(kbase + (size_t)srow * 64 + sch * 8);
    u32x4 vreg = *(const u32x4*)(vbase + (size_t)srow * SKV + sch * 8);
    __syncthreads();
    *(LAS u32x4*)(lds + srow * PITCH + sch * 16) = kreg;
    *(LAS u32x4*)(lds + 2 * TB + srow * PITCH + sch * 16) = vreg;
    __syncthreads();
    for (int t = 0; t < nkt; ++t) {
        const int cur = t & 1;
        if (t + 1 < nkt) {
            kreg = *(const u32x4*)(kbase + ((size_t)(t + 1) * 64 + srow) * 64 + sch * 8);
            vreg = *(const u32x4*)(vbase + (size_t)srow * SKV + (t + 1) * 64 + sch * 8);
        }
        const LAS unsigned char* kl = lds + cur * TB;
        const LAS unsigned char* vl = lds + 2 * TB + cur * TB;
        f32x16 p0, p1;
#pragma unroll
        for (int i = 0; i < 16; ++i) { p0[i] = 0.f; p1[i] = 0.f; }
#pragma unroll
        for (int s = 0; s < 4; ++s) {
            const bf16x8 ka = *(const LAS bf16x8*)(kl + r32 * PITCH + (16 * s + 8 * h) * 2);
            const bf16x8 kb2 = *(const LAS bf16x8*)(kl + (32 + r32) * PITCH + (16 * s + 8 * h) * 2);
            p0 = __builtin_amdgcn_mfma_f32_32x32x16_bf16(ka, qf[s], p0, 0, 0, 0);
            p1 = __builtin_amdgcn_mfma_f32_32x32x16_bf16(kb2, qf[s], p1, 0, 0, 0);
        }
        float mx = p0[0];
#pragma unroll
        for (int i = 1; i < 16; ++i) mx = fmaxf(mx, p0[i]);
#pragma unroll
        for (int i = 0; i < 16; ++i) mx = fmaxf(mx, p1[i]);
        mx = fmaxf(mx, __shfl_xor(mx, 32));
        const float m_new = fmaxf(m_run, mx);
        const float alpha = __builtin_amdgcn_exp2f(m_run - m_new);
        m_run = m_new;
        float rs = 0.f;
#pragma unroll
        for (int i = 0; i < 16; ++i) { p0[i] = __builtin_amdgcn_exp2f(p0[i] - m_new); p1[i] = __builtin_amdgcn_exp2f(p1[i] - m_new); rs += p0[i] + p1[i]; }
        l_run = l_run * alpha + rs;
#pragma unroll
        for (int i = 0; i < 16; ++i) { o0[i] *= alpha; o1[i] *= alpha; }
#pragma unroll
        for (int kb = 0; kb < 2; ++kb)
#pragma unroll
            for (int s2 = 0; s2 < 2; ++s2) {
                u32x4 pw;
                if (kb == 0) { pw.x = cvtpk(p0[8 * s2 + 0], p0[8 * s2 + 1]); pw.y = cvtpk(p0[8 * s2 + 2], p0[8 * s2 + 3]); pw.z = cvtpk(p0[8 * s2 + 4], p0[8 * s2 + 5]); pw.w = cvtpk(p0[8 * s2 + 6], p0[8 * s2 + 7]); }
                else { pw.x = cvtpk(p1[8 * s2 + 0], p1[8 * s2 + 1]); pw.y = cvtpk(p1[8 * s2 + 2], p1[8 * s2 + 3]); pw.z = cvtpk(p1[8 * s2 + 4], p1[8 * s2 + 5]); pw.w = cvtpk(p1[8 * s2 + 6], p1[8 * s2 + 7]); }
                const bf16x8 pb = __builtin_bit_cast(bf16x8, pw);
                const int kk = 32 * kb + 16 * s2 + 4 * h;
                {
                    const u32x2 lo = *(const LAS u32x2*)(vl + r32 * PITCH + kk * 2), hi = *(const LAS u32x2*)(vl + r32 * PITCH + (kk + 8) * 2);
                    u32x4 vw; vw.x = lo.x; vw.y = lo.y; vw.z = hi.x; vw.w = hi.y;
                    o0 = __builtin_amdgcn_mfma_f32_32x32x16_bf16(__builtin_bit_cast(bf16x8, vw), pb, o0, 0, 0, 0);
                }
                {
                    const u32x2 lo = *(const LAS u32x2*)(vl + (32 + r32) * PITCH + kk * 2), hi = *(const LAS u32x2*)(vl + (32 + r32) * PITCH + (kk + 8) * 2);
                    u32x4 vw; vw.x = lo.x; vw.y = lo.y; vw.z = hi.x; vw.w = hi.y;
                    o1 = __builtin_amdgcn_mfma_f32_32x32x16_bf16(__builtin_bit_cast(bf16x8, vw), pb, o1, 0, 0, 0);
                }
            }
        if (t + 1 < nkt) {
            *(LAS u32x4*)(lds + (cur ^ 1) * TB + srow * PITCH + sch * 16) = kreg;
            *(LAS u32x4*)(lds + 2 * TB + (cur ^ 1) * TB + srow * PITCH + sch * 16) = vreg;
        }
        __syncthreads();
    }
    const float lt = l_run + __shfl_xor(l_run, 32);
    const float inv = 1.0f / lt;
    bf16_t* orow = ACT4 + (size_t)qrow * 1280 + head * 64;
#pragma unroll
    for (int g4 = 0; g4 < 4; ++g4) {
        u32x2 w; w.x = cvtpk(o0[4 * g4] * inv, o0[4 * g4 + 1] * inv); w.y = cvtpk(o0[4 * g4 + 2] * inv, o0[4 * g4 + 3] * inv);
        *(u32x2*)(orow + 8 * g4 + 4 * h) = w;
        u32x2 w2; w2.x = cvtpk(o1[4 * g4] * inv, o1[4 * g4 + 1] * inv); w2.y = cvtpk(o1[4 * g4 + 2] * inv, o1[4 * g4 + 3] * inv);
        *(u32x2*)(orow + 32 + 8 * g4 + 4 * h) = w2;
    }
}

DI void scpool_phase(const bf16_t* ZS, const bf16_t* ZP, bf16_t* ACT4, const float* convw, int nrows, int G) {
    const int tid = tid_(), lane = tid & 63, wave = tid >> 6;
    const int gw = blockIdx.x * 8 + wave, NGW = G * 8;
    for (int r = gw; r < nrows; r += NGW) {
        int t, N; if (r < ML) { t = r & 2047; N = SEQ; } else { t = (r - ML) & 255; N = CTXL; }
        if (lane < 32) {
            const int c = lane * 8;
            float a[8];
#pragma unroll
            for (int j = 0; j < 8; ++j) a[j] = 0.f;
#pragma unroll
            for (int dt = -1; dt <= 1; ++dt) {
                if (t + dt >= 0 && t + dt < N) {
                    const bf16_t* row = ZS + (size_t)(r + dt) * 768;
                    const u32x4 gc = *(const u32x4*)(row + 256 + c), xs = *(const u32x4*)(row + 512 + c);
                    const f32x4 w0 = *(const f32x4*)(convw + (dt + 1) * 256 + c), w1 = *(const f32x4*)(convw + (dt + 1) * 256 + c + 4);
                    a[0] += w0[0] * bflo(gc.x) * bflo(xs.x); a[1] += w0[1] * bfhi(gc.x) * bfhi(xs.x);
                    a[2] += w0[2] * bflo(gc.y) * bflo(xs.y); a[3] += w0[3] * bfhi(gc.y) * bfhi(xs.y);
                    a[4] += w1[0] * bflo(gc.z) * bflo(xs.z); a[5] += w1[1] * bfhi(gc.z) * bfhi(xs.z);
                    a[6] += w1[2] * bflo(gc.w) * bflo(xs.w); a[7] += w1[3] * bfhi(gc.w) * bfhi(xs.w);
                }
            }
            const u32x4 gb = *(const u32x4*)(ZS + (size_t)r * 768 + c);
            u32x4 w; w.x = cvtpk(bflo(gb.x) * a[0], bfhi(gb.x) * a[1]); w.y = cvtpk(bflo(gb.y) * a[2], bfhi(gb.y) * a[3]);
            w.z = cvtpk(bflo(gb.z) * a[4], bfhi(gb.z) * a[5]); w.w = cvtpk(bflo(gb.w) * a[6], bfhi(gb.w) * a[7]);
            *(u32x4*)(ACT4 + (size_t)r * 1280 + 512 + c) = w;
        } else {
            const int c = (lane - 32) * 8, gi = c >> 6, wdw = 2 << gi, left = (wdw - 1) >> 1, right = wdw >> 1;
            const int lo = (t - left) > 0 ? (t - left) : 0, hi = (t + right + 1) < N ? (t + right + 1) : N;
            float a[8];
#pragma unroll
            for (int j = 0; j < 8; ++j) a[j] = 0.f;
            u32x4 pv[16];
#pragma unroll
            for (int i = 0; i < 16; ++i) { int tt = lo + i; tt = tt < hi ? tt : (hi - 1); pv[i] = *(const u32x4*)(ZP + (size_t)(r - t + tt) * 256 + c); }
#pragma unroll
            for (int i = 0; i < 16; ++i) if (lo + i < hi) {
                const u32x4 v = pv[i];
                a[0] += bflo(v.x); a[1] += bfhi(v.x); a[2] += bflo(v.y); a[3] += bfhi(v.y); a[4] += bflo(v.z); a[5] += bfhi(v.z); a[6] += bflo(v.w); a[7] += bfhi(v.w);
            }
            const float ic = 1.0f / (float)(hi - lo);
            const u32x4 x = *(const u32x4*)(ZP + (size_t)r * 256 + c);
            u32x4 w; w.x = cvtpk(a[0] * ic - bflo(x.x), a[1] * ic - bfhi(x.x)); w.y = cvtpk(a[2] * ic - bflo(x.y), a[3] * ic - bfhi(x.y));
            w.z = cvtpk(a[4] * ic - bflo(x.z), a[5] * ic - bfhi(x.z)); w.w = cvtpk(a[6] * ic - bflo(x.w), a[7] * ic - bfhi(x.w));
            *(u32x4*)(ACT4 + (size_t)r * 1280 + 1024 + c) = w;
        }
    }
}

DI void fixup_phase(const bf16_t* RAW, bf16_t* ACT, const float* wconv, int nchunks, int G) {
    const int tid = tid_();
    for (int it = blockIdx.x; it < nchunks * 2; it += G) {
        const int ch = it >> 1, which = it & 1;
        const int r = ch * 64 + (which ? 63 : 0);
        int t, N; if (r < ML) { t = r & 2047; N = SEQ; } else { t = (r - ML) & 255; N = CTXL; }
        const bf16_t *up, *mid, *dn;
        if (!which) { up = (t > 0) ? RAW + ((size_t)(ch - 1) * 4 + 1) * UPW : nullptr; mid = RAW + ((size_t)ch * 4 + 2) * UPW; dn = RAW + ((size_t)ch * 4 + 3) * UPW; }
        else { up = RAW + ((size_t)ch * 4 + 0) * UPW; mid = RAW + ((size_t)ch * 4 + 1) * UPW; dn = (t < N - 1) ? RAW + ((size_t)(ch + 1) * 4 + 2) * UPW : nullptr; }
        for (int j = tid; j < DFF; j += 512) {
            const float ua = up ? bflo(up[j]) : 0.f, ub = up ? bflo(up[DFF + j]) : 0.f;
            const float ma = bflo(mid[j]), mb = bflo(mid[DFF + j]);
            const float da = dn ? bflo(dn[j]) : 0.f, db = dn ? bflo(dn[DFF + j]) : 0.f;
            const float ca = wconv[j] * ua + wconv[UPW + j] * ma + wconv[2 * UPW + j] * da;
            const float cb = wconv[DFF + j] * ub + wconv[UPW + DFF + j] * mb + wconv[2 * UPW + DFF + j] * db;
            ACT[(size_t)r * DFF + j] = (bf16_t)(cvtpk(ca * sigmoidf_(ca) * cb, 0.f) & 0xffff);
        }
    }
}

#define XB_TMO      128
#define XB_XCNT(j)  (256  + 64 * (j))
#define XB_XSUB(j)  (1280 + 64 * (j))
#define XB_XGEN(j)  (2304 + 64 * (j))
#define XB_TOP      3328
#define XB_TOPGEN   3392
#define XCD_BAR_WORDS 3456
#define XB_SPIN_CAP (1u << 22)
DI unsigned xb_ld(unsigned* p)              { return __hip_atomic_load(p, __ATOMIC_RELAXED, __HIP_MEMORY_SCOPE_AGENT); }
DI unsigned xb_add(unsigned* p, unsigned v) { return __hip_atomic_fetch_add(p, v, __ATOMIC_RELAXED, __HIP_MEMORY_SCOPE_AGENT); }
DI unsigned xb_xcc_id() { return (unsigned)__builtin_amdgcn_s_getreg((3 << 11) | 20) & 0xFu; }
#define XB_SPIN(cond, bar) do { unsigned _sp = 0; while (cond) { __builtin_amdgcn_s_sleep(1); \
    if ((++_sp & 255u) == 0u) { if (xb_ld(&(bar)[XB_TMO])) break; if (_sp > XB_SPIN_CAP) { atomicAdd(&(bar)[XB_TMO], 1u); break; } } } } while (0)
DI void xcd_barrier_complete(unsigned* bar, unsigned x, unsigned& nloc, unsigned& nx) {
    const unsigned G = gridDim.x * gridDim.y * gridDim.z;
    unsigned sum, cnt, mine, sp = 0u;
    for (;;) {
        sum = 0u; cnt = 0u; mine = 0u;
#pragma unroll
        for (unsigned j = 0; j < 16; ++j) { const unsigned c = xb_ld(&bar[XB_XCNT(j)]); sum += c; cnt += (c > 0u) ? 1u : 0u; mine = (j == x) ? c : mine; }
        if (sum == G) break;
        __builtin_amdgcn_s_sleep(1);
        if ((++sp & 255u) == 0u) { if (xb_ld(&bar[XB_TMO])) break; if (sp > XB_SPIN_CAP) { atomicAdd(&bar[XB_TMO], 1u); break; } }
    }
    nloc = mine > 0u ? mine : 1u; nx = cnt > 0u ? cnt : 1u;
}
DI void xb_post(unsigned* bar) { if (threadIdx.x == 0) (void)xb_add(&bar[XB_XCNT(xb_xcc_id())], 1u); }
DI void xcd_barrier(unsigned* bar, volatile LAS unsigned* st) {
    asm volatile("s_waitcnt vmcnt(0)" ::: "memory");
    __syncthreads();
    if (threadIdx.x == 0) {
        const unsigned x = xb_xcc_id();
        __builtin_amdgcn_s_waitcnt(0);
        unsigned nloc = st[0], nx = st[1];
        if (nloc == 0u) { xcd_barrier_complete(bar, x, nloc, nx); st[0] = nloc; st[1] = nx; }
        const unsigned old = xb_add(&bar[XB_XSUB(x)], 1u);
        const unsigned gen = old / nloc;
        if (old + 1u == (gen + 1u) * nloc) {
            __builtin_amdgcn_fence(__ATOMIC_RELEASE, "agent");
            asm volatile("s_waitcnt vmcnt(0)" ::: "memory");
            const unsigned og = xb_add(&bar[XB_TOP], 1u);
            const unsigned tg = og / nx;
            if (og + 1u == (tg + 1u) * nx) xb_add(&bar[XB_TOPGEN], 1u);
            else XB_SPIN(xb_ld(&bar[XB_TOPGEN]) == tg, bar);
            __builtin_amdgcn_fence(__ATOMIC_ACQUIRE, "agent");
            xb_add(&bar[XB_XGEN(x)], 1u);
            asm volatile("s_waitcnt vmcnt(0)" ::: "memory");
        } else {
            XB_SPIN(xb_ld(&bar[XB_XGEN(x)]) == gen, bar);
            __builtin_amdgcn_fence(__ATOMIC_ACQUIRE, "agent");
            asm volatile("s_waitcnt vmcnt(0)" ::: "memory");
        }
    }
    __syncthreads();
}

DI void ph0(LAS unsigned char* lds) {
    KP q = getp(); unsigned char* ws = q->ws;
    const int tid = tid_(), G = gridDim.x, cu = blockIdx.x, gt = cu * 512 + tid, NGT = G * 512;
    float* MODS = (float*)(ws + WS_MODS);
    float* ROPEC = (float*)(ws + WS_ROPE); float* ROPES = ROPEC + 2048 * 32;
    bf16_t* FML = (bf16_t*)(ws + WS_FML); bf16_t* FMC = (bf16_t*)(ws + WS_FMC);
    LAS float* sm = (LAS float*)lds;
    const float* cvec = q->in[1]; const float* cctx = q->in[3]; const float* w_mod = q->in[4]; const float* b_mod = q->in[5];
    for (int it = cu; it < 192; it += G) {
        const int l = it / 96, rem = it % 96, kc = rem / 12, cb = rem % 12;
        __syncthreads();
        for (int e = tid; e < 9 * 128; e += 512) { const int v = e >> 7, k = kc * 128 + (e & 127); const float cv = (v < 8) ? cvec[v * D + k] : cctx[k]; sm[e] = cv / (1.0f + __expf(-cv)); }
        __syncthreads();
        const int j = cb * 512 + tid;
        float a[9];
#pragma unroll
        for (int v = 0; v < 9; ++v) a[v] = 0.f;
        const float* wp = w_mod + ((size_t)l * D + kc * 128) * INW + j;
#pragma unroll 4
        for (int k = 0; k < 128; ++k) { const float w = wp[(size_t)k * INW];
#pragma unroll
            for (int v = 0; v < 9; ++v) a[v] += sm[v * 128 + k] * w; }
        const float bm = (kc == 0) ? b_mod[l * INW + j] : 0.f;
#pragma unroll
        for (int v = 0; v < 9; ++v) atomicAdd(&MODS[(size_t)(l * 9 + v) * INW + j], a[v] + bm);
    }
    for (int e = gt; e < 2048 * 32; e += NGT) {
        const int t = e >> 5, ax = (e >> 4) & 1, i = e & 15;
        const float pos = (float)(ax ? (t & 63) : (t >> 6));
        const float inv = powf(10000.0f, -(float)i * (1.0f / 16.0f));
        float sn, cs; sincosf(pos * inv, &sn, &cs);
        ROPEC[e] = cs; ROPES[e] = sn;
    }
    for (int e = gt; e < 2048 * 512; e += NGT) {
        const int k1 = e >> 9, c8 = e & 511, part = c8 >> 8, n0 = (c8 & 255) * 8;
        float v[8];
#pragma unroll
        for (int j = 0; j < 8; ++j) { const int mm = (k1 * (n0 + j)) & 2047; float sn, cs; sincospif((float)mm * (1.0f / 1024.0f), &sn, &cs); v[j] = (part ? -sn : cs) * 0.022097086912079608f; }
        u32x4 w; w.x = cvtpk(v[0], v[1]); w.y = cvtpk(v[2], v[3]); w.z = cvtpk(v[4], v[5]); w.w = cvtpk(v[6], v[7]);
        *(u32x4*)(FML + (size_t)k1 * 4096 + part * 2048 + n0) = w;
    }
    for (int e = gt; e < 256 * 64; e += NGT) {
        const int k1 = e >> 6, c8 = e & 63, part = c8 >> 5, n0 = (c8 & 31) * 8;
        float v[8];
#pragma unroll
        for (int j = 0; j < 8; ++j) { const int mm = (k1 * (n0 + j)) & 255; float sn, cs; sincospif((float)mm * (1.0f / 128.0f), &sn, &cs); v[j] = (part ? -sn : cs) * 0.0625f; }
        u32x4 w; w.x = cvtpk(v[0], v[1]); w.y = cvtpk(v[2], v[3]); w.z = cvtpk(v[4], v[5]); w.w = cvtpk(v[6], v[7]);
        *(u32x4*)(FMC + (size_t)k1 * 512 + part * 256 + n0) = w;
    }
}
DI void ph_norm(int l, int which, bool do_ctx) {
    KP q = getp(); unsigned char* ws = q->ws;
    const float* MODS = (const float*)(ws + WS_MODS);
    const float* srcL = (l == 0 && which == 0) ? q->in[0] : (const float*)q->out;
    const float* srcC = (l == 0 && which == 0) ? q->in[2] : (const float*)(ws + WS_CX);
    norm_phase(srcL, srcC, do_ctx, q->in[which ? 7 : 6] + l * D, MODS + (size_t)l * 9 * INW, which ? 3 : 0, (bf16_t*)(ws + WS_H), gridDim.x);
}
DI void ph2(int l, LAS unsigned char* lds) {
    KP q = getp(); unsigned char* ws = q->ws;
    const int G = gridDim.x, cu = blockIdx.x;
    pg8::Gemm g{(const bf16_t*)(ws + WS_H), (const bf16_t*)(ws + WS_WIN), 1024, 1024};
    pg8::Sched S;
    if (l == 0) S.init(72, 25, G, cu, 16);
    else { S.init(64, 25, G, cu, 16); S.nx = 8; S.xpm0 = 64; S.xpn = 2; }
    float* ROPEC = (float*)(ws + WS_ROPE);
    EpiZ E{(bf16_t*)(ws + WS_ZQ), (bf16_t*)(ws + WS_ZS), (bf16_t*)(ws + WS_ZP), (bf16_t*)(ws + WS_KB), (bf16_t*)(ws + WS_VT), (bf16_t*)(ws + WS_YTL), (bf16_t*)(ws + WS_YTC), ws + WS_G8,
           ROPEC, ROPEC + 2048 * 32, q->in[10] + l * 128, q->in[10] + l * 128 + 64};
    pg8::gemm_phase<EpiZ, true>(lds, g, S, E);
}
DI void ph3_dft(int l, LAS unsigned char* lds) {
    KP q = getp(); unsigned char* ws = q->ws;
    const int G = gridDim.x, cu = blockIdx.x;
    const int nsub = (l == 0) ? 2 : 1;
#pragma nounroll
    for (int j = 0; j < nsub; ++j) {
        pg8::Gemm g; pg8::Sched S; EpiDft E;
        if (j == 0) { g = pg8::Gemm{(const bf16_t*)(ws + WS_FML), (const bf16_t*)(ws + WS_YTL), 4096, 4096}; S.init(8, 8, G, cu, 64); E = EpiDft{(bf16_t*)(ws + WS_ACT4), 0, SEQ}; }
        else { g = pg8::Gemm{(const bf16_t*)(ws + WS_FMC), (const bf16_t*)(ws + WS_YTC), 512, 512}; S.init(1, 8, G, (cu + G - 64) % G, 8); E = EpiDft{(bf16_t*)(ws + WS_ACT4), ML, CTXL}; }
        pg8::gemm_phase<EpiDft, true>(lds, g, S, E);
    }
}
DI void ph3_attn(int l, LAS unsigned char* lds) {
    KP q = getp(); unsigned char* ws = q->ws;
    const int G = gridDim.x, cu = blockIdx.x;
    const bf16_t* ZQ = (const bf16_t*)(ws + WS_ZQ); const bf16_t* KB = (const bf16_t*)(ws + WS_KB); const bf16_t* VT = (const bf16_t*)(ws + WS_VT); bf16_t* ACT4 = (bf16_t*)(ws + WS_ACT4);
    int a0, step;
    if (G > 64) { if (cu < 64) { a0 = cu; step = 1 << 20; } else { a0 = cu; step = G - 64; } } else { a0 = cu; step = G; }
#pragma nounroll
    for (int a = a0; a < 512; a += step) attn_unit(lds, ZQ, KB, VT, ACT4, a >> 6, (a >> 5) & 1, (a >> 6) * SEQ + (a & 31) * 64, 0, 36);
    if (l == 0) {
#pragma nounroll
        for (int a = (cu + 64) % G; a < 64; a += G) attn_unit(lds, ZQ, KB, VT, ACT4, a >> 3, (a >> 2) & 1, ML + (a >> 3) * CTXL + (a & 3) * 64, SEQ, 4);
    }
}
DI void ph3_scpool(int l) {
    KP q = getp(); unsigned char* ws = q->ws;
    scpool_phase((const bf16_t*)(ws + WS_ZS), (const bf16_t*)(ws + WS_ZP), (bf16_t*)(ws + WS_ACT4), q->in[9] + l * 768, l == 0 ? MT : ML, gridDim.x);
}
DI void ph4(int l, LAS unsigned char* lds) {
    KP q = getp(); unsigned char* ws = q->ws;
    const int G = gridDim.x, cu = blockIdx.x;
    pg8::Gemm g{(const bf16_t*)(ws + WS_ACT4), (const bf16_t*)(ws + WS_WBR), 1280, 1280};
    pg8::Sched S; S.init(l == 0 ? 72 : 64, 4, G, cu, 8); S.sub = 4;
    EpiBr E{ws + WS_G8, (bf16_t*)(ws + WS_Y), ws + WS_PY + (size_t)cu * 131072};
    pg8::gemm_phase<EpiBr, true>(lds, g, S, E);
}
DI void ph_res(int l, int which, LAS unsigned char* lds) {
    KP q = getp(); unsigned char* ws = q->ws;
    const int G = gridDim.x, cu = blockIdx.x;
    const float* mods = (const float*)(ws + WS_MODS) + (size_t)l * 9 * INW;
    float* OUT = q->out; float* CX = (float*)(ws + WS_CX);
    pg8::Gemm g; pg8::Sched S; EpiRes E;
    if (which == 0) {
        g = pg8::Gemm{(const bf16_t*)(ws + WS_Y), (const bf16_t*)(ws + WS_WOUT), 1024, 1024}; S.init(l == 0 ? 72 : 64, 4, G, cu, 16);
        E = EpiRes{(l == 0) ? q->in[0] : (const float*)OUT, OUT, (l == 0) ? q->in[2] : (const float*)CX, CX, mods + 2 * 1024};
    } else {
        g = pg8::Gemm{(const bf16_t*)(ws + WS_ACT), (const bf16_t*)(ws + WS_WDN), DFF, DFF}; S.init(l == 0 ? 72 : 64, 4, G, cu, 44);
        E = EpiRes{OUT, OUT, CX, CX, mods + 5 * 1024};
    }
    pg8::gemm_phase<EpiRes, true>(lds, g, S, E);
}
DI void ph7(int l, LAS unsigned char* lds) {
    KP q = getp(); unsigned char* ws = q->ws;
    const int G = gridDim.x, cu = blockIdx.x;
    pg8::Gemm g{(const bf16_t*)(ws + WS_H), (const bf16_t*)(ws + WS_WUP), 1024, 1024};
    pg8::Sched S; S.init(l == 0 ? 72 : 64, 22, G, cu, 16);
    EpiUp E{(bf16_t*)(ws + WS_ACT), (bf16_t*)(ws + WS_RAW), q->in[19] + (size_t)l * 3 * UPW};
    pg8::gemm_phase<EpiUp, true>(lds, g, S, E);
}
DI void ph7b(int l) {
    KP q = getp(); unsigned char* ws = q->ws;
    fixup_phase((const bf16_t*)(ws + WS_RAW), (bf16_t*)(ws + WS_ACT), q->in[19] + (size_t)l * 3 * UPW, l == 0 ? 288 : 256, gridDim.x);
}
DI void ph_final() {
    KP q = getp();
    const int tid = tid_(), lane = tid & 63, gw = blockIdx.x * 8 + (tid >> 6), NGW = gridDim.x * 8;
    const float* fg = q->in[21]; float* OUT = q->out;
    for (int r = gw; r < ML; r += NGW) {
        f32x4* xr = (f32x4*)(OUT + (size_t)r * D) + lane;
        f32x4 v[4]; float s = 0.f;
#pragma unroll
        for (int j = 0; j < 4; ++j) { v[j] = xr[64 * j]; s += (v[j][0] * v[j][0] + v[j][1] * v[j][1]) + (v[j][2] * v[j][2] + v[j][3] * v[j][3]); }
        const float rstd = rsqrtf(wave_sum(s) * (1.0f / D) + EPS);
#pragma unroll
        for (int j = 0; j < 4; ++j) { const f32x4 gg = *(const f32x4*)(fg + 256 * j + 4 * lane); xr[64 * j] = (v[j] * rstd) * gg; }
    }
}

__global__ void __launch_bounds__(512, 2) mega(Params p) {
    extern __shared__ __attribute__((aligned(16))) unsigned char lds_raw[];
    LAS unsigned char* lds = (LAS unsigned char*)lds_raw;
    cg::grid_group grid = cg::this_grid();
    volatile LAS unsigned* xst = (volatile LAS unsigned*)(lds + 131072 + 64);
    if (threadIdx.x < 2) xst[threadIdx.x] = 0u;
    __syncthreads();
    { KP q = getp(); xb_post((unsigned*)(q->ws + WS_CTL)); }
#define GBAR() do { KP q_ = getp(); xcd_barrier((unsigned*)(q_->ws + WS_CTL), xst); } while (0)
    ph0(lds);
    grid.sync();
    ph_norm(0, 0, true);
    conv_mixer(0, lds, gridDim.x);
    GBAR();
#pragma nounroll
    for (int l = 0; l < 2; ++l) {
        ph2(l, lds);
        GBAR();
        ph3_dft(l, lds);
        ph3_attn(l, lds);
        ph3_scpool(l);
        GBAR();
        ph4(l, lds);
        GBAR();
        ph_res(l, 0, lds);
        GBAR();
        ph_norm(l, 1, l == 0);
        conv_ffn(l, lds, gridDim.x);
        if (l == 0) conv_mixer(1, lds, gridDim.x);
        GBAR();
        ph7(l, lds);
        GBAR();
        ph7b(l);
        GBAR();
        ph_res(l, 1, lds);
        GBAR();
        if (l == 0) { ph_norm(1, 0, true); GBAR(); }
        else ph_final();
    }
#undef GBAR
}

extern "C" void kernel_launch(void* const* d_in, const int* in_sizes, int n_in, void* d_out, int out_size, void* d_ws, size_t ws_size, hipStream_t stream) {
    static int grid_blocks = 0;
    if (grid_blocks == 0) {
        if (n_in != 22 || ws_size < WS_END) { fprintf(stderr, "kernel_launch: unexpected inputs (n_in %d, ws %zu)\n", n_in, ws_size); grid_blocks = -1; return; }
        int dev = 0, cus = 0, per_cu = 0;
        (void)hipGetDevice(&dev);
        (void)hipDeviceGetAttribute(&cus, hipDeviceAttributeMultiprocessorCount, dev);
        if (hipFuncSetAttribute((const void*)mega, hipFuncAttributeMaxDynamicSharedMemorySize, LDS_BYTES) != hipSuccess) { fprintf(stderr, "kernel_launch: hipFuncSetAttribute failed\n"); }
        if (hipOccupancyMaxActiveBlocksPerMultiprocessor(&per_cu, (const void*)mega, 512, LDS_BYTES) != hipSuccess || per_cu < 1) { fprintf(stderr, "kernel_launch: occupancy query gave %d\n", per_cu); per_cu = 1; }
        (void)hipGetLastError();
        grid_blocks = cus * 1;
        fprintf(stderr, "kernel_launch: cus %d per_cu %d grid %d ws %zu\n", cus, per_cu, grid_blocks, ws_size);
    }
    if (grid_blocks < 0) return;
    (void)hipMemsetAsync((char*)d_ws + WS_CTL, 0, WS_MODS + MODS_BYTES, stream);
    Params p{};
    for (int i = 0; i < 22; ++i) p.in[i] = (const float*)d_in[i];
    p.out = (float*)d_out; p.ws = (unsigned char*)d_ws;
    void* args[] = {&p};
    hipError_t e = hipLaunchCooperativeKernel((void*)mega, dim3(grid_blocks), dim3(512), args, LDS_BYTES, stream);
    if (e != hipSuccess) fprintf(stderr, "cooperative launch failed: %s (grid %d)\n", hipGetErrorString(e), grid_blocks);
}
```

```cpp
#include <hip/hip_runtime.h>
#include <hip/hip_cooperative_groups.h>
#include <cstdio>
#include <cstdint>
namespace cg = cooperative_groups;

#define LAS __attribute__((address_space(3)))
#define DI __device__ __forceinline__
typedef unsigned short bf16_t;
typedef short bf16x8 __attribute__((ext_vector_type(8)));
typedef short s16x4 __attribute__((ext_vector_type(4)));
typedef float f32x4 __attribute__((ext_vector_type(4)));
typedef float f32x2_t __attribute__((ext_vector_type(2)));
typedef float f32x16 __attribute__((ext_vector_type(16)));
typedef unsigned u32x4 __attribute__((ext_vector_type(4)));
typedef unsigned u32x2 __attribute__((ext_vector_type(2)));
typedef __bf16 bf16x2_t __attribute__((ext_vector_type(2)));

constexpr int D = 1024, SEQ = 2048, NB = 8, CTXL = 256;
constexpr int ML = NB * SEQ;
constexpr int MC = NB * CTXL;
constexpr int MT = ML + MC;
constexpr int INW = 6144, DFF = 2816, UPW = 5632;
constexpr int NZ = 6400;
constexpr int SKV = SEQ + CTXL;
constexpr float EPS = 1e-6f;

constexpr size_t MiB = 1u << 20;
constexpr size_t WS_CTL = 0;
constexpr size_t WS_MODS = 64 * 1024;
constexpr size_t MODS_BYTES = 2 * 9 * 6144 * 4;
constexpr size_t WS_ROPE = 1 * MiB;
constexpr size_t WS_CX = 2 * MiB;
constexpr size_t WS_FML = 10 * MiB;
constexpr size_t WS_FMC = 26 * MiB;
constexpr size_t WS_WIN = 27 * MiB;
constexpr size_t WS_WBR = WS_WIN + (size_t)NZ * 1024 * 2;
constexpr size_t WS_WOUT = 42 * MiB;
constexpr size_t WS_H = 44 * MiB;
constexpr size_t WS_ACT4 = 44 * MiB;
constexpr size_t WS_ZQ = 89 * MiB;
constexpr size_t WS_ZS = 107 * MiB;
constexpr size_t WS_ZP = 134 * MiB;
constexpr size_t WS_KB = 143 * MiB;
constexpr size_t WS_VT = WS_KB + (size_t)NB * 2 * SKV * 64 * 2;
constexpr size_t WS_YTL = 152 * MiB;
constexpr size_t WS_YTC = 168 * MiB;
constexpr size_t WS_G8 = 170 * MiB;
constexpr size_t WS_PY = 134 * MiB;
constexpr size_t WS_Y = 89 * MiB;
constexpr size_t WS_ACT = 89 * MiB;
constexpr size_t WS_WUP = 226 * MiB;
constexpr size_t WS_WDN = 237 * MiB;
constexpr size_t WS_RAW = 243 * MiB;
constexpr size_t WS_END = 256 * MiB;
static_assert(WS_WBR + 1024 * 1280 * 2 <= WS_WOUT && WS_VT + (size_t)NB * 2 * SKV * 64 * 2 <= WS_YTL, "ws map");
static_assert(WS_G8 + (size_t)MT * 4096 <= WS_WDN + 6 * MiB && WS_RAW + 288ull * 4 * UPW * 2 <= WS_END, "ws map");
static_assert(WS_ACT + (size_t)MT * DFF * 2 <= WS_WUP, "ws map");

constexpr int LDS_BYTES = 131072 + 4096;
#define REP_P2 1
#define REP_DFT 1
#define REP_ATTN 1
#define REP_SCP 1
#define REP_P4 1
#define REP_P7 1
#define REP_NORM 1

DI unsigned cvtpk(float lo, float hi) { f32x2_t v = {lo, hi}; bf16x2_t b = __builtin_convertvector(v, bf16x2_t); return __builtin_bit_cast(unsigned, b); }
DI float bflo(unsigned u) { return __uint_as_float(u << 16); }
DI float bfhi(unsigned u) { return __uint_as_float(u & 0xffff0000u); }
DI float wave_sum(float v) {
#pragma unroll
    for (int o = 1; o < 64; o <<= 1) v += __shfl_xor(v, o);
    return v;
}
DI int tid_() { int t; asm volatile("v_mov_b32 %0, %1" : "=v"(t) : "v"((int)threadIdx.x)); return t; }
DI float sigmoidf_(float v) { return 1.0f / (1.0f + __expf(-v)); }

struct Params { const float* in[22]; float* out; unsigned char* ws; };
typedef const __attribute__((address_space(4))) Params* KP;
DI KP getp() { KP q = (KP)__builtin_amdgcn_kernarg_segment_ptr(); asm volatile("" : "+s"(q)); return q; }

namespace pg8 {
constexpr int BM = 256, BK = 64, HALF = 128, HTB = HALF * BK * 2, STAGE_BYTES = 8 * HTB, NXCD = 8, WGM = 8;
DI int lds_byte(int r, int c) { const int st = (r >> 4) * 2 + (c >> 5), rr = r & 15, cc = c & 31, ob = rr * 64 + cc * 2; return st * 1024 + (ob ^ (((ob >> 9) & 1) << 5)); }
DI void stage_rc(int b, int& R, int& C) { const int st = b / 1024, sb = b % 1024, swz = sb ^ (((sb >> 9) & 1) << 5); R = (st >> 1) * 16 + swz / 64; C = (st & 1) * 32 + (swz % 64) / 2; }
DI int perm32(int rho) { const int n = rho >> 4, i = rho & 15; return 8 * (i >> 2) + 4 * n + (i & 3); }

struct Unit { int pm, pn, koff, nt, tag; };
struct Gemm { const bf16_t* A; const bf16_t* Bt; int lda, ldb; };

struct Sched {
    int nM, nN, nwg, G, c, nx, xpm0, xpn, sub, nt;
    DI void init(int nM_, int nN_, int G_, int c_, int nt_) { nM = nM_; nN = nN_; nwg = nM * nN; G = G_; c = c_; nx = 0; xpm0 = 0; xpn = 0; sub = 1; nt = nt_; }
    DI bool next(int i, Unit& u) const {
        int ti = i, s = 0;
        if (sub == 4) { ti = i >> 2; s = i & 3; }
        const long L = (long)ti * G + c;
        if (L < nwg) {
            int wgid = (int)L; { const int q = nwg / NXCD, r = nwg % NXCD, xcd = wgid % NXCD, off = wgid / NXCD; wgid = (xcd < r ? xcd * (q + 1) : r * (q + 1) + (xcd - r) * q) + off; }
            const int nig = WGM * nN, gid = wgid / nig, fm = gid * WGM, gsz = (nM - fm) < WGM ? (nM - fm) : WGM;
            u.pm = fm + ((wgid % nig) % gsz); u.pn = (wgid % nig) / gsz;
        } else if (L - nwg < nx) { u.pm = xpm0 + (int)(L - nwg); u.pn = xpn; }
        else return false;
        if (sub == 4) { u.tag = s; u.koff = (s == 0) ? 0 : 256 + 256 * s; u.nt = (s == 0) ? 8 : 4; }
        else { u.tag = 0; u.koff = 0; u.nt = nt; }
        return true;
    }
};

typedef f32x4 Acc[2][2][4][2];
DI void zero_acc(Acc& acc) {
#pragma unroll
    for (int a = 0; a < 2; ++a)
#pragma unroll
        for (int b = 0; b < 2; ++b)
#pragma unroll
            for (int m = 0; m < 4; ++m)
#pragma unroll
                for (int n = 0; n < 2; ++n) acc[a][b][m][n] = (f32x4){0.f, 0.f, 0.f, 0.f};
}

template <class Epi, bool ALIGN_EPI>
DI void gemm_phase(LAS unsigned char* lds, const Gemm g, const Sched& S, const Epi& E) {
    int tid; asm volatile("v_mov_b32 %0, %1" : "=v"(tid) : "v"((int)threadIdx.x));
    const int wid = __builtin_amdgcn_readfirstlane(tid >> 6), lane = tid & 63, wr = wid >> 2, wc = wid & 3, fr = lane & 15, fq = lane >> 4;
    unsigned voffA[2], voffB[2];
#pragma unroll
    for (int i = 0; i < 2; ++i) { int R, C; stage_rc(tid * 16 + i * 8192, R, C); const int Rb = Epi::PERM ? ((R & ~31) + perm32(R & 31)) : R;
        voffA[i] = (unsigned)(R * g.lda + C) * 2u; voffB[i] = (unsigned)(Rb * g.ldb + C) * 2u; }
    const size_t kstep = (size_t)(BK * 2);
    const size_t hstepA = (size_t)HALF * g.lda * 2, hstepB = (size_t)HALF * g.ldb * 2;
    const size_t tstepA = 2 * hstepA, tstepB = 2 * hstepB;
    const unsigned ldsw = (unsigned)wid * 1024u;
    const int aoff = lds_byte(wr * 64 + fr, fq * 8), boff = lds_byte(wc * 32 + fr, fq * 8);
#define PG8_SA(b, h) (((b) * 2 + (h)) * HTB)
#define PG8_SB(b, h) ((4 + (b) * 2 + (h)) * HTB)
#define PG8_STAGE(bufoff, gbase, voff) do { _Pragma("unroll") for (int _i = 0; _i < 2; ++_i) \
        __builtin_amdgcn_global_load_lds((const unsigned*)((const char*)(gbase) + (voff)[_i]), (LAS unsigned*)(lds + (bufoff) + ldsw + _i * 8192), 16, 0, 0); } while (0)
#define PG8_LDA(dst, b, h) do { _Pragma("unroll") for (int m = 0; m < 4; ++m) _Pragma("unroll") for (int k = 0; k < 2; ++k) dst[m][k] = *(const LAS bf16x8*)(lds + PG8_SA(b, h) + aoff + m * 2048 + k * 1024); } while (0)
#define PG8_LDB(dst, b, h) do { _Pragma("unroll") for (int n = 0; n < 2; ++n) _Pragma("unroll") for (int k = 0; k < 2; ++k) dst[n][k] = *(const LAS bf16x8*)(lds + PG8_SB(b, h) + boff + n * 2048 + k * 1024); } while (0)
#define PG8_MMA(ai, bj, At, Bt) do { __builtin_amdgcn_s_setprio(1); _Pragma("unroll") for (int m = 0; m < 4; ++m) _Pragma("unroll") for (int n = 0; n < 2; ++n) _Pragma("unroll") for (int k = 0; k < 2; ++k) \
        acc[ai][bj][m][n] = __builtin_amdgcn_mfma_f32_16x16x32_bf16(Bt[n][k], At[m][k], acc[ai][bj][m][n], 0, 0, 0); __builtin_amdgcn_s_setprio(0); } while (0)
#define PG8_WAIT_V(n) asm volatile("s_waitcnt vmcnt(" #n ")" ::: "memory")
#define PG8_WAIT_L(n) asm volatile("s_waitcnt lgkmcnt(" #n ")" ::: "memory")
#define PG8_BAR __builtin_amdgcn_s_barrier()
#define PG8_SCHED __builtin_amdgcn_sched_barrier(0)
    Unit cur, nxt; int ui = 0;
    if (!S.next(0, cur)) return;
    Acc acc;
    { int l2; asm volatile("v_mov_b32 %0, %1" : "=v"(l2) : "v"(lane)); E.init(acc, cur, wr, wc, l2 & 15, l2 >> 4); }
    PG8_WAIT_V(0);
    bf16x8 At[4][2], B0[2][2], B1[2][2];
    const char* cA = (const char*)g.A + (size_t)cur.pm * tstepA + (size_t)cur.koff * 2; const char* cB = (const char*)g.Bt + (size_t)cur.pn * tstepB + (size_t)cur.koff * 2;
    PG8_STAGE(PG8_SB(0, 0), cB, voffB); PG8_STAGE(PG8_SB(0, 1), cB + hstepB, voffB); PG8_STAGE(PG8_SA(0, 0), cA, voffA); PG8_STAGE(PG8_SA(0, 1), cA + hstepA, voffA);
    if (wr == 1) PG8_BAR;
    PG8_WAIT_V(2); PG8_BAR;
    PG8_STAGE(PG8_SB(1, 0), cB + kstep, voffB); PG8_STAGE(PG8_SA(1, 0), cA + kstep, voffA); PG8_STAGE(PG8_SB(1, 1), cB + hstepB + kstep, voffB);
    PG8_WAIT_V(6); PG8_BAR;
    for (;;) {
        const bool has_next = S.next(ui + 1, nxt);
        const char* nA = has_next ? (const char*)g.A + (size_t)nxt.pm * tstepA + (size_t)nxt.koff * 2 : cA;
        const char* nB = has_next ? (const char*)g.Bt + (size_t)nxt.pn * tstepB + (size_t)nxt.koff * 2 : cB;
        const int nt = cur.nt;
        for (int t = 0; t < nt; t += 2) {
            const bool last = (t == nt - 2);
            const char* a1 = cA + (size_t)(t + 1) * kstep;
            const char* a2 = last ? nA : cA + (size_t)(t + 2) * kstep; const char* b2 = last ? nB : cB + (size_t)(t + 2) * kstep;
            const char* a3 = a2 + kstep; const char* b3 = b2 + kstep;
            PG8_LDB(B0, 0, 0); PG8_LDB(B1, 0, 1); PG8_SCHED; PG8_LDA(At, 0, 0); PG8_STAGE(PG8_SA(1, 1), a1 + hstepA, voffA);
            PG8_WAIT_V(8); PG8_WAIT_L(0); PG8_BAR; PG8_MMA(0, 0, At, B0); PG8_MMA(0, 1, At, B1); PG8_BAR; PG8_SCHED;
            PG8_LDA(At, 0, 1); PG8_STAGE(PG8_SB(0, 0), b2, voffB); PG8_STAGE(PG8_SB(0, 1), b2 + hstepB, voffB); PG8_STAGE(PG8_SA(0, 0), a2, voffA);
            PG8_WAIT_V(8); PG8_WAIT_L(0); PG8_BAR; PG8_MMA(1, 0, At, B0); PG8_MMA(1, 1, At, B1); PG8_BAR; PG8_SCHED;
            PG8_LDB(B0, 1, 0); PG8_LDB(B1, 1, 1); PG8_SCHED; PG8_LDA(At, 1, 0); PG8_STAGE(PG8_SA(0, 1), a2 + hstepA, voffA);
            PG8_WAIT_V(8); PG8_WAIT_L(0); PG8_BAR; PG8_MMA(0, 0, At, B0); PG8_MMA(0, 1, At, B1); PG8_BAR; PG8_SCHED;
            PG8_LDA(At, 1, 1); PG8_STAGE(PG8_SB(1, 0), b3, voffB); PG8_STAGE(PG8_SB(1, 1), b3 + hstepB, voffB); PG8_STAGE(PG8_SA(1, 0), a3, voffA);
            PG8_WAIT_V(8); PG8_WAIT_L(0); PG8_BAR; PG8_MMA(1, 0, At, B0); PG8_MMA(1, 1, At, B1); PG8_BAR; PG8_SCHED;
        }
        if constexpr (ALIGN_EPI) { if (wr == 0) PG8_BAR; }
        int l2; asm volatile("v_mov_b32 %0, %1" : "=v"(l2) : "v"(lane));
        E(acc, cur, wr, wc, l2 & 15, l2 >> 4);
        if (!has_next) break;
        E.init(acc, nxt, wr, wc, l2 & 15, l2 >> 4);
        PG8_WAIT_V(0);
        cur = nxt; cA = nA; cB = nB; ++ui;
        if constexpr (ALIGN_EPI) { if (wr == 1) PG8_BAR; }
    }
    PG8_WAIT_V(0);
    if constexpr (!ALIGN_EPI) { if (wr == 0) PG8_BAR; }
    PG8_BAR;
#undef PG8_SA
#undef PG8_SB
#undef PG8_STAGE
#undef PG8_LDA
#undef PG8_LDB
#undef PG8_MMA
#undef PG8_WAIT_V
#undef PG8_WAIT_L
#undef PG8_BAR
#undef PG8_SCHED
}
}
using pg8::Acc; using pg8::Unit;

struct EpiZ {
    static constexpr bool PERM = false;
    bf16_t *ZQ, *ZS, *ZP, *KB, *VT, *YTL, *YTC; unsigned char* G8;
    const float *ropec, *ropes, *qg, *kg;
    DI void init(Acc& acc, const Unit&, int, int, int, int) const { pg8::zero_acc(acc); }
    DI void operator()(Acc& acc, const Unit& u, int wr, int wc, int fr, int fq) const {
        const bool isctx = u.pm >= 64;
        const int pn = u.pn;
        if (pn <= 2) {
            if (pn == 2 && wc >= 2) {
                const int g = wc - 2;
#pragma unroll
                for (int ai = 0; ai < 2; ++ai)
#pragma unroll
                    for (int m = 0; m < 4; ++m) {
                        const int r = u.pm * 256 + ai * 128 + wr * 64 + m * 16 + fr;
                        int b, pos; if (!isctx) { b = r >> 11; pos = r & 2047; } else { const int rc = r - ML; b = rc >> 8; pos = SEQ + (rc & 255); }
                        bf16_t* vb = VT + ((size_t)(b * 2 + g) * 64) * SKV + pos;
#pragma unroll
                        for (int bj = 0; bj < 2; ++bj)
#pragma unroll
                            for (int n = 0; n < 2; ++n) {
                                const f32x4 v = acc[ai][bj][m][n];
                                const unsigned p0 = cvtpk(v[0], v[1]), p1 = cvtpk(v[2], v[3]);
                                const int e = 32 * bj + 16 * n + 4 * fq;
                                vb[(size_t)(e + 0) * SKV] = (bf16_t)(p0 & 0xffff); vb[(size_t)(e + 1) * SKV] = (bf16_t)(p0 >> 16);
                                vb[(size_t)(e + 2) * SKV] = (bf16_t)(p1 & 0xffff); vb[(size_t)(e + 3) * SKV] = (bf16_t)(p1 >> 16);
                            }
                    }
                return;
            }
            const bool isq = pn < 2;
            const float* gain = isq ? qg : kg;
            const float osc = isq ? (0.125f * 1.4426950408889634f) : 1.0f;
#pragma unroll
            for (int ai = 0; ai < 2; ++ai)
#pragma unroll
                for (int m = 0; m < 4; ++m) {
                    const int r = u.pm * 256 + ai * 128 + wr * 64 + m * 16 + fr;
                    float ss = 0.f;
#pragma unroll
                    for (int bj = 0; bj < 2; ++bj)
#pragma unroll
                        for (int n = 0; n < 2; ++n) { const f32x4 v = acc[ai][bj][m][n]; ss += (v[0] * v[0] + v[1] * v[1]) + (v[2] * v[2] + v[3] * v[3]); }
                    ss += __shfl_xor(ss, 16); ss += __shfl_xor(ss, 32);
                    const float rinv = rsqrtf(ss * (1.0f / 64.0f) + EPS) * osc;
                    int b, pos, t = 0; if (!isctx) { b = r >> 11; pos = r & 2047; t = pos; } else { const int rc = r - ML; b = rc >> 8; pos = SEQ + (rc & 255); }
                    bf16_t* dst;
                    if (isq) dst = ZQ + (size_t)r * 512 + (pn * 4 + wc) * 64;
                    else dst = KB + ((size_t)(b * 2 + wc) * SKV + pos) * 64;
#pragma unroll
                    for (int bj = 0; bj < 2; ++bj) {
                        const f32x4 g0 = *(const f32x4*)(gain + 32 * bj + 4 * fq), g1 = *(const f32x4*)(gain + 32 * bj + 16 + 4 * fq);
                        f32x4 x0 = acc[ai][bj][m][0] * rinv * g0, x1 = acc[ai][bj][m][1] * rinv * g1;
                        if (!isctx) {
                            const f32x4 cs = *(const f32x4*)(ropec + (t * 2 + bj) * 16 + 4 * fq), sn = *(const f32x4*)(ropes + (t * 2 + bj) * 16 + 4 * fq);
                            const f32x4 o0 = x0 * cs - x1 * sn, o1 = x1 * cs + x0 * sn; x0 = o0; x1 = o1;
                        }
                        u32x2 w0, w1; w0.x = cvtpk(x0[0], x0[1]); w0.y = cvtpk(x0[2], x0[3]); w1.x = cvtpk(x1[0], x1[1]); w1.y = cvtpk(x1[2], x1[3]);
                        *(u32x2*)(dst + 32 * bj + 4 * fq) = w0; *(u32x2*)(dst + 32 * bj + 16 + 4 * fq) = w1;
                    }
                }
            return;
        }
#pragma unroll
        for (int ai = 0; ai < 2; ++ai)
#pragma unroll
            for (int m = 0; m < 4; ++m) {
                const int r = u.pm * 256 + ai * 128 + wr * 64 + m * 16 + fr;
                int b, t; if (!isctx) { b = r >> 11; t = r & 2047; } else { const int rc = r - ML; b = rc >> 8; t = rc & 255; }
#pragma unroll
                for (int bj = 0; bj < 2; ++bj)
#pragma unroll
                    for (int n = 0; n < 2; ++n) {
                        const f32x4 v = acc[ai][bj][m][n];
                        const int c = 128 * bj + 32 * wc + 16 * n + 4 * fq;
                        if (pn >= 9) {
                            unsigned w = 0;
#pragma unroll
                            for (int x = 0; x < 4; ++x) { const float s = sigmoidf_(v[x]); int q = (int)(s * 256.0f); q = q > 255 ? 255 : (q < 0 ? 0 : q); w |= (unsigned)q << (8 * x); }
                            *(unsigned*)(G8 + (size_t)r * 4096 + (pn - 9) * 256 + c) = w;
                        } else if (pn <= 5) {
                            u32x2 w; w.x = cvtpk(v[0], v[1]); w.y = cvtpk(v[2], v[3]);
                            *(u32x2*)(ZS + (size_t)r * 768 + (pn - 3) * 256 + c) = w;
                        } else if (pn == 8) {
                            u32x2 w; w.x = cvtpk(v[0], v[1]); w.y = cvtpk(v[2], v[3]);
                            *(u32x2*)(ZP + (size_t)r * 256 + c) = w;
                        } else {
                            const int cs = pn - 6;
                            const unsigned p0 = cvtpk(v[0], v[1]), p1 = cvtpk(v[2], v[3]);
                            bf16_t* y; size_t st;
                            if (!isctx) { y = YTL + ((size_t)(b * 256 + c) * 4096) + cs * 2048 + t; st = 4096; }
                            else { y = YTC + ((size_t)(b * 256 + c) * 512) + cs * 256 + t; st = 512; }
                            y[0] = (bf16_t)(p0 & 0xffff); y[st] = (bf16_t)(p0 >> 16); y[2 * st] = (bf16_t)(p1 & 0xffff); y[3 * st] = (bf16_t)(p1 >> 16);
                        }
                    }
            }
    }
};

struct EpiDft {
    static constexpr bool PERM = true;
    bf16_t* ACT4; int rowbase, nrows;
    DI void init(Acc& acc, const Unit&, int, int, int, int) const { pg8::zero_acc(acc); }
    DI void operator()(Acc& acc, const Unit& u, int wr, int wc, int fr, int fq) const {
#pragma unroll
        for (int ai = 0; ai < 2; ++ai)
#pragma unroll
            for (int m = 0; m < 4; ++m) {
                const int r = rowbase + u.pn * nrows + u.pm * 256 + ai * 128 + wr * 64 + m * 16 + fr;
#pragma unroll
                for (int bj = 0; bj < 2; ++bj) {
                    const f32x4 v0 = acc[ai][bj][m][0], v1 = acc[ai][bj][m][1];
                    u32x4 w; w.x = cvtpk(v0[0], v0[1]); w.y = cvtpk(v0[2], v0[3]); w.z = cvtpk(v1[0], v1[1]); w.w = cvtpk(v1[2], v1[3]);
                    *(u32x4*)(ACT4 + (size_t)r * 1280 + 768 + 128 * bj + 32 * wc + 8 * fq) = w;
                }
            }
    }
};

struct EpiBr {
    static constexpr bool PERM = true;
    const unsigned char* G8; bf16_t* Y; unsigned char* PY;
    DI void init(Acc& acc, const Unit&, int, int, int, int) const { pg8::zero_acc(acc); }
    DI void operator()(Acc& acc, const Unit& u, int wr, int wc, int fr, int fq) const {
        const unsigned char* ub = G8 + ((size_t)u.pm * 256 + wr * 64) * 4096 + u.tag * 1024 + u.pn * 256 + 32 * wc;
        const unsigned lo = (unsigned)(fr * 4096 + 8 * fq);
        unsigned char* pyb = PY + (size_t)((wr * 4 + wc) * 64 + fr + 16 * fq) * 16;
        bf16_t* yb = Y + ((size_t)u.pm * 256 + wr * 64) * 1024 + u.pn * 256 + 32 * wc;
        const unsigned yo = (unsigned)(fr * 1024 + 8 * fq);
#pragma unroll
        for (int ai = 0; ai < 2; ++ai) {
            u32x2 gw[4][2];
#pragma unroll
            for (int m = 0; m < 4; ++m)
#pragma unroll
                for (int bj = 0; bj < 2; ++bj) gw[m][bj] = *(const u32x2*)(ub + ((ai * 128 + m * 16) * 4096 + bj * 128) + lo);
#pragma unroll
            for (int m = 0; m < 4; ++m)
#pragma unroll
                for (int bj = 0; bj < 2; ++bj) {
                    f32x4 v[2];
#pragma unroll
                    for (int n = 0; n < 2; ++n) { const unsigned w = n ? gw[m][bj].y : gw[m][bj].x;
#pragma unroll
                        for (int x = 0; x < 4; ++x) { const float gq = ((float)((w >> (8 * x)) & 255u) + 0.5f) * (1.0f / 256.0f); v[n][x] = acc[ai][bj][m][n][x] * gq; } }
                    unsigned char* pp = pyb + (size_t)(((ai * 4 + m) * 2 + bj) * 512) * 16;
                    if (u.tag != 0) {
                        const u32x4 pv = *(const u32x4*)pp;
                        v[0][0] += bflo(pv.x); v[0][1] += bfhi(pv.x); v[0][2] += bflo(pv.y); v[0][3] += bfhi(pv.y);
                        v[1][0] += bflo(pv.z); v[1][1] += bfhi(pv.z); v[1][2] += bflo(pv.w); v[1][3] += bfhi(pv.w);
                    }
                    u32x4 w; w.x = cvtpk(v[0][0], v[0][1]); w.y = cvtpk(v[0][2], v[0][3]); w.z = cvtpk(v[1][0], v[1][1]); w.w = cvtpk(v[1][2], v[1][3]);
                    if (u.tag != 3) *(u32x4*)pp = w;
                    else *(u32x4*)(yb + ((ai * 128 + m * 16) * 1024 + bj * 128) + yo) = w;
                }
        }
    }
};

struct EpiRes {
    static constexpr bool PERM = false;
    const float* srcL; float* dstL; const float* srcC; float* dstC; const float* gates;
    DI void init(Acc& acc, const Unit&, int, int, int, int) const { pg8::zero_acc(acc); }
    DI void operator()(Acc& acc, const Unit& u, int wr, int wc, int fr, int fq) const {
        const bool isctx = u.pm >= 64;
        const size_t rb = isctx ? ((size_t)(u.pm - 64) * 256 + wr * 64) : ((size_t)u.pm * 256 + wr * 64);
        const float* sb = (isctx ? srcC : srcL) + rb * D + u.pn * 256 + 32 * wc;
        float* db = (isctx ? dstC : dstL) + rb * D + u.pn * 256 + 32 * wc;
        const float* gb = gates + (size_t)(isctx ? 8 : (u.pm >> 3)) * 6144 + u.pn * 256 + 32 * wc;
        const unsigned lo = (unsigned)(fr * D + 4 * fq), go = (unsigned)(4 * fq);
#pragma unroll
        for (int ai = 0; ai < 2; ++ai)
#pragma unroll
            for (int m = 0; m < 4; ++m) {
#pragma unroll
                for (int bj = 0; bj < 2; ++bj)
#pragma unroll
                    for (int n = 0; n < 2; ++n) {
                        const int co = (ai * 128 + m * 16) * D + bj * 128 + n * 16;
                        const f32x4 s = *(const f32x4*)(sb + co + lo), gg = *(const f32x4*)(gb + (bj * 128 + n * 16) + go);
                        *(f32x4*)(db + co + lo) = s + gg * acc[ai][bj][m][n];
                    }
                if (m == 3) asm volatile("" ::: "memory");
            }
    }
};

struct EpiUp {
    static constexpr bool PERM = true;
    bf16_t* ACT; bf16_t* RAW; const float* wconv;
    DI void init(Acc& acc, const Unit&, int, int, int, int) const { pg8::zero_acc(acc); }
    DI void operator()(Acc& acc, const Unit& u, int wr, int wc, int fr, int fq) const {
        const int lane = fr + 16 * fq;
        const int srcR = (lane & 48) | ((fr + 15) & 15), srcLn = (lane & 48) | ((fr + 1) & 15);
        const int jl = 32 * wc + 8 * fq;
        const int ja = u.pn * 128 + jl;
        bf16_t* ab = ACT + ((size_t)u.pm * 256 + wr * 64) * DFF + u.pn * 128 + 32 * wc;
        const unsigned alo = (unsigned)(fr * DFF + 8 * fq);
#pragma unroll
        for (int ai = 0; ai < 2; ++ai) {
            const int rbase = u.pm * 256 + ai * 128 + wr * 64;
#pragma unroll
            for (int m = 0; m < 4; m += 3) {
                const bool dump = (m == 0) ? (fr < 2) : (fr >= 14);
                if (dump) {
                    const int slot = (m == 0) ? (2 + fr) : (fr - 14);
                    bf16_t* rw = RAW + ((size_t)(rbase >> 6) * 4 + slot) * UPW;
#pragma unroll
                    for (int bj = 0; bj < 2; ++bj) {
                        const f32x4 v0 = acc[ai][bj][m][0], v1 = acc[ai][bj][m][1];
                        u32x4 w; w.x = cvtpk(v0[0], v0[1]); w.y = cvtpk(v0[2], v0[3]); w.z = cvtpk(v1[0], v1[1]); w.w = cvtpk(v1[2], v1[3]);
                        *(u32x4*)(rw + bj * DFF + ja) = w;
                    }
                }
            }
#pragma unroll
            for (int n = 0; n < 2; ++n) {
#pragma unroll
                for (int xp = 0; xp < 2; ++xp) {
                    float act[4][2];
#pragma unroll
                    for (int xx = 0; xx < 2; ++xx) {
                        const int x = 2 * xp + xx;
                        float ca[4], cb[4];
#pragma unroll
                        for (int bj = 0; bj < 2; ++bj) {
                            const float* wp = wconv + bj * DFF + ja + 4 * n + x;
                            const float w0 = wp[0], w1 = wp[UPW], w2 = wp[2 * UPW];
                            float R[4], L[4];
#pragma unroll
                            for (int m = 0; m < 4; ++m) { const float v = acc[ai][bj][m][n][x]; R[m] = __shfl(v, srcR); L[m] = __shfl(v, srcLn); }
#pragma unroll
                            for (int m = 0; m < 4; ++m) {
                                const float up = (fr > 0) ? R[m] : (m > 0 ? R[m > 0 ? m - 1 : 0] : 0.f);
                                const float dn = (fr < 15) ? L[m] : (m < 3 ? L[m < 3 ? m + 1 : 3] : 0.f);
                                const float cv = w0 * up + w1 * acc[ai][bj][m][n][x] + w2 * dn;
                                if (bj == 0) ca[m] = cv; else cb[m] = cv;
                            }
                        }
#pragma unroll
                        for (int m = 0; m < 4; ++m) act[m][xx] = ca[m] * sigmoidf_(ca[m]) * cb[m];
                    }
#pragma unroll
                    for (int m = 0; m < 4; ++m) {
                        const bool skip = (m == 0 && fr == 0) || (m == 3 && fr == 15);
                        if (!skip) *(unsigned*)(ab + ((ai * 128 + m * 16) * DFF + 4 * n + 2 * xp) + alo) = cvtpk(act[m][0], act[m][1]);
                    }
                    asm volatile("" ::: "memory");
                }
            }
        }
    }
};

DI void transpose_item(const float* W, int ldn, int k0, int n0, bf16_t* WT, int drow0, int ldd, int koff, LAS float* scr, int lane) {
#pragma unroll 8
    for (int i = 0; i < 32; ++i) { const int kk = 2 * i + (lane >> 5); scr[kk * 33 + (lane & 31)] = W[(size_t)(k0 + kk) * ldn + n0 + (lane & 31)]; }
    asm volatile("s_waitcnt lgkmcnt(0)" ::: "memory");
    const int c = lane & 7;
#pragma unroll
    for (int j = 0; j < 4; ++j) { const int n = (lane >> 3) + 8 * j; const LAS float* s = scr + (8 * c) * 33 + n;
        u32x4 o; o.x = cvtpk(s[0 * 33], s[1 * 33]); o.y = cvtpk(s[2 * 33], s[3 * 33]); o.z = cvtpk(s[4 * 33], s[5 * 33]); o.w = cvtpk(s[6 * 33], s[7 * 33]);
        *(u32x4*)(WT + (size_t)(drow0 + n) * ldd + koff + k0 + 8 * c) = o; }
    asm volatile("s_waitcnt lgkmcnt(0)" ::: "memory");
}
DI int win_dest(int n0) {
    if (n0 < 768) { const int tile = n0 >> 8, within = n0 & 255, hd = within >> 6, e = within & 63; return tile * 256 + 128 * (e >> 5) + 32 * hd + (e & 31); }
    if (n0 < 1536) return n0;
    if (n0 < 1792) return -1;
    return n0 + 256;
}
DI int wup_dest(int n0) { if (n0 < DFF) return 256 * (n0 >> 7) + (n0 & 127); const int j = n0 - DFF; return 256 * (j >> 7) + 128 + (j & 127); }

DI void conv_mixer(int l, LAS unsigned char* lds, int G) {
    KP q = getp(); unsigned char* ws = q->ws;
    const int tid = tid_(), lane = tid & 63, wave = tid >> 6;
    const int gw = blockIdx.x * 8 + wave, NGW = G * 8;
    LAS float* scr = (LAS float*)(lds + wave * 8448);
    bf16_t* WinT = (bf16_t*)(ws + WS_WIN); bf16_t* WbrT = (bf16_t*)(ws + WS_WBR); bf16_t* WoutT = (bf16_t*)(ws + WS_WOUT);
    const float* w_in = q->in[8] + (size_t)l * D * INW;
    constexpr int I_IN = 16 * 192, I_BA = 8 * 32, I_BS = 4 * 32, I_O = 16 * 32;
    constexpr int NIT = I_IN + I_BA + 2 * I_BS + I_O;
    for (int it = gw; it < NIT; it += NGW) {
        int r = it;
        if (r < I_IN) { const int kb = r / 192, nb = r % 192, n0 = nb * 32, d = win_dest(n0); if (d >= 0) transpose_item(w_in, INW, kb * 64, n0, WinT, d, 1024, 0, scr, lane); continue; } r -= I_IN;
        if (r < I_BA) { const int kb = r / 32, nb = r % 32; transpose_item(q->in[13] + (size_t)l * 512 * D, D, kb * 64, nb * 32, WbrT, nb * 32, 1280, 0, scr, lane); continue; } r -= I_BA;
        if (r < I_BS) { const int kb = r / 32, nb = r % 32; transpose_item(q->in[14] + (size_t)l * 256 * D, D, kb * 64, nb * 32, WbrT, nb * 32, 1280, 512, scr, lane); continue; } r -= I_BS;
        if (r < I_BS) { const int kb = r / 32, nb = r % 32; transpose_item(q->in[15] + (size_t)l * 256 * D, D, kb * 64, nb * 32, WbrT, nb * 32, 1280, 768, scr, lane); continue; } r -= I_BS;
        { const int kb = r / 32, nb = r % 32; transpose_item(q->in[17] + (size_t)l * D * D, D, kb * 64, nb * 32, WoutT, nb * 32, 1024, 0, scr, lane); }
    }
    __syncthreads();
    LAS float* tab = (LAS float*)(lds + 8 * 8448);
    if (tid < 64) { float s, c; sincospif((float)tid * (1.0f / 32.0f), &s, &c); tab[tid] = c; tab[64 + tid] = s; }
    __syncthreads();
    const int gt = blockIdx.x * 512 + tid, NGT = G * 512;
    for (int e = gt; e < 512 * 1024; e += NGT) {
        const int k = e & 1023, nrow = e >> 10, cs = nrow >> 8, g = (nrow >> 6) & 3, k2 = nrow & 63;
        const float* src = w_in + (size_t)k * INW + 1536 + g * 64;
        const LAS float* tb = tab + cs * 64;
        float a = 0.f;
#pragma unroll 4
        for (int c4 = 0; c4 < 16; ++c4) { const f32x4 v = *(const f32x4*)(src + 4 * c4);
#pragma unroll
            for (int x = 0; x < 4; ++x) a += v[x] * tb[(k2 * (4 * c4 + x)) & 63]; }
        WinT[(size_t)(1536 + nrow) * 1024 + k] = (bf16_t)(cvtpk(a * 0.125f, 0.f) & 0xffff);
    }
    const float* pm = q->in[11] + (size_t)l * 4 * 64 * 64; const float* psc = q->in[12] + (size_t)l * 256; const float* wp = q->in[16] + (size_t)l * 256 * D;
    for (int e = gt; e < 256 * 1024; e += NGT) {
        const int n = e & 1023, gc = e >> 10, g = gc >> 6;
        float a = 0.f;
#pragma unroll 8
        for (int d = 0; d < 64; ++d) a += pm[(size_t)gc * 64 + d] * psc[g * 64 + d] * wp[(size_t)(g * 64 + d) * D + n];
        WbrT[(size_t)n * 1280 + 1024 + gc] = (bf16_t)(cvtpk(a, 0.f) & 0xffff);
    }
    __syncthreads();
}

DI void conv_ffn(int l, LAS unsigned char* lds, int G) {
    KP q = getp(); unsigned char* ws = q->ws;
    const int tid = tid_(), lane = tid & 63, wave = tid >> 6;
    const int gw = blockIdx.x * 8 + wave, NGW = G * 8;
    LAS float* scr = (LAS float*)(lds + wave * 8448);
    bf16_t* WupT = (bf16_t*)(ws + WS_WUP); bf16_t* WdnT = (bf16_t*)(ws + WS_WDN);
    constexpr int I_U = 16 * 176, I_D = 44 * 32;
    for (int it = gw; it < I_U + I_D; it += NGW) {
        int r = it;
        if (r < I_U) { const int kb = r / 176, nb = r % 176, n0 = nb * 32; transpose_item(q->in[18] + (size_t)l * D * UPW, UPW, kb * 64, n0, WupT, wup_dest(n0), 1024, 0, scr, lane); continue; } r -= I_U;
        { const int kb = r / 32, nb = r % 32; transpose_item(q->in[20] + (size_t)l * DFF * D, D, kb * 64, nb * 32, WdnT, nb * 32, DFF, 0, scr, lane); }
    }
}

DI void norm_row(const float* xrow, const float* gain, const float* shift, const float* scale, bf16_t* orow, int lane) {
    const f32x4* xr = (const f32x4*)xrow + lane;
    f32x4 v[4]; float s = 0.f;
#pragma unroll
    for (int j = 0; j < 4; ++j) { v[j] = xr[64 * j]; s += (v[j][0] * v[j][0] + v[j][1] * v[j][1]) + (v[j][2] * v[j][2] + v[j][3] * v[j][3]); }
    const float rstd = rsqrtf(wave_sum(s) * (1.0f / D) + EPS);
#pragma unroll
    for (int j = 0; j < 4; ++j) {
        const int c = 256 * j + 4 * lane;
        const f32x4 g = *(const f32x4*)(gain + c), sh = *(const f32x4*)(shift + c), sc = *(const f32x4*)(scale + c);
        const f32x4 y = (v[j] * rstd) * g;
        const f32x4 h = y * (1.0f + sc) + sh;
        u32x2 w; w.x = cvtpk(h[0], h[1]); w.y = cvtpk(h[2], h[3]);
        *(u32x2*)(orow + c) = w;
    }
}
DI void norm_phase(const float* srcL, const float* srcC, bool do_ctx, const float* gain, const float* mods, int si, bf16_t* H, int G) {
    const int tid = tid_(), lane = tid & 63, wave = tid >> 6;
    const int gw = blockIdx.x * 8 + wave, NGW = G * 8;
    const int nrows = do_ctx ? MT : ML;
    for (int r = gw; r < nrows; r += NGW) {
        const float* x; const float* md;
        if (r < ML) { x = srcL + (size_t)r * D; md = mods + (size_t)(r >> 11) * 6144; }
        else { x = srcC + (size_t)(r - ML) * D; md = mods + (size_t)8 * 6144; }
        norm_row(x, gain, md + si * 1024, md + (si + 1) * 1024, H + (size_t)r * D, lane);
    }
}

DI void attn_qk(f32x16& p0, f32x16& p1, const LAS unsigned char* kl, const bf16x8 (&qf)[4], int r32, int h) {
    constexpr int PITCH = 144;
#pragma unroll
    for (int i = 0; i < 16; ++i) { p0[i] = 0.f; p1[i] = 0.f; }
#pragma unroll
    for (int s = 0; s < 4; ++s) {
        const bf16x8 ka = *(const LAS bf16x8*)(kl + r32 * PITCH + (16 * s + 8 * h) * 2);
        const bf16x8 kb2 = *(const LAS bf16x8*)(kl + (32 + r32) * PITCH + (16 * s + 8 * h) * 2);
        p0 = __builtin_amdgcn_mfma_f32_32x32x16_bf16(ka, qf[s], p0, 0, 0, 0);
        p1 = __builtin_amdgcn_mfma_f32_32x32x16_bf16(kb2, qf[s], p1, 0, 0, 0);
    }
}
#define ATTN_ITER(FAST, t, PC0, PC1, PN0, PN1, KW, VW, KL, VL) do { \
        const int cur = (t) & 1; \
        if ((t) + 3 < nkt) KL = *(const u32x4*)(kbase + ((size_t)((t) + 3) * 64 + srow) * 64 + sch * 8); \
        if ((t) + 2 < nkt) VL = *(const u32x4*)(vbase + (size_t)srow * SKV + ((t) + 2) * 64 + sch * 8); \
        if ((t) + 1 < nkt) attn_qk(PN0, PN1, lds + (cur ^ 1) * TB, qf, r32, h); \
        if (FAST) {                                           \
            f32x2_t rs = {0.f, 0.f}; \
            _Pragma("unroll") for (int i = 0; i < 16; i += 2) { \
                f32x2_t a0, a1; \
                a0.x = __builtin_amdgcn_exp2f(PC0[i]); a0.y = __builtin_amdgcn_exp2f(PC0[i + 1]); a1.x = __builtin_amdgcn_exp2f(PC1[i]); a1.y = __builtin_amdgcn_exp2f(PC1[i + 1]); \
                PC0[i] = a0.x; PC0[i + 1] = a0.y; PC1[i] = a1.x; PC1[i + 1] = a1.y; rs += a0 + a1; } \
            l_run += rs.x + rs.y; \
        } else { \
        float mx0 = fmaxf(PC0[0], PC1[0]), mx1 = fmaxf(PC0[1], PC1[1]); \
        _Pragma("unroll") for (int i = 2; i < 16; i += 2) { mx0 = fmaxf(mx0, fmaxf(PC0[i], PC1[i])); mx1 = fmaxf(mx1, fmaxf(PC0[i + 1], PC1[i + 1])); } \
        float mx = fmaxf(mx0, mx1); \
        mx = fmaxf(mx, __shfl_xor(mx, 32)); \
        const float m_new = fmaxf(m_run, mx); \
        const float alpha = __builtin_amdgcn_exp2f(m_run - m_new); \
        m_run = m_new; \
        const f32x2_t mm = {m_new, m_new}; \
        f32x2_t rs = {0.f, 0.f}; \
        _Pragma("unroll") for (int i = 0; i < 16; i += 2) { \
            f32x2_t a0 = (f32x2_t){PC0[i], PC0[i + 1]} - mm, a1 = (f32x2_t){PC1[i], PC1[i + 1]} - mm; \
            a0.x = __builtin_amdgcn_exp2f(a0.x); a0.y = __builtin_amdgcn_exp2f(a0.y); a1.x = __builtin_amdgcn_exp2f(a1.x); a1.y = __builtin_amdgcn_exp2f(a1.y); \
            PC0[i] = a0.x; PC0[i + 1] = a0.y; PC1[i] = a1.x; PC1[i + 1] = a1.y; rs += a0 + a1; } \
        l_run = l_run * alpha + (rs.x + rs.y); \
        _Pragma("unroll") for (int i = 0; i < 16; ++i) { o0[i] *= alpha; o1[i] *= alpha; } \
        } \
        const LAS unsigned char* vl = lds + 2 * TB + cur * TB; \
        _Pragma("unroll") for (int kb = 0; kb < 2; ++kb) \
        _Pragma("unroll") for (int s2 = 0; s2 < 2; ++s2) { \
                u32x4 pw; \
                if (kb == 0) { pw.x = cvtpk(PC0[8 * s2 + 0], PC0[8 * s2 + 1]); pw.y = cvtpk(PC0[8 * s2 + 2], PC0[8 * s2 + 3]); pw.z = cvtpk(PC0[8 * s2 + 4], PC0[8 * s2 + 5]); pw.w = cvtpk(PC0[8 * s2 + 6], PC0[8 * s2 + 7]); } \
                else { pw.x = cvtpk(PC1[8 * s2 + 0], PC1[8 * s2 + 1]); pw.y = cvtpk(PC1[8 * s2 + 2], PC1[8 * s2 + 3]); pw.z = cvtpk(PC1[8 * s2 + 4], PC1[8 * s2 + 5]); pw.w = cvtpk(PC1[8 * s2 + 6], PC1[8 * s2 + 7]); } \
                const bf16x8 pb = __builtin_bit_cast(bf16x8, pw); \
                const int kk = 32 * kb + 16 * s2 + 4 * h; \
                { const u32x2 lo = *(const LAS u32x2*)(vl + r32 * PITCH + kk * 2), hi = *(const LAS u32x2*)(vl + r32 * PITCH + (kk + 8) * 2); \
                  u32x4 vw; vw.x = lo.x; vw.y = lo.y; vw.z = hi.x; vw.w = hi.y; \
                  o0 = __builtin_amdgcn_mfma_f32_32x32x16_bf16(__builtin_bit_cast(bf16x8, vw), pb, o0, 0, 0, 0); } \
                { const u32x2 lo = *(const LAS u32x2*)(vl + (32 + r32) * PITCH + kk * 2), hi = *(const LAS u32x2*)(vl + (32 + r32) * PITCH + (kk + 8) * 2); \
                  u32x4 vw; vw.x = lo.x; vw.y = lo.y; vw.z = hi.x; vw.w = hi.y; \
                  o1 = __builtin_amdgcn_mfma_f32_32x32x16_bf16(__builtin_bit_cast(bf16x8, vw), pb, o1, 0, 0, 0); } \
            } \
        if ((t) + 2 < nkt) *(LAS u32x4*)(lds + cur * TB + soff) = KW;                   \
        if ((t) + 1 < nkt) *(LAS u32x4*)(lds + 2 * TB + (cur ^ 1) * TB + soff) = VW;    \
        __syncthreads(); \
    } while (0)

DI void attn_unit(LAS unsigned char* lds, const bf16_t* ZQ, const bf16_t* KB, const bf16_t* VT, bf16_t* ACT4, int b, int g, int qrow0, int key0, int nkt, bool fast) {
    const int tid = tid_(), wave = tid >> 6, lane = tid & 63, r32 = lane & 31, h = lane >> 5;
    const int head = g * 4 + (wave >> 1);
    const int qrow = qrow0 + (wave & 1) * 32 + r32;
    constexpr int PITCH = 144, TB = 64 * PITCH;
    bf16x8 qf[4];
#pragma unroll
    for (int s = 0; s < 4; ++s) qf[s] = *(const bf16x8*)(ZQ + (size_t)qrow * 512 + head * 64 + 16 * s + 8 * h);
    f32x16 o0, o1;
#pragma unroll
    for (int i = 0; i < 16; ++i) { o0[i] = 0.f; o1[i] = 0.f; }
    float m_run = -1e30f, l_run = 0.f;
    const bf16_t* kbase = KB + ((size_t)(b * 2 + g) * SKV + key0) * 64;
    const bf16_t* vbase = VT + ((size_t)(b * 2 + g) * 64) * SKV + key0;
    const int srow = tid >> 3, sch = tid & 7;
    const unsigned soff = (unsigned)(srow * PITCH + sch * 16);
    u32x4 kA = *(const u32x4*)(kbase + (size_t)srow * 64 + sch * 8);
    u32x4 vA = *(const u32x4*)(vbase + (size_t)srow * SKV + sch * 8);
    u32x4 kB = *(const u32x4*)(kbase + ((size_t)64 + srow) * 64 + sch * 8);
    u32x4 vB;
    __syncthreads();
    *(LAS u32x4*)(lds + soff) = kA;
    *(LAS u32x4*)(lds + 2 * TB + soff) = vA;
    *(LAS u32x4*)(lds + TB + soff) = kB;
    if (nkt > 2) kA = *(const u32x4*)(kbase + ((size_t)128 + srow) * 64 + sch * 8);
    vA = *(const u32x4*)(vbase + (size_t)srow * SKV + 64 + sch * 8);
    vB = vA; kB = kA;
    __syncthreads();
    f32x16 pa0, pa1, pb0, pb1;
    attn_qk(pa0, pa1, lds, qf, r32, h);
#pragma unroll
    for (int i = 0; i < 16; ++i) { pb0[i] = 0.f; pb1[i] = 0.f; }
    if (fast) {
#pragma nounroll
        for (int t = 0; t < nkt; t += 2) {
            ATTN_ITER(true, t, pa0, pa1, pb0, pb1, kA, vA, kB, vB);
            ATTN_ITER(true, t + 1, pb0, pb1, pa0, pa1, kB, vB, kA, vA);
        }
    } else {
#pragma nounroll
        for (int t = 0; t < nkt; t += 2) {
            ATTN_ITER(false, t, pa0, pa1, pb0, pb1, kA, vA, kB, vB);
            ATTN_ITER(false, t + 1, pb0, pb1, pa0, pa1, kB, vB, kA, vA);
        }
    }
    const float lt = l_run + __shfl_xor(l_run, 32);
    const float inv = 1.0f / lt;
    bf16_t* orow = ACT4 + (size_t)qrow * 1280 + head * 64;
#pragma unroll
    for (int g4 = 0; g4 < 4; ++g4) {
        u32x2 w; w.x = cvtpk(o0[4 * g4] * inv, o0[4 * g4 + 1] * inv); w.y = cvtpk(o0[4 * g4 + 2] * inv, o0[4 * g4 + 3] * inv);
        *(u32x2*)(orow + 8 * g4 + 4 * h) = w;
        u32x2 w2; w2.x = cvtpk(o1[4 * g4] * inv, o1[4 * g4 + 1] * inv); w2.y = cvtpk(o1[4 * g4 + 2] * inv, o1[4 * g4 + 3] * inv);
        *(u32x2*)(orow + 32 + 8 * g4 + 4 * h) = w2;
    }
}

DI void scpool_phase(const bf16_t* ZS, const bf16_t* ZP, bf16_t* ACT4, const float* convw, int nrows, int G) {
    const int tid = tid_(), lane = tid & 63, wave = tid >> 6;
    const int gw = blockIdx.x * 8 + wave, NGW = G * 8;
    for (int r = gw; r < nrows; r += NGW) {
        int t, N; if (r < ML) { t = r & 2047; N = SEQ; } else { t = (r - ML) & 255; N = CTXL; }
        if (lane < 32) {
            const int c = lane * 8;
            float a[8];
#pragma unroll
            for (int j = 0; j < 8; ++j) a[j] = 0.f;
#pragma unroll
            for (int dt = -1; dt <= 1; ++dt) {
                if (t + dt >= 0 && t + dt < N) {
                    const bf16_t* row = ZS + (size_t)(r + dt) * 768;
                    const u32x4 gc = *(const u32x4*)(row + 256 + c), xs = *(const u32x4*)(row + 512 + c);
                    const f32x4 w0 = *(const f32x4*)(convw + (dt + 1) * 256 + c), w1 = *(const f32x4*)(convw + (dt + 1) * 256 + c + 4);
                    a[0] += w0[0] * bflo(gc.x) * bflo(xs.x); a[1] += w0[1] * bfhi(gc.x) * bfhi(xs.x);
                    a[2] += w0[2] * bflo(gc.y) * bflo(xs.y); a[3] += w0[3] * bfhi(gc.y) * bfhi(xs.y);
                    a[4] += w1[0] * bflo(gc.z) * bflo(xs.z); a[5] += w1[1] * bfhi(gc.z) * bfhi(xs.z);
                    a[6] += w1[2] * bflo(gc.w) * bflo(xs.w); a[7] += w1[3] * bfhi(gc.w) * bfhi(xs.w);
                }
            }
            const u32x4 gb = *(const u32x4*)(ZS + (size_t)r * 768 + c);
            u32x4 w; w.x = cvtpk(bflo(gb.x) * a[0], bfhi(gb.x) * a[1]); w.y = cvtpk(bflo(gb.y) * a[2], bfhi(gb.y) * a[3]);
            w.z = cvtpk(bflo(gb.z) * a[4], bfhi(gb.z) * a[5]); w.w = cvtpk(bflo(gb.w) * a[6], bfhi(gb.w) * a[7]);
            *(u32x4*)(ACT4 + (size_t)r * 1280 + 512 + c) = w;
        } else {
            const int c = (lane - 32) * 8, gi = c >> 6, wdw = 2 << gi, left = (wdw - 1) >> 1, right = wdw >> 1;
            const int lo = (t - left) > 0 ? (t - left) : 0, hi = (t + right + 1) < N ? (t + right + 1) : N;
            float a[8];
#pragma unroll
            for (int j = 0; j < 8; ++j) a[j] = 0.f;
            u32x4 pv[16];
#pragma unroll
            for (int i = 0; i < 16; ++i) { int tt = lo + i; tt = tt < hi ? tt : (hi - 1); pv[i] = *(const u32x4*)(ZP + (size_t)(r - t + tt) * 256 + c); }
#pragma unroll
            for (int i = 0; i < 16; ++i) if (lo + i < hi) {
                const u32x4 v = pv[i];
                a[0] += bflo(v.x); a[1] += bfhi(v.x); a[2] += bflo(v.y); a[3] += bfhi(v.y); a[4] += bflo(v.z); a[5] += bfhi(v.z); a[6] += bflo(v.w); a[7] += bfhi(v.w);
            }
            const float ic = 1.0f / (float)(hi - lo);
            const u32x4 x = *(const u32x4*)(ZP + (size_t)r * 256 + c);
            u32x4 w; w.x = cvtpk(a[0] * ic - bflo(x.x), a[1] * ic - bfhi(x.x)); w.y = cvtpk(a[2] * ic - bflo(x.y), a[3] * ic - bfhi(x.y));
            w.z = cvtpk(a[4] * ic - bflo(x.z), a[5] * ic - bfhi(x.z)); w.w = cvtpk(a[6] * ic - bflo(x.w), a[7] * ic - bfhi(x.w));
            *(u32x4*)(ACT4 + (size_t)r * 1280 + 1024 + c) = w;
        }
    }
}

DI void fixup_phase(const bf16_t* RAW, bf16_t* ACT, const float* wconv, int nchunks, int G) {
    const int tid = tid_();
    for (int it = blockIdx.x; it < nchunks * 2; it += G) {
        const int ch = it >> 1, which = it & 1;
        const int r = ch * 64 + (which ? 63 : 0);
        int t, N; if (r < ML) { t = r & 2047; N = SEQ; } else { t = (r - ML) & 255; N = CTXL; }
        const bf16_t *up, *mid, *dn;
        if (!which) { up = (t > 0) ? RAW + ((size_t)(ch - 1) * 4 + 1) * UPW : nullptr; mid = RAW + ((size_t)ch * 4 + 2) * UPW; dn = RAW + ((size_t)ch * 4 + 3) * UPW; }
        else { up = RAW + ((size_t)ch * 4 + 0) * UPW; mid = RAW + ((size_t)ch * 4 + 1) * UPW; dn = (t < N - 1) ? RAW + ((size_t)(ch + 1) * 4 + 2) * UPW : nullptr; }
        for (int j = tid; j < DFF; j += 512) {
            const float ua = up ? bflo(up[j]) : 0.f, ub = up ? bflo(up[DFF + j]) : 0.f;
            const float ma = bflo(mid[j]), mb = bflo(mid[DFF + j]);
            const float da = dn ? bflo(dn[j]) : 0.f, db = dn ? bflo(dn[DFF + j]) : 0.f;
            const float ca = wconv[j] * ua + wconv[UPW + j] * ma + wconv[2 * UPW + j] * da;
            const float cb = wconv[DFF + j] * ub + wconv[UPW + DFF + j] * mb + wconv[2 * UPW + DFF + j] * db;
            ACT[(size_t)r * DFF + j] = (bf16_t)(cvtpk(ca * sigmoidf_(ca) * cb, 0.f) & 0xffff);
        }
    }
}

#define XB_TMO      128
#define XB_XCNT(j)  (256  + 64 * (j))
#define XB_XSUB(j)  (1280 + 64 * (j))
#define XB_XGEN(j)  (2304 + 64 * (j))
#define XB_TOP      3328
#define XB_TOPGEN   3392
#define XCD_BAR_WORDS 3456
#define XB_SPIN_CAP (1u << 22)
DI unsigned xb_ld(unsigned* p)              { return __hip_atomic_load(p, __ATOMIC_RELAXED, __HIP_MEMORY_SCOPE_AGENT); }
DI unsigned xb_add(unsigned* p, unsigned v) { return __hip_atomic_fetch_add(p, v, __ATOMIC_RELAXED, __HIP_MEMORY_SCOPE_AGENT); }
DI unsigned xb_xcc_id() { return (unsigned)__builtin_amdgcn_s_getreg((3 << 11) | 20) & 0xFu; }
#define XB_SPIN(cond, bar) do { unsigned _sp = 0; while (cond) { __builtin_amdgcn_s_sleep(1); \
    if ((++_sp & 255u) == 0u) { if (xb_ld(&(bar)[XB_TMO])) break; if (_sp > XB_SPIN_CAP) { atomicAdd(&(bar)[XB_TMO], 1u); break; } } } } while (0)
DI void xcd_barrier_complete(unsigned* bar, unsigned x, unsigned& nloc, unsigned& nx) {
    const unsigned G = gridDim.x * gridDim.y * gridDim.z;
    unsigned sum, cnt, mine, sp = 0u;
    for (;;) {
        sum = 0u; cnt = 0u; mine = 0u;
#pragma unroll
        for (unsigned j = 0; j < 16; ++j) { const unsigned c = xb_ld(&bar[XB_XCNT(j)]); sum += c; cnt += (c > 0u) ? 1u : 0u; mine = (j == x) ? c : mine; }
        if (sum == G) break;
        __builtin_amdgcn_s_sleep(1);
        if ((++sp & 255u) == 0u) { if (xb_ld(&bar[XB_TMO])) break; if (sp > XB_SPIN_CAP) { atomicAdd(&bar[XB_TMO], 1u); break; } }
    }
    nloc = mine > 0u ? mine : 1u; nx = cnt > 0u ? cnt : 1u;
}
DI void xb_post(unsigned* bar) { if (threadIdx.x == 0) (void)xb_add(&bar[XB_XCNT(xb_xcc_id())], 1u); }
DI void xcd_barrier(unsigned* bar, volatile LAS unsigned* st) {
    asm volatile("s_waitcnt vmcnt(0)" ::: "memory");
    __syncthreads();
    if (threadIdx.x == 0) {
        const unsigned x = xb_xcc_id();
        __builtin_amdgcn_s_waitcnt(0);
        unsigned nloc = st[0], nx = st[1];
        if (nloc == 0u) { xcd_barrier_complete(bar, x, nloc, nx); st[0] = nloc; st[1] = nx; }
        const unsigned old = xb_add(&bar[XB_XSUB(x)], 1u);
        const unsigned gen = old / nloc;
        if (old + 1u == (gen + 1u) * nloc) {
            __builtin_amdgcn_fence(__ATOMIC_RELEASE, "agent");
            asm volatile("s_waitcnt vmcnt(0)" ::: "memory");
            const unsigned og = xb_add(&bar[XB_TOP], 1u);
            const unsigned tg = og / nx;
            if (og + 1u == (tg + 1u) * nx) xb_add(&bar[XB_TOPGEN], 1u);
            else XB_SPIN(xb_ld(&bar[XB_TOPGEN]) == tg, bar);
            __builtin_amdgcn_fence(__ATOMIC_ACQUIRE, "agent");
            xb_add(&bar[XB_XGEN(x)], 1u);
            asm volatile("s_waitcnt vmcnt(0)" ::: "memory");
        } else {
            XB_SPIN(xb_ld(&bar[XB_XGEN(x)]) == gen, bar);
            __builtin_amdgcn_fence(__ATOMIC_ACQUIRE, "agent");
            asm volatile("s_waitcnt vmcnt(0)" ::: "memory");
        }
    }
    __syncthreads();
}

DI void ph0(LAS unsigned char* lds) {
    KP q = getp(); unsigned char* ws = q->ws;
    const int tid = tid_(), G = gridDim.x, cu = blockIdx.x, gt = cu * 512 + tid, NGT = G * 512;
    float* MODS = (float*)(ws + WS_MODS);
    float* ROPEC = (float*)(ws + WS_ROPE); float* ROPES = ROPEC + 2048 * 32;
    bf16_t* FML = (bf16_t*)(ws + WS_FML); bf16_t* FMC = (bf16_t*)(ws + WS_FMC);
    LAS float* sm = (LAS float*)lds;
    const float* cvec = q->in[1]; const float* cctx = q->in[3]; const float* w_mod = q->in[4]; const float* b_mod = q->in[5];
    for (int it = cu; it < 192; it += G) {
        const int l = it / 96, rem = it % 96, kc = rem / 12, cb = rem % 12;
        __syncthreads();
        for (int e = tid; e < 9 * 128; e += 512) { const int v = e >> 7, k = kc * 128 + (e & 127); const float cv = (v < 8) ? cvec[v * D + k] : cctx[k]; sm[e] = cv / (1.0f + __expf(-cv)); }
        __syncthreads();
        const int j = cb * 512 + tid;
        float a[9];
#pragma unroll
        for (int v = 0; v < 9; ++v) a[v] = 0.f;
        const float* wp = w_mod + ((size_t)l * D + kc * 128) * INW + j;
#pragma unroll 4
        for (int k = 0; k < 128; ++k) { const float w = wp[(size_t)k * INW];
#pragma unroll
            for (int v = 0; v < 9; ++v) a[v] += sm[v * 128 + k] * w; }
        const float bm = (kc == 0) ? b_mod[l * INW + j] : 0.f;
#pragma unroll
        for (int v = 0; v < 9; ++v) atomicAdd(&MODS[(size_t)(l * 9 + v) * INW + j], a[v] + bm);
    }
    for (int e = gt; e < 2048 * 32; e += NGT) {
        const int t = e >> 5, ax = (e >> 4) & 1, i = e & 15;
        const float pos = (float)(ax ? (t & 63) : (t >> 6));
        const float inv = powf(10000.0f, -(float)i * (1.0f / 16.0f));
        float sn, cs; sincosf(pos * inv, &sn, &cs);
        ROPEC[e] = cs; ROPES[e] = sn;
    }
    for (int e = gt; e < 2048 * 512; e += NGT) {
        const int k1 = e >> 9, c8 = e & 511, part = c8 >> 8, n0 = (c8 & 255) * 8;
        float v[8];
#pragma unroll
        for (int j = 0; j < 8; ++j) { const int mm = (k1 * (n0 + j)) & 2047; float sn, cs; sincospif((float)mm * (1.0f / 1024.0f), &sn, &cs); v[j] = (part ? -sn : cs) * 0.022097086912079608f; }
        u32x4 w; w.x = cvtpk(v[0], v[1]); w.y = cvtpk(v[2], v[3]); w.z = cvtpk(v[4], v[5]); w.w = cvtpk(v[6], v[7]);
        *(u32x4*)(FML + (size_t)k1 * 4096 + part * 2048 + n0) = w;
    }
    for (int e = gt; e < 256 * 64; e += NGT) {
        const int k1 = e >> 6, c8 = e & 63, part = c8 >> 5, n0 = (c8 & 31) * 8;
        float v[8];
#pragma unroll
        for (int j = 0; j < 8; ++j) { const int mm = (k1 * (n0 + j)) & 255; float sn, cs; sincospif((float)mm * (1.0f / 128.0f), &sn, &cs); v[j] = (part ? -sn : cs) * 0.0625f; }
        u32x4 w; w.x = cvtpk(v[0], v[1]); w.y = cvtpk(v[2], v[3]); w.z = cvtpk(v[4], v[5]); w.w = cvtpk(v[6], v[7]);
        *(u32x4*)(FMC + (size_t)k1 * 512 + part * 256 + n0) = w;
    }
}
DI void ph_norm(int l, int which, bool do_ctx) {
    KP q = getp(); unsigned char* ws = q->ws;
    const float* MODS = (const float*)(ws + WS_MODS);
    const float* srcL = (l == 0 && which == 0) ? q->in[0] : (const float*)q->out;
    const float* srcC = (l == 0 && which == 0) ? q->in[2] : (const float*)(ws + WS_CX);
    norm_phase(srcL, srcC, do_ctx, q->in[which ? 7 : 6] + l * D, MODS + (size_t)l * 9 * INW, which ? 3 : 0, (bf16_t*)(ws + WS_H), gridDim.x);
}
DI void ph2(int l, LAS unsigned char* lds) {
    KP q = getp(); unsigned char* ws = q->ws;
    const int G = gridDim.x, cu = blockIdx.x;
    pg8::Gemm g{(const bf16_t*)(ws + WS_H), (const bf16_t*)(ws + WS_WIN), 1024, 1024};
    pg8::Sched S;
    if (l == 0) S.init(72, 25, G, cu, 16);
    else { S.init(64, 25, G, cu, 16); S.nx = 8; S.xpm0 = 64; S.xpn = 2; }
    float* ROPEC = (float*)(ws + WS_ROPE);
    EpiZ E{(bf16_t*)(ws + WS_ZQ), (bf16_t*)(ws + WS_ZS), (bf16_t*)(ws + WS_ZP), (bf16_t*)(ws + WS_KB), (bf16_t*)(ws + WS_VT), (bf16_t*)(ws + WS_YTL), (bf16_t*)(ws + WS_YTC), ws + WS_G8,
           ROPEC, ROPEC + 2048 * 32, q->in[10] + l * 128, q->in[10] + l * 128 + 64};
    pg8::gemm_phase<EpiZ, true>(lds, g, S, E);
}
DI void ph3_dft(int l, LAS unsigned char* lds) {
    KP q = getp(); unsigned char* ws = q->ws;
    const int G = gridDim.x, cu = blockIdx.x;
    const int nsub = (l == 0) ? 2 : 1;
#pragma nounroll
    for (int j = 0; j < nsub; ++j) {
        pg8::Gemm g; pg8::Sched S; EpiDft E;
        if (j == 0) { g = pg8::Gemm{(const bf16_t*)(ws + WS_FML), (const bf16_t*)(ws + WS_YTL), 4096, 4096}; S.init(8, 8, G, cu, 64); E = EpiDft{(bf16_t*)(ws + WS_ACT4), 0, SEQ}; }
        else { g = pg8::Gemm{(const bf16_t*)(ws + WS_FMC), (const bf16_t*)(ws + WS_YTC), 512, 512}; S.init(1, 8, G, (cu + G - 64) % G, 8); E = EpiDft{(bf16_t*)(ws + WS_ACT4), ML, CTXL}; }
        pg8::gemm_phase<EpiDft, true>(lds, g, S, E);
    }
}
DI void ph3_attn(int l, LAS unsigned char* lds) {
    KP q = getp(); unsigned char* ws = q->ws;
    const int G = gridDim.x, cu = blockIdx.x;
    const bf16_t* ZQ = (const bf16_t*)(ws + WS_ZQ); const bf16_t* KB = (const bf16_t*)(ws + WS_KB); const bf16_t* VT = (const bf16_t*)(ws + WS_VT); bf16_t* ACT4 = (bf16_t*)(ws + WS_ACT4);
    bool fast;
    {
        const int ln = tid_() & 63;
        float gq = fabsf(q->in[10][l * 128 + ln]), gk = fabsf(q->in[10][l * 128 + 64 + ln]);
#pragma unroll
        for (int o = 1; o < 64; o <<= 1) { gq = fmaxf(gq, __shfl_xor(gq, o)); gk = fmaxf(gk, __shfl_xor(gk, o)); }
        const float bound = 11.5416f * gq * gk;
        fast = __builtin_amdgcn_readfirstlane(bound <= 60.0f ? 1 : 0) != 0;
    }
    if (G == 256) {
        if (cu >= 64) {
            const int x = cu & 7, idx = (cu - 64) >> 3;
#pragma nounroll
            for (int u = idx; u < 64; u += 24) { const int a = (2 * x + (u >> 5)) * 32 + (u & 31); attn_unit(lds, ZQ, KB, VT, ACT4, a >> 6, (a >> 5) & 1, (a >> 6) * SEQ + (a & 31) * 64, 0, 36, fast); }
        }
    } else {
#pragma nounroll
        for (int a = cu; a < 512; a += G) attn_unit(lds, ZQ, KB, VT, ACT4, a >> 6, (a >> 5) & 1, (a >> 6) * SEQ + (a & 31) * 64, 0, 36, fast);
    }
    if (l == 0) {
#pragma nounroll
        for (int a = (cu + 64) % G; a < 64; a += G) attn_unit(lds, ZQ, KB, VT, ACT4, a >> 3, (a >> 2) & 1, ML + (a >> 3) * CTXL + (a & 3) * 64, SEQ, 4, fast);
    }
}
DI void ph3_scpool(int l) {
    KP q = getp(); unsigned char* ws = q->ws;
    scpool_phase((const bf16_t*)(ws + WS_ZS), (const bf16_t*)(ws + WS_ZP), (bf16_t*)(ws + WS_ACT4), q->in[9] + l * 768, l == 0 ? MT : ML, gridDim.x);
}
DI void ph4(int l, LAS unsigned char* lds) {
    KP q = getp(); unsigned char* ws = q->ws;
    const int G = gridDim.x, cu = blockIdx.x;
    pg8::Gemm g{(const bf16_t*)(ws + WS_ACT4), (const bf16_t*)(ws + WS_WBR), 1280, 1280};
    pg8::Sched S; S.init(l == 0 ? 72 : 64, 4, G, cu, 8); S.sub = 4;
    EpiBr E{ws + WS_G8, (bf16_t*)(ws + WS_Y), ws + WS_PY + (size_t)cu * 131072};
    pg8::gemm_phase<EpiBr, true>(lds, g, S, E);
}
DI void ph_res(int l, int which, LAS unsigned char* lds) {
    KP q = getp(); unsigned char* ws = q->ws;
    const int G = gridDim.x, cu = blockIdx.x;
    const float* mods = (const float*)(ws + WS_MODS) + (size_t)l * 9 * INW;
    float* OUT = q->out; float* CX = (float*)(ws + WS_CX);
    pg8::Gemm g; pg8::Sched S; EpiRes E;
    if (which == 0) {
        g = pg8::Gemm{(const bf16_t*)(ws + WS_Y), (const bf16_t*)(ws + WS_WOUT), 1024, 1024}; S.init(l == 0 ? 72 : 64, 4, G, cu, 16);
        E = EpiRes{(l == 0) ? q->in[0] : (const float*)OUT, OUT, (l == 0) ? q->in[2] : (const float*)CX, CX, mods + 2 * 1024};
    } else {
        g = pg8::Gemm{(const bf16_t*)(ws + WS_ACT), (const bf16_t*)(ws + WS_WDN), DFF, DFF}; S.init(l == 0 ? 72 : 64, 4, G, cu, 44);
        E = EpiRes{OUT, OUT, CX, CX, mods + 5 * 1024};
    }
    pg8::gemm_phase<EpiRes, true>(lds, g, S, E);
}
DI void ph7(int l, LAS unsigned char* lds) {
    KP q = getp(); unsigned char* ws = q->ws;
    const int G = gridDim.x, cu = blockIdx.x;
    pg8::Gemm g{(const bf16_t*)(ws + WS_H), (const bf16_t*)(ws + WS_WUP), 1024, 1024};
    pg8::Sched S; S.init(l == 0 ? 72 : 64, 22, G, cu, 16);
    EpiUp E{(bf16_t*)(ws + WS_ACT), (bf16_t*)(ws + WS_RAW), q->in[19] + (size_t)l * 3 * UPW};
    pg8::gemm_phase<EpiUp, true>(lds, g, S, E);
}
DI void ph7b(int l) {
    KP q = getp(); unsigned char* ws = q->ws;
    fixup_phase((const bf16_t*)(ws + WS_RAW), (bf16_t*)(ws + WS_ACT), q->in[19] + (size_t)l * 3 * UPW, l == 0 ? 288 : 256, gridDim.x);
}
DI void ph_final() {
    KP q = getp();
    const int tid = tid_(), lane = tid & 63, gw = blockIdx.x * 8 + (tid >> 6), NGW = gridDim.x * 8;
    const float* fg = q->in[21]; float* OUT = q->out;
    for (int r = gw; r < ML; r += NGW) {
        f32x4* xr = (f32x4*)(OUT + (size_t)r * D) + lane;
        f32x4 v[4]; float s = 0.f;
#pragma unroll
        for (int j = 0; j < 4; ++j) { v[j] = xr[64 * j]; s += (v[j][0] * v[j][0] + v[j][1] * v[j][1]) + (v[j][2] * v[j][2] + v[j][3] * v[j][3]); }
        const float rstd = rsqrtf(wave_sum(s) * (1.0f / D) + EPS);
#pragma unroll
        for (int j = 0; j < 4; ++j) { const f32x4 gg = *(const f32x4*)(fg + 256 * j + 4 * lane); xr[64 * j] = (v[j] * rstd) * gg; }
    }
}

__global__ void __launch_bounds__(512, 2) mega(Params p) {
    extern __shared__ __attribute__((aligned(16))) unsigned char lds_raw[];
    LAS unsigned char* lds = (LAS unsigned char*)lds_raw;
    cg::grid_group grid = cg::this_grid();
    volatile LAS unsigned* xst = (volatile LAS unsigned*)(lds + 131072 + 64);
    if (threadIdx.x < 2) xst[threadIdx.x] = 0u;
    __syncthreads();
    { KP q = getp(); xb_post((unsigned*)(q->ws + WS_CTL)); }
#define GBAR() do { KP q_ = getp(); xcd_barrier((unsigned*)(q_->ws + WS_CTL), xst); } while (0)
    ph0(lds);
    grid.sync();
    ph_norm(0, 0, true);
    conv_mixer(0, lds, gridDim.x);
    GBAR();
#pragma nounroll
    for (int l = 0; l < 2; ++l) {
        for (int rep = 0; rep < REP_P2; ++rep) ph2(l, lds);
        GBAR();
        for (int rep = 0; rep < REP_DFT; ++rep) ph3_dft(l, lds);
        for (int rep = 0; rep < REP_ATTN; ++rep) ph3_attn(l, lds);
        for (int rep = 0; rep < REP_SCP; ++rep) ph3_scpool(l);
        GBAR();
        for (int rep = 0; rep < REP_P4; ++rep) ph4(l, lds);
        GBAR();
        ph_res(l, 0, lds);
        GBAR();
        for (int rep = 0; rep < REP_NORM; ++rep) ph_norm(l, 1, l == 0);
        conv_ffn(l, lds, gridDim.x);
        if (l == 0) conv_mixer(1, lds, gridDim.x);
        GBAR();
        for (int rep = 0; rep < REP_P7; ++rep) ph7(l, lds);
        GBAR();
        ph7b(l);
        GBAR();
        ph_res(l, 1, lds);
        GBAR();
        if (l == 0) { ph_norm(1, 0, true); GBAR(); }
        else ph_final();
    }
#undef GBAR
}

extern "C" void kernel_launch(void* const* d_in, const int* in_sizes, int n_in, void* d_out, int out_size, void* d_ws, size_t ws_size, hipStream_t stream) {
    static int grid_blocks = 0;
    if (grid_blocks == 0) {
        if (n_in != 22 || ws_size < WS_END) { fprintf(stderr, "kernel_launch: unexpected inputs (n_in %d, ws %zu)\n", n_in, ws_size); grid_blocks = -1; return; }
        int dev = 0, cus = 0, per_cu = 0;
        (void)hipGetDevice(&dev);
        (void)hipDeviceGetAttribute(&cus, hipDeviceAttributeMultiprocessorCount, dev);
        if (hipFuncSetAttribute((const void*)mega, hipFuncAttributeMaxDynamicSharedMemorySize, LDS_BYTES) != hipSuccess) { fprintf(stderr, "kernel_launch: hipFuncSetAttribute failed\n"); }
        if (hipOccupancyMaxActiveBlocksPerMultiprocessor(&per_cu, (const void*)mega, 512, LDS_BYTES) != hipSuccess || per_cu < 1) { fprintf(stderr, "kernel_launch: occupancy query gave %d\n", per_cu); per_cu = 1; }
        (void)hipGetLastError();
        grid_blocks = cus * 1;
        fprintf(stderr, "kernel_launch: cus %d per_cu %d grid %d ws %zu\n", cus, per_cu, grid_blocks, ws_size);
    }
    if (grid_blocks < 0) return;
    (void)hipMemsetAsync((char*)d_ws + WS_CTL, 0, WS_MODS + MODS_BYTES, stream);
    Params p{};
    for (int i = 0; i < 22; ++i) p.in[i] = (const float*)d_in[i];
    p.out = (float*)d_out; p.ws = (unsigned char*)d_ws;
    void* args[] = {&p};
    hipError_t e = hipLaunchCooperativeKernel((void*)mega, dim3(grid_blocks), dim3(512), args, LDS_BYTES, stream);
    if (e != hipSuccess) fprintf(stderr, "cooperative launch failed: %s (grid %d)\n", hipGetErrorString(e), grid_blocks);
}
```

```cpp
#include <hip/hip_runtime.h>
#include <hip/hip_cooperative_groups.h>
#include <cstdio>
#include <cstdint>
namespace cg = cooperative_groups;

#define LAS __attribute__((address_space(3)))
#define DI __device__ __forceinline__
typedef unsigned short bf16_t;
typedef short bf16x8 __attribute__((ext_vector_type(8)));
typedef short s16x4 __attribute__((ext_vector_type(4)));
typedef float f32x4 __attribute__((ext_vector_type(4)));
typedef float f32x2_t __attribute__((ext_vector_type(2)));
typedef float f32x16 __attribute__((ext_vector_type(16)));
typedef unsigned u32x4 __attribute__((ext_vector_type(4)));
typedef unsigned u32x2 __attribute__((ext_vector_type(2)));
typedef __bf16 bf16x2_t __attribute__((ext_vector_type(2)));

constexpr int D = 1024, SEQ = 2048, NB = 8, CTXL = 256;
constexpr int ML = NB * SEQ;
constexpr int MC = NB * CTXL;
constexpr int MT = ML + MC;
constexpr int INW = 6144, DFF = 2816, UPW = 5632;
constexpr int NZ = 6400;
constexpr int SKV = SEQ + CTXL;
constexpr float EPS = 1e-6f;

constexpr size_t MiB = 1u << 20;
constexpr size_t WS_CTL = 0;
constexpr size_t WS_MODS = 64 * 1024;
constexpr size_t MODS_BYTES = 2 * 9 * 6144 * 4;
constexpr size_t WS_ROPE = 1 * MiB;
constexpr size_t WS_CX = 2 * MiB;
constexpr size_t WS_FML = 10 * MiB;
constexpr size_t WS_FMC = 26 * MiB;
constexpr size_t WS_WIN = 27 * MiB;
constexpr size_t WS_WBR = WS_WIN + (size_t)NZ * 1024 * 2;
constexpr size_t WS_WOUT = 42 * MiB;
constexpr size_t WS_H = 44 * MiB;
constexpr size_t WS_ACT4 = 44 * MiB;
constexpr size_t WS_ZQ = 89 * MiB;
constexpr size_t WS_ZS = 107 * MiB;
constexpr size_t WS_ZP = 134 * MiB;
constexpr size_t WS_KB = 143 * MiB;
constexpr size_t WS_VT = WS_KB + (size_t)NB * 2 * SKV * 64 * 2;
constexpr size_t WS_YTL = 152 * MiB;
constexpr size_t WS_YTC = 168 * MiB;
constexpr size_t WS_G8 = 170 * MiB;
constexpr size_t WS_PY = 134 * MiB;
constexpr size_t WS_Y = 89 * MiB;
constexpr size_t WS_ACT = 89 * MiB;
constexpr size_t WS_WUP = 226 * MiB;
constexpr size_t WS_WDN = 237 * MiB;
constexpr size_t WS_RAW = 243 * MiB;
constexpr size_t WS_END = 256 * MiB;
static_assert(WS_WBR + 1024 * 1280 * 2 <= WS_WOUT && WS_VT + (size_t)NB * 2 * SKV * 64 * 2 <= WS_YTL, "ws map");
static_assert(WS_G8 + (size_t)MT * 4096 <= WS_WDN + 6 * MiB && WS_RAW + 288ull * 4 * UPW * 2 <= WS_END, "ws map");
static_assert(WS_ACT + (size_t)MT * DFF * 2 <= WS_WUP, "ws map");

constexpr int LDS_BYTES = 131072 + 4096;
#define REP_P2 1
#define REP_DFT 1
#define REP_ATTN 1
#define REP_SCP 1
#define REP_P4 1
#define REP_P7 1
#define REP_NORM 1

DI unsigned cvtpk(float lo, float hi) { f32x2_t v = {lo, hi}; bf16x2_t b = __builtin_convertvector(v, bf16x2_t); return __builtin_bit_cast(unsigned, b); }
DI float bflo(unsigned u) { return __uint_as_float(u << 16); }
DI float bfhi(unsigned u) { return __uint_as_float(u & 0xffff0000u); }
DI float wave_sum(float v) {
#pragma unroll
    for (int o = 1; o < 64; o <<= 1) v += __shfl_xor(v, o);
    return v;
}
DI int tid_() { int t; asm volatile("v_mov_b32 %0, %1" : "=v"(t) : "v"((int)threadIdx.x)); return t; }
DI float sigmoidf_(float v) { return 1.0f / (1.0f + __expf(-v)); }

struct Params { const float* in[22]; float* out; unsigned char* ws; };
typedef const __attribute__((address_space(4))) Params* KP;
DI KP getp() { KP q = (KP)__builtin_amdgcn_kernarg_segment_ptr(); asm volatile("" : "+s"(q)); return q; }

namespace pg8 {
constexpr int BM = 256, BK = 64, HALF = 128, HTB = HALF * BK * 2, STAGE_BYTES = 8 * HTB, NXCD = 8, WGM = 8;
DI int lds_byte(int r, int c) { const int st = (r >> 4) * 2 + (c >> 5), rr = r & 15, cc = c & 31, ob = rr * 64 + cc * 2; return st * 1024 + (ob ^ (((ob >> 9) & 1) << 5)); }
DI void stage_rc(int b, int& R, int& C) { const int st = b / 1024, sb = b % 1024, swz = sb ^ (((sb >> 9) & 1) << 5); R = (st >> 1) * 16 + swz / 64; C = (st & 1) * 32 + (swz % 64) / 2; }
DI int perm32(int rho) { const int n = rho >> 4, i = rho & 15; return 8 * (i >> 2) + 4 * n + (i & 3); }

struct Unit { int pm, pn, koff, nt, tag; };
struct Gemm { const bf16_t* A; const bf16_t* Bt; int lda, ldb; };

struct Sched {
    int nM, nN, nwg, G, c, nx, xpm0, xpn, sub, nt;
    DI void init(int nM_, int nN_, int G_, int c_, int nt_) { nM = nM_; nN = nN_; nwg = nM * nN; G = G_; c = c_; nx = 0; xpm0 = 0; xpn = 0; sub = 1; nt = nt_; }
    DI bool next(int i, Unit& u) const {
        int ti = i, s = 0;
        if (sub == 4) { ti = i >> 2; s = i & 3; }
        const long L = (long)ti * G + c;
        if (L < nwg) {
            int wgid = (int)L; { const int q = nwg / NXCD, r = nwg % NXCD, xcd = wgid % NXCD, off = wgid / NXCD; wgid = (xcd < r ? xcd * (q + 1) : r * (q + 1) + (xcd - r) * q) + off; }
            const int nig = WGM * nN, gid = wgid / nig, fm = gid * WGM, gsz = (nM - fm) < WGM ? (nM - fm) : WGM;
            u.pm = fm + ((wgid % nig) % gsz); u.pn = (wgid % nig) / gsz;
        } else if (L - nwg < nx) { u.pm = xpm0 + (int)(L - nwg); u.pn = xpn; }
        else return false;
        if (sub == 4) { u.tag = s; u.koff = (s == 0) ? 0 : 256 + 256 * s; u.nt = (s == 0) ? 8 : 4; }
        else { u.tag = 0; u.koff = 0; u.nt = nt; }
        return true;
    }
};

typedef f32x4 Acc[2][2][4][2];
DI void zero_acc(Acc& acc) {
#pragma unroll
    for (int a = 0; a < 2; ++a)
#pragma unroll
        for (int b = 0; b < 2; ++b)
#pragma unroll
            for (int m = 0; m < 4; ++m)
#pragma unroll
                for (int n = 0; n < 2; ++n) acc[a][b][m][n] = (f32x4){0.f, 0.f, 0.f, 0.f};
}

template <class Epi, bool ALIGN_EPI>
DI void gemm_phase(LAS unsigned char* lds, const Gemm g, const Sched& S, const Epi& E) {
    int tid; asm volatile("v_mov_b32 %0, %1" : "=v"(tid) : "v"((int)threadIdx.x));
    const int wid = __builtin_amdgcn_readfirstlane(tid >> 6), lane = tid & 63, wr = wid >> 2, wc = wid & 3, fr = lane & 15, fq = lane >> 4;
    unsigned voffA[2], voffB[2];
#pragma unroll
    for (int i = 0; i < 2; ++i) { int R, C; stage_rc(tid * 16 + i * 8192, R, C); const int Rb = Epi::PERM ? ((R & ~31) + perm32(R & 31)) : R;
        voffA[i] = (unsigned)(R * g.lda + C) * 2u; voffB[i] = (unsigned)(Rb * g.ldb + C) * 2u; }
    const size_t kstep = (size_t)(BK * 2);
    const size_t hstepA = (size_t)HALF * g.lda * 2, hstepB = (size_t)HALF * g.ldb * 2;
    const size_t tstepA = 2 * hstepA, tstepB = 2 * hstepB;
    const unsigned ldsw = (unsigned)wid * 1024u;
    const int aoff = lds_byte(wr * 64 + fr, fq * 8), boff = lds_byte(wc * 32 + fr, fq * 8);
#define PG8_SA(b, h) (((b) * 2 + (h)) * HTB)
#define PG8_SB(b, h) ((4 + (b) * 2 + (h)) * HTB)
#define PG8_STAGE(bufoff, gbase, voff) do { _Pragma("unroll") for (int _i = 0; _i < 2; ++_i) \
        __builtin_amdgcn_global_load_lds((const unsigned*)((const char*)(gbase) + (voff)[_i]), (LAS unsigned*)(lds + (bufoff) + ldsw + _i * 8192), 16, 0, 0); } while (0)
#define PG8_LDA(dst, b, h) do { _Pragma("unroll") for (int m = 0; m < 4; ++m) _Pragma("unroll") for (int k = 0; k < 2; ++k) dst[m][k] = *(const LAS bf16x8*)(lds + PG8_SA(b, h) + aoff + m * 2048 + k * 1024); } while (0)
#define PG8_LDB(dst, b, h) do { _Pragma("unroll") for (int n = 0; n < 2; ++n) _Pragma("unroll") for (int k = 0; k < 2; ++k) dst[n][k] = *(const LAS bf16x8*)(lds + PG8_SB(b, h) + boff + n * 2048 + k * 1024); } while (0)
#define PG8_MMA(ai, bj, At, Bt) do { __builtin_amdgcn_s_setprio(1); _Pragma("unroll") for (int m = 0; m < 4; ++m) _Pragma("unroll") for (int n = 0; n < 2; ++n) _Pragma("unroll") for (int k = 0; k < 2; ++k) \
        acc[ai][bj][m][n] = __builtin_amdgcn_mfma_f32_16x16x32_bf16(Bt[n][k], At[m][k], acc[ai][bj][m][n], 0, 0, 0); __builtin_amdgcn_s_setprio(0); } while (0)
#define PG8_WAIT_V(n) asm volatile("s_waitcnt vmcnt(" #n ")" ::: "memory")
#define PG8_WAIT_L(n) asm volatile("s_waitcnt lgkmcnt(" #n ")" ::: "memory")
#define PG8_BAR __builtin_amdgcn_s_barrier()
#define PG8_SCHED __builtin_amdgcn_sched_barrier(0)
    Unit cur, nxt; int ui = 0;
    if (!S.next(0, cur)) return;
    Acc acc;
    { int l2; asm volatile("v_mov_b32 %0, %1" : "=v"(l2) : "v"(lane)); E.init(acc, cur, wr, wc, l2 & 15, l2 >> 4); }
    PG8_WAIT_V(0);
    bf16x8 At[4][2], B0[2][2], B1[2][2];
    const char* cA = (const char*)g.A + (size_t)cur.pm * tstepA + (size_t)cur.koff * 2; const char* cB = (const char*)g.Bt + (size_t)cur.pn * tstepB + (size_t)cur.koff * 2;
    PG8_STAGE(PG8_SB(0, 0), cB, voffB); PG8_STAGE(PG8_SB(0, 1), cB + hstepB, voffB); PG8_STAGE(PG8_SA(0, 0), cA, voffA); PG8_STAGE(PG8_SA(0, 1), cA + hstepA, voffA);
    if (wr == 1) PG8_BAR;
    PG8_WAIT_V(2); PG8_BAR;
    PG8_STAGE(PG8_SB(1, 0), cB + kstep, voffB); PG8_STAGE(PG8_SA(1, 0), cA + kstep, voffA); PG8_STAGE(PG8_SB(1, 1), cB + hstepB + kstep, voffB);
    PG8_WAIT_V(6); PG8_BAR;
    for (;;) {
        const bool has_next = S.next(ui + 1, nxt);
        const char* nA = has_next ? (const char*)g.A + (size_t)nxt.pm * tstepA + (size_t)nxt.koff * 2 : cA;
        const char* nB = has_next ? (const char*)g.Bt + (size_t)nxt.pn * tstepB + (size_t)nxt.koff * 2 : cB;
        const int nt = cur.nt;
        for (int t = 0; t < nt; t += 2) {
            const bool last = (t == nt - 2);
            const char* a1 = cA + (size_t)(t + 1) * kstep;
            const char* a2 = last ? nA : cA + (size_t)(t + 2) * kstep; const char* b2 = last ? nB : cB + (size_t)(t + 2) * kstep;
            const char* a3 = a2 + kstep; const char* b3 = b2 + kstep;
            PG8_LDB(B0, 0, 0); PG8_LDB(B1, 0, 1); PG8_SCHED; PG8_LDA(At, 0, 0); PG8_STAGE(PG8_SA(1, 1), a1 + hstepA, voffA);
            PG8_WAIT_V(8); PG8_WAIT_L(0); PG8_BAR; PG8_MMA(0, 0, At, B0); PG8_MMA(0, 1, At, B1); PG8_BAR; PG8_SCHED;
            PG8_LDA(At, 0, 1); PG8_STAGE(PG8_SB(0, 0), b2, voffB); PG8_STAGE(PG8_SB(0, 1), b2 + hstepB, voffB); PG8_STAGE(PG8_SA(0, 0), a2, voffA);
            PG8_WAIT_V(8); PG8_WAIT_L(0); PG8_BAR; PG8_MMA(1, 0, At, B0); PG8_MMA(1, 1, At, B1); PG8_BAR; PG8_SCHED;
            PG8_LDB(B0, 1, 0); PG8_LDB(B1, 1, 1); PG8_SCHED; PG8_LDA(At, 1, 0); PG8_STAGE(PG8_SA(0, 1), a2 + hstepA, voffA);
            PG8_WAIT_V(8); PG8_WAIT_L(0); PG8_BAR; PG8_MMA(0, 0, At, B0); PG8_MMA(0, 1, At, B1); PG8_BAR; PG8_SCHED;
            PG8_LDA(At, 1, 1); PG8_STAGE(PG8_SB(1, 0), b3, voffB); PG8_STAGE(PG8_SB(1, 1), b3 + hstepB, voffB); PG8_STAGE(PG8_SA(1, 0), a3, voffA);
            PG8_WAIT_V(8); PG8_WAIT_L(0); PG8_BAR; PG8_MMA(1, 0, At, B0); PG8_MMA(1, 1, At, B1); PG8_BAR; PG8_SCHED;
        }
        if constexpr (ALIGN_EPI) { if (wr == 0) PG8_BAR; }
        int l2; asm volatile("v_mov_b32 %0, %1" : "=v"(l2) : "v"(lane));
        E(acc, cur, wr, wc, l2 & 15, l2 >> 4);
        if (!has_next) break;
        E.init(acc, nxt, wr, wc, l2 & 15, l2 >> 4);
        PG8_WAIT_V(0);
        cur = nxt; cA = nA; cB = nB; ++ui;
        if constexpr (ALIGN_EPI) { if (wr == 1) PG8_BAR; }
    }
    PG8_WAIT_V(0);
    if constexpr (!ALIGN_EPI) { if (wr == 0) PG8_BAR; }
    PG8_BAR;
#undef PG8_SA
#undef PG8_SB
#undef PG8_STAGE
#undef PG8_LDA
#undef PG8_LDB
#undef PG8_MMA
#undef PG8_WAIT_V
#undef PG8_WAIT_L
#undef PG8_BAR
#undef PG8_SCHED
}
}
using pg8::Acc; using pg8::Unit;

struct EpiZ {
    static constexpr bool PERM = false;
    bf16_t *ZQ, *ZS, *ZP, *KB, *VT, *YTL, *YTC; unsigned char* G8;
    const float *ropec, *ropes, *qg, *kg;
    DI void init(Acc& acc, const Unit&, int, int, int, int) const { pg8::zero_acc(acc); }
    DI void operator()(Acc& acc, const Unit& u, int wr, int wc, int fr, int fq) const {
        const bool isctx = u.pm >= 64;
        const int pn = u.pn;
        if (pn <= 2) {
            if (pn == 2 && wc >= 2) {
                const int g = wc - 2;
#pragma unroll
                for (int ai = 0; ai < 2; ++ai)
#pragma unroll
                    for (int m = 0; m < 4; ++m) {
                        const int r = u.pm * 256 + ai * 128 + wr * 64 + m * 16 + fr;
                        int b, pos; if (!isctx) { b = r >> 11; pos = r & 2047; } else { const int rc = r - ML; b = rc >> 8; pos = SEQ + (rc & 255); }
                        bf16_t* vb = VT + ((size_t)(b * 2 + g) * 64) * SKV + pos;
#pragma unroll
                        for (int bj = 0; bj < 2; ++bj)
#pragma unroll
                            for (int n = 0; n < 2; ++n) {
                                const f32x4 v = acc[ai][bj][m][n];
                                const unsigned p0 = cvtpk(v[0], v[1]), p1 = cvtpk(v[2], v[3]);
                                const int e = 32 * bj + 16 * n + 4 * fq;
                                vb[(size_t)(e + 0) * SKV] = (bf16_t)(p0 & 0xffff); vb[(size_t)(e + 1) * SKV] = (bf16_t)(p0 >> 16);
                                vb[(size_t)(e + 2) * SKV] = (bf16_t)(p1 & 0xffff); vb[(size_t)(e + 3) * SKV] = (bf16_t)(p1 >> 16);
                            }
                    }
                return;
            }
            const bool isq = pn < 2;
            const float* gain = isq ? qg : kg;
            const float osc = isq ? (0.125f * 1.4426950408889634f) : 1.0f;
#pragma unroll
            for (int ai = 0; ai < 2; ++ai)
#pragma unroll
                for (int m = 0; m < 4; ++m) {
                    const int r = u.pm * 256 + ai * 128 + wr * 64 + m * 16 + fr;
                    float ss = 0.f;
#pragma unroll
                    for (int bj = 0; bj < 2; ++bj)
#pragma unroll
                        for (int n = 0; n < 2; ++n) { const f32x4 v = acc[ai][bj][m][n]; ss += (v[0] * v[0] + v[1] * v[1]) + (v[2] * v[2] + v[3] * v[3]); }
                    ss += __shfl_xor(ss, 16); ss += __shfl_xor(ss, 32);
                    const float rinv = rsqrtf(ss * (1.0f / 64.0f) + EPS) * osc;
                    int b, pos, t = 0; if (!isctx) { b = r >> 11; pos = r & 2047; t = pos; } else { const int rc = r - ML; b = rc >> 8; pos = SEQ + (rc & 255); }
                    bf16_t* dst;
                    if (isq) dst = ZQ + (size_t)r * 512 + (pn * 4 + wc) * 64;
                    else dst = KB + ((size_t)(b * 2 + wc) * SKV + pos) * 64;
#pragma unroll
                    for (int bj = 0; bj < 2; ++bj) {
                        const f32x4 g0 = *(const f32x4*)(gain + 32 * bj + 4 * fq), g1 = *(const f32x4*)(gain + 32 * bj + 16 + 4 * fq);
                        f32x4 x0 = acc[ai][bj][m][0] * rinv * g0, x1 = acc[ai][bj][m][1] * rinv * g1;
                        if (!isctx) {
                            const f32x4 cs = *(const f32x4*)(ropec + (t * 2 + bj) * 16 + 4 * fq), sn = *(const f32x4*)(ropes + (t * 2 + bj) * 16 + 4 * fq);
                            const f32x4 o0 = x0 * cs - x1 * sn, o1 = x1 * cs + x0 * sn; x0 = o0; x1 = o1;
                        }
                        u32x2 w0, w1; w0.x = cvtpk(x0[0], x0[1]); w0.y = cvtpk(x0[2], x0[3]); w1.x = cvtpk(x1[0], x1[1]); w1.y = cvtpk(x1[2], x1[3]);
                        *(u32x2*)(dst + 32 * bj + 4 * fq) = w0; *(u32x2*)(dst + 32 * bj + 16 + 4 * fq) = w1;
                    }
                }
            return;
        }
#pragma unroll
        for (int ai = 0; ai < 2; ++ai)
#pragma unroll
            for (int m = 0; m < 4; ++m) {
                const int r = u.pm * 256 + ai * 128 + wr * 64 + m * 16 + fr;
                int b, t; if (!isctx) { b = r >> 11; t = r & 2047; } else { const int rc = r - ML; b = rc >> 8; t = rc & 255; }
#pragma unroll
                for (int bj = 0; bj < 2; ++bj)
#pragma unroll
                    for (int n = 0; n < 2; ++n) {
                        const f32x4 v = acc[ai][bj][m][n];
                        const int c = 128 * bj + 32 * wc + 16 * n + 4 * fq;
                        if (pn >= 9) {
                            unsigned w = 0;
#pragma unroll
                            for (int x = 0; x < 4; ++x) { const float s = sigmoidf_(v[x]); int q = (int)(s * 256.0f); q = q > 255 ? 255 : (q < 0 ? 0 : q); w |= (unsigned)q << (8 * x); }
                            *(unsigned*)(G8 + (size_t)r * 4096 + (pn - 9) * 256 + c) = w;
                        } else if (pn <= 5) {
                            u32x2 w; w.x = cvtpk(v[0], v[1]); w.y = cvtpk(v[2], v[3]);
                            *(u32x2*)(ZS + (size_t)r * 768 + (pn - 3) * 256 + c) = w;
                        } else if (pn == 8) {
                            u32x2 w; w.x = cvtpk(v[0], v[1]); w.y = cvtpk(v[2], v[3]);
                            *(u32x2*)(ZP + (size_t)r * 256 + c) = w;
                        } else {
                            const int cs = pn - 6;
                            const unsigned p0 = cvtpk(v[0], v[1]), p1 = cvtpk(v[2], v[3]);
                            bf16_t* y; size_t st;
                            if (!isctx) { y = YTL + ((size_t)(b * 256 + c) * 4096) + cs * 2048 + t; st = 4096; }
                            else { y = YTC + ((size_t)(b * 256 + c) * 512) + cs * 256 + t; st = 512; }
                            y[0] = (bf16_t)(p0 & 0xffff); y[st] = (bf16_t)(p0 >> 16); y[2 * st] = (bf16_t)(p1 & 0xffff); y[3 * st] = (bf16_t)(p1 >> 16);
                        }
                    }
            }
    }
};

struct EpiDft {
    static constexpr bool PERM = true;
    bf16_t* ACT4; int rowbase, nrows;
    DI void init(Acc& acc, const Unit&, int, int, int, int) const { pg8::zero_acc(acc); }
    DI void operator()(Acc& acc, const Unit& u, int wr, int wc, int fr, int fq) const {
#pragma unroll
        for (int ai = 0; ai < 2; ++ai)
#pragma unroll
            for (int m = 0; m < 4; ++m) {
                const int r = rowbase + u.pn * nrows + u.pm * 256 + ai * 128 + wr * 64 + m * 16 + fr;
#pragma unroll
                for (int bj = 0; bj < 2; ++bj) {
                    const f32x4 v0 = acc[ai][bj][m][0], v1 = acc[ai][bj][m][1];
                    u32x4 w; w.x = cvtpk(v0[0], v0[1]); w.y = cvtpk(v0[2], v0[3]); w.z = cvtpk(v1[0], v1[1]); w.w = cvtpk(v1[2], v1[3]);
                    *(u32x4*)(ACT4 + (size_t)r * 1280 + 768 + 128 * bj + 32 * wc + 8 * fq) = w;
                }
            }
    }
};

struct EpiBr {
    static constexpr bool PERM = true;
    const unsigned char* G8; bf16_t* Y; unsigned char* PY;
    DI void init(Acc& acc, const Unit&, int, int, int, int) const { pg8::zero_acc(acc); }
    DI void operator()(Acc& acc, const Unit& u, int wr, int wc, int fr, int fq) const {
        const unsigned char* ub = G8 + ((size_t)u.pm * 256 + wr * 64) * 4096 + u.tag * 1024 + u.pn * 256 + 32 * wc;
        const unsigned lo = (unsigned)(fr * 4096 + 8 * fq);
        unsigned char* pyb = PY + (size_t)((wr * 4 + wc) * 64 + fr + 16 * fq) * 16;
        bf16_t* yb = Y + ((size_t)u.pm * 256 + wr * 64) * 1024 + u.pn * 256 + 32 * wc;
        const unsigned yo = (unsigned)(fr * 1024 + 8 * fq);
#pragma unroll
        for (int ai = 0; ai < 2; ++ai) {
            u32x2 gw[4][2];
#pragma unroll
            for (int m = 0; m < 4; ++m)
#pragma unroll
                for (int bj = 0; bj < 2; ++bj) gw[m][bj] = *(const u32x2*)(ub + ((ai * 128 + m * 16) * 4096 + bj * 128) + lo);
#pragma unroll
            for (int m = 0; m < 4; ++m)
#pragma unroll
                for (int bj = 0; bj < 2; ++bj) {
                    f32x4 v[2];
#pragma unroll
                    for (int n = 0; n < 2; ++n) { const unsigned w = n ? gw[m][bj].y : gw[m][bj].x;
#pragma unroll
                        for (int x = 0; x < 4; ++x) { const float gq = ((float)((w >> (8 * x)) & 255u) + 0.5f) * (1.0f / 256.0f); v[n][x] = acc[ai][bj][m][n][x] * gq; } }
                    unsigned char* pp = pyb + (size_t)(((ai * 4 + m) * 2 + bj) * 512) * 16;
                    if (u.tag != 0) {
                        const u32x4 pv = *(const u32x4*)pp;
                        v[0][0] += bflo(pv.x); v[0][1] += bfhi(pv.x); v[0][2] += bflo(pv.y); v[0][3] += bfhi(pv.y);
                        v[1][0] += bflo(pv.z); v[1][1] += bfhi(pv.z); v[1][2] += bflo(pv.w); v[1][3] += bfhi(pv.w);
                    }
                    u32x4 w; w.x = cvtpk(v[0][0], v[0][1]); w.y = cvtpk(v[0][2], v[0][3]); w.z = cvtpk(v[1][0], v[1][1]); w.w = cvtpk(v[1][2], v[1][3]);
                    if (u.tag != 3) *(u32x4*)pp = w;
                    else *(u32x4*)(yb + ((ai * 128 + m * 16) * 1024 + bj * 128) + yo) = w;
                }
        }
    }
};

struct EpiRes {
    static constexpr bool PERM = false;
    const float* srcL; float* dstL; const float* srcC; float* dstC; const float* gates;
    DI void init(Acc& acc, const Unit&, int, int, int, int) const { pg8::zero_acc(acc); }
    DI void operator()(Acc& acc, const Unit& u, int wr, int wc, int fr, int fq) const {
        const bool isctx = u.pm >= 64;
        const size_t rb = isctx ? ((size_t)(u.pm - 64) * 256 + wr * 64) : ((size_t)u.pm * 256 + wr * 64);
        const float* sb = (isctx ? srcC : srcL) + rb * D + u.pn * 256 + 32 * wc;
        float* db = (isctx ? dstC : dstL) + rb * D + u.pn * 256 + 32 * wc;
        const float* gb = gates + (size_t)(isctx ? 8 : (u.pm >> 3)) * 6144 + u.pn * 256 + 32 * wc;
        const unsigned lo = (unsigned)(fr * D + 4 * fq), go = (unsigned)(4 * fq);
#pragma unroll
        for (int ai = 0; ai < 2; ++ai)
#pragma unroll
            for (int m = 0; m < 4; ++m) {
#pragma unroll
                for (int bj = 0; bj < 2; ++bj)
#pragma unroll
                    for (int n = 0; n < 2; ++n) {
                        const int co = (ai * 128 + m * 16) * D + bj * 128 + n * 16;
                        const f32x4 s = *(const f32x4*)(sb + co + lo), gg = *(const f32x4*)(gb + (bj * 128 + n * 16) + go);
                        *(f32x4*)(db + co + lo) = s + gg * acc[ai][bj][m][n];
                    }
                if (m == 3) asm volatile("" ::: "memory");
            }
    }
};

struct EpiUp {
    static constexpr bool PERM = true;
    bf16_t* ACT; bf16_t* RAW; const float* wconv;
    DI void init(Acc& acc, const Unit&, int, int, int, int) const { pg8::zero_acc(acc); }
    DI void operator()(Acc& acc, const Unit& u, int wr, int wc, int fr, int fq) const {
        const int lane = fr + 16 * fq;
        const int jl = 32 * wc + 8 * fq;
        const int ja = u.pn * 128 + jl;
        bf16_t* ab = ACT + ((size_t)u.pm * 256 + wr * 64) * DFF + u.pn * 128 + 32 * wc;
        const unsigned alo = (unsigned)(fr * DFF + 8 * fq);
#pragma unroll
        for (int ai = 0; ai < 2; ++ai) {
            const int rbase = u.pm * 256 + ai * 128 + wr * 64;
#pragma unroll
            for (int m = 0; m < 4; m += 3) {
                const bool dump = (m == 0) ? (fr < 2) : (fr >= 14);
                if (dump) {
                    const int slot = (m == 0) ? (2 + fr) : (fr - 14);
                    bf16_t* rw = RAW + ((size_t)(rbase >> 6) * 4 + slot) * UPW;
#pragma unroll
                    for (int bj = 0; bj < 2; ++bj) {
                        const f32x4 v0 = acc[ai][bj][m][0], v1 = acc[ai][bj][m][1];
                        u32x4 w; w.x = cvtpk(v0[0], v0[1]); w.y = cvtpk(v0[2], v0[3]); w.z = cvtpk(v1[0], v1[1]); w.w = cvtpk(v1[2], v1[3]);
                        *(u32x4*)(rw + bj * DFF + ja) = w;
                    }
                }
            }
#pragma unroll
            for (int n = 0; n < 2; ++n) {
#pragma unroll
                for (int xp = 0; xp < 2; ++xp) {
                    float act[4][2];
#pragma unroll
                    for (int xx = 0; xx < 2; ++xx) {
                        const int x = 2 * xp + xx;
                        float ca[4], cb[4];
#pragma unroll
                        for (int bj = 0; bj < 2; ++bj) {
                            const float* wp = wconv + bj * DFF + ja + 4 * n + x;
                            const float w0 = wp[0], w1 = wp[UPW], w2 = wp[2 * UPW];
                            float R[4], L[4];
#pragma unroll
                            for (int m = 0; m < 4; ++m) { const int vi = __float_as_int(acc[ai][bj][m][n][x]);
                                R[m] = __int_as_float(__builtin_amdgcn_update_dpp(vi, vi, 0x121, 0xF, 0xF, false));
                                L[m] = __int_as_float(__builtin_amdgcn_update_dpp(vi, vi, 0x12F, 0xF, 0xF, false)); }
#pragma unroll
                            for (int m = 0; m < 4; ++m) {
                                const float up = (fr > 0) ? R[m] : (m > 0 ? R[m > 0 ? m - 1 : 0] : 0.f);
                                const float dn = (fr < 15) ? L[m] : (m < 3 ? L[m < 3 ? m + 1 : 3] : 0.f);
                                const float cv = w0 * up + w1 * acc[ai][bj][m][n][x] + w2 * dn;
                                if (bj == 0) ca[m] = cv; else cb[m] = cv;
                            }
                        }
#pragma unroll
                        for (int m = 0; m < 4; ++m) act[m][xx] = ca[m] * sigmoidf_(ca[m]) * cb[m];
                    }
#pragma unroll
                    for (int m = 0; m < 4; ++m) {
                        const bool skip = (m == 0 && fr == 0) || (m == 3 && fr == 15);
                        if (!skip) *(unsigned*)(ab + ((ai * 128 + m * 16) * DFF + 4 * n + 2 * xp) + alo) = cvtpk(act[m][0], act[m][1]);
                    }
                    asm volatile("" ::: "memory");
                }
            }
        }
    }
};

DI void transpose_item(const float* W, int ldn, int k0, int n0, bf16_t* WT, int drow0, int ldd, int koff, LAS float* scr, int lane) {
#pragma unroll 8
    for (int i = 0; i < 32; ++i) { const int kk = 2 * i + (lane >> 5); scr[kk * 33 + (lane & 31)] = W[(size_t)(k0 + kk) * ldn + n0 + (lane & 31)]; }
    asm volatile("s_waitcnt lgkmcnt(0)" ::: "memory");
    const int c = lane & 7;
#pragma unroll
    for (int j = 0; j < 4; ++j) { const int n = (lane >> 3) + 8 * j; const LAS float* s = scr + (8 * c) * 33 + n;
        u32x4 o; o.x = cvtpk(s[0 * 33], s[1 * 33]); o.y = cvtpk(s[2 * 33], s[3 * 33]); o.z = cvtpk(s[4 * 33], s[5 * 33]); o.w = cvtpk(s[6 * 33], s[7 * 33]);
        *(u32x4*)(WT + (size_t)(drow0 + n) * ldd + koff + k0 + 8 * c) = o; }
    asm volatile("s_waitcnt lgkmcnt(0)" ::: "memory");
}
DI int win_dest(int n0) {
    if (n0 < 768) { const int tile = n0 >> 8, within = n0 & 255, hd = within >> 6, e = within & 63; return tile * 256 + 128 * (e >> 5) + 32 * hd + (e & 31); }
    if (n0 < 1536) return n0;
    if (n0 < 1792) return -1;
    return n0 + 256;
}
DI int wup_dest(int n0) { if (n0 < DFF) return 256 * (n0 >> 7) + (n0 & 127); const int j = n0 - DFF; return 256 * (j >> 7) + 128 + (j & 127); }

DI void conv_mixer(int l, LAS unsigned char* lds, int G) {
    KP q = getp(); unsigned char* ws = q->ws;
    const int tid = tid_(), lane = tid & 63, wave = tid >> 6;
    const int gw = blockIdx.x * 8 + wave, NGW = G * 8;
    LAS float* scr = (LAS float*)(lds + wave * 8448);
    bf16_t* WinT = (bf16_t*)(ws + WS_WIN); bf16_t* WbrT = (bf16_t*)(ws + WS_WBR); bf16_t* WoutT = (bf16_t*)(ws + WS_WOUT);
    const float* w_in = q->in[8] + (size_t)l * D * INW;
    constexpr int I_IN = 16 * 192, I_BA = 8 * 32, I_BS = 4 * 32, I_O = 16 * 32;
    constexpr int NIT = I_IN + I_BA + 2 * I_BS + I_O;
    for (int it = gw; it < NIT; it += NGW) {
        int r = it;
        if (r < I_IN) { const int kb = r / 192, nb = r % 192, n0 = nb * 32, d = win_dest(n0); if (d >= 0) transpose_item(w_in, INW, kb * 64, n0, WinT, d, 1024, 0, scr, lane); continue; } r -= I_IN;
        if (r < I_BA) { const int kb = r / 32, nb = r % 32; transpose_item(q->in[13] + (size_t)l * 512 * D, D, kb * 64, nb * 32, WbrT, nb * 32, 1280, 0, scr, lane); continue; } r -= I_BA;
        if (r < I_BS) { const int kb = r / 32, nb = r % 32; transpose_item(q->in[14] + (size_t)l * 256 * D, D, kb * 64, nb * 32, WbrT, nb * 32, 1280, 512, scr, lane); continue; } r -= I_BS;
        if (r < I_BS) { const int kb = r / 32, nb = r % 32; transpose_item(q->in[15] + (size_t)l * 256 * D, D, kb * 64, nb * 32, WbrT, nb * 32, 1280, 768, scr, lane); continue; } r -= I_BS;
        { const int kb = r / 32, nb = r % 32; transpose_item(q->in[17] + (size_t)l * D * D, D, kb * 64, nb * 32, WoutT, nb * 32, 1024, 0, scr, lane); }
    }
    __syncthreads();
    LAS float* tab = (LAS float*)(lds + 8 * 8448);
    if (tid < 64) { float s, c; sincospif((float)tid * (1.0f / 32.0f), &s, &c); tab[tid] = c; tab[64 + tid] = s; }
    __syncthreads();
    const int gt = blockIdx.x * 512 + tid, NGT = G * 512;
    for (int e = gt; e < 512 * 1024; e += NGT) {
        const int k = e & 1023, nrow = e >> 10, cs = nrow >> 8, g = (nrow >> 6) & 3, k2 = nrow & 63;
        const float* src = w_in + (size_t)k * INW + 1536 + g * 64;
        const LAS float* tb = tab + cs * 64;
        float a = 0.f;
#pragma unroll 4
        for (int c4 = 0; c4 < 16; ++c4) { const f32x4 v = *(const f32x4*)(src + 4 * c4);
#pragma unroll
            for (int x = 0; x < 4; ++x) a += v[x] * tb[(k2 * (4 * c4 + x)) & 63]; }
        WinT[(size_t)(1536 + nrow) * 1024 + k] = (bf16_t)(cvtpk(a * 0.125f, 0.f) & 0xffff);
    }
    const float* pm = q->in[11] + (size_t)l * 4 * 64 * 64; const float* psc = q->in[12] + (size_t)l * 256; const float* wp = q->in[16] + (size_t)l * 256 * D;
    for (int e = gt; e < 256 * 1024; e += NGT) {
        const int n = e & 1023, gc = e >> 10, g = gc >> 6;
        float a = 0.f;
#pragma unroll 8
        for (int d = 0; d < 64; ++d) a += pm[(size_t)gc * 64 + d] * psc[g * 64 + d] * wp[(size_t)(g * 64 + d) * D + n];
        WbrT[(size_t)n * 1280 + 1024 + gc] = (bf16_t)(cvtpk(a, 0.f) & 0xffff);
    }
    __syncthreads();
}

DI void conv_ffn(int l, LAS unsigned char* lds, int G) {
    KP q = getp(); unsigned char* ws = q->ws;
    const int tid = tid_(), lane = tid & 63, wave = tid >> 6;
    const int gw = blockIdx.x * 8 + wave, NGW = G * 8;
    LAS float* scr = (LAS float*)(lds + wave * 8448);
    bf16_t* WupT = (bf16_t*)(ws + WS_WUP); bf16_t* WdnT = (bf16_t*)(ws + WS_WDN);
    constexpr int I_U = 16 * 176, I_D = 44 * 32;
    for (int it = gw; it < I_U + I_D; it += NGW) {
        int r = it;
        if (r < I_U) { const int kb = r / 176, nb = r % 176, n0 = nb * 32; transpose_item(q->in[18] + (size_t)l * D * UPW, UPW, kb * 64, n0, WupT, wup_dest(n0), 1024, 0, scr, lane); continue; } r -= I_U;
        { const int kb = r / 32, nb = r % 32; transpose_item(q->in[20] + (size_t)l * DFF * D, D, kb * 64, nb * 32, WdnT, nb * 32, DFF, 0, scr, lane); }
    }
}

DI void norm_rows2(const float* x0, const float* x1, const float* gain, const float* md0, const float* md1, int si, bf16_t* o0, bf16_t* o1, int lane) {
    const f32x4* xr0 = (const f32x4*)x0 + lane; const f32x4* xr1 = (const f32x4*)x1 + lane;
    f32x4 v0[4], v1[4]; float s0 = 0.f, s1 = 0.f;
#pragma unroll
    for (int j = 0; j < 4; ++j) { v0[j] = xr0[64 * j]; v1[j] = xr1[64 * j]; }
#pragma unroll
    for (int j = 0; j < 4; ++j) { s0 += (v0[j][0] * v0[j][0] + v0[j][1] * v0[j][1]) + (v0[j][2] * v0[j][2] + v0[j][3] * v0[j][3]); s1 += (v1[j][0] * v1[j][0] + v1[j][1] * v1[j][1]) + (v1[j][2] * v1[j][2] + v1[j][3] * v1[j][3]); }
    const float r0 = rsqrtf(wave_sum(s0) * (1.0f / D) + EPS), r1 = rsqrtf(wave_sum(s1) * (1.0f / D) + EPS);
#pragma unroll
    for (int j = 0; j < 4; ++j) {
        const int c = 256 * j + 4 * lane;
        const f32x4 g = *(const f32x4*)(gain + c);
        const f32x4 sh0 = *(const f32x4*)(md0 + si * 1024 + c), sc0 = *(const f32x4*)(md0 + (si + 1) * 1024 + c);
        const f32x4 sh1 = *(const f32x4*)(md1 + si * 1024 + c), sc1 = *(const f32x4*)(md1 + (si + 1) * 1024 + c);
        const f32x4 h0 = ((v0[j] * r0) * g) * (1.0f + sc0) + sh0, h1 = ((v1[j] * r1) * g) * (1.0f + sc1) + sh1;
        u32x2 w0; w0.x = cvtpk(h0[0], h0[1]); w0.y = cvtpk(h0[2], h0[3]);
        u32x2 w1; w1.x = cvtpk(h1[0], h1[1]); w1.y = cvtpk(h1[2], h1[3]);
        *(u32x2*)(o0 + c) = w0; *(u32x2*)(o1 + c) = w1;
    }
}
DI void norm_phase(const float* srcL, const float* srcC, bool do_ctx, const float* gain, const float* mods, int si, bf16_t* H, int G) {
    const int tid = tid_(), lane = tid & 63, wave = tid >> 6;
    const int gw = blockIdx.x * 8 + wave, NGW = G * 8;
    const int nrows = do_ctx ? MT : ML;
    for (int r = 2 * gw; r < nrows; r += 2 * NGW) {
        const float *x0, *x1, *md0, *md1;
        if (r < ML) { x0 = srcL + (size_t)r * D; md0 = mods + (size_t)(r >> 11) * 6144; x1 = x0 + D; md1 = md0; }
        else { x0 = srcC + (size_t)(r - ML) * D; md0 = mods + (size_t)8 * 6144; x1 = x0 + D; md1 = md0; }
        norm_rows2(x0, x1, gain, md0, md1, si, H + (size_t)r * D, H + (size_t)(r + 1) * D, lane);
    }
}

DI void attn_qk(f32x16& p0, f32x16& p1, const LAS unsigned char* kl, const bf16x8 (&qf)[4], int r32, int h) {
    constexpr int PITCH = 144;
#pragma unroll
    for (int i = 0; i < 16; ++i) { p0[i] = 0.f; p1[i] = 0.f; }
#pragma unroll
    for (int s = 0; s < 4; ++s) {
        const bf16x8 ka = *(const LAS bf16x8*)(kl + r32 * PITCH + (16 * s + 8 * h) * 2);
        const bf16x8 kb2 = *(const LAS bf16x8*)(kl + (32 + r32) * PITCH + (16 * s + 8 * h) * 2);
        p0 = __builtin_amdgcn_mfma_f32_32x32x16_bf16(ka, qf[s], p0, 0, 0, 0);
        p1 = __builtin_amdgcn_mfma_f32_32x32x16_bf16(kb2, qf[s], p1, 0, 0, 0);
    }
}
#define ATTN_ITER(FAST, t, PC0, PC1, PN0, PN1, KW, VW, KL, VL) do { \
        const int cur = (t) & 1; \
        if ((t) + 3 < nkt) KL = *(const u32x4*)(kbase + ((size_t)((t) + 3) * 64 + srow) * 64 + sch * 8); \
        if ((t) + 2 < nkt) VL = *(const u32x4*)(vbase + (size_t)srow * SKV + ((t) + 2) * 64 + sch * 8); \
        if ((t) + 1 < nkt) attn_qk(PN0, PN1, lds + (cur ^ 1) * TB, qf, r32, h); \
        if (FAST) {                                           \
            f32x2_t rs = {0.f, 0.f}; \
            _Pragma("unroll") for (int i = 0; i < 16; i += 2) { \
                f32x2_t a0, a1; \
                a0.x = __builtin_amdgcn_exp2f(PC0[i]); a0.y = __builtin_amdgcn_exp2f(PC0[i + 1]); a1.x = __builtin_amdgcn_exp2f(PC1[i]); a1.y = __builtin_amdgcn_exp2f(PC1[i + 1]); \
                PC0[i] = a0.x; PC0[i + 1] = a0.y; PC1[i] = a1.x; PC1[i + 1] = a1.y; rs += a0 + a1; } \
            l_run += rs.x + rs.y; \
        } else { \
        float mx0 = fmaxf(PC0[0], PC1[0]), mx1 = fmaxf(PC0[1], PC1[1]); \
        _Pragma("unroll") for (int i = 2; i < 16; i += 2) { mx0 = fmaxf(mx0, fmaxf(PC0[i], PC1[i])); mx1 = fmaxf(mx1, fmaxf(PC0[i + 1], PC1[i + 1])); } \
        float mx = fmaxf(mx0, mx1); \
        mx = fmaxf(mx, __shfl_xor(mx, 32)); \
        const float m_new = fmaxf(m_run, mx); \
        const float alpha = __builtin_amdgcn_exp2f(m_run - m_new); \
        m_run = m_new; \
        const f32x2_t mm = {m_new, m_new}; \
        f32x2_t rs = {0.f, 0.f}; \
        _Pragma("unroll") for (int i = 0; i < 16; i += 2) { \
            f32x2_t a0 = (f32x2_t){PC0[i], PC0[i + 1]} - mm, a1 = (f32x2_t){PC1[i], PC1[i + 1]} - mm; \
            a0.x = __builtin_amdgcn_exp2f(a0.x); a0.y = __builtin_amdgcn_exp2f(a0.y); a1.x = __builtin_amdgcn_exp2f(a1.x); a1.y = __builtin_amdgcn_exp2f(a1.y); \
            PC0[i] = a0.x; PC0[i + 1] = a0.y; PC1[i] = a1.x; PC1[i + 1] = a1.y; rs += a0 + a1; } \
        l_run = l_run * alpha + (rs.x + rs.y); \
        _Pragma("unroll") for (int i = 0; i < 16; ++i) { o0[i] *= alpha; o1[i] *= alpha; } \
        } \
        const LAS unsigned char* vl = lds + 2 * TB + cur * TB; \
        _Pragma("unroll") for (int kb = 0; kb < 2; ++kb) \
        _Pragma("unroll") for (int s2 = 0; s2 < 2; ++s2) { \
                u32x4 pw; \
                if (kb == 0) { pw.x = cvtpk(PC0[8 * s2 + 0], PC0[8 * s2 + 1]); pw.y = cvtpk(PC0[8 * s2 + 2], PC0[8 * s2 + 3]); pw.z = cvtpk(PC0[8 * s2 + 4], PC0[8 * s2 + 5]); pw.w = cvtpk(PC0[8 * s2 + 6], PC0[8 * s2 + 7]); } \
                else { pw.x = cvtpk(PC1[8 * s2 + 0], PC1[8 * s2 + 1]); pw.y = cvtpk(PC1[8 * s2 + 2], PC1[8 * s2 + 3]); pw.z = cvtpk(PC1[8 * s2 + 4], PC1[8 * s2 + 5]); pw.w = cvtpk(PC1[8 * s2 + 6], PC1[8 * s2 + 7]); } \
                const bf16x8 pb = __builtin_bit_cast(bf16x8, pw); \
                const int kk = 32 * kb + 16 * s2 + 4 * h; \
                { const u32x2 lo = *(const LAS u32x2*)(vl + r32 * PITCH + kk * 2), hi = *(const LAS u32x2*)(vl + r32 * PITCH + (kk + 8) * 2); \
                  u32x4 vw; vw.x = lo.x; vw.y = lo.y; vw.z = hi.x; vw.w = hi.y; \
                  o0 = __builtin_amdgcn_mfma_f32_32x32x16_bf16(__builtin_bit_cast(bf16x8, vw), pb, o0, 0, 0, 0); } \
                { const u32x2 lo = *(const LAS u32x2*)(vl + (32 + r32) * PITCH + kk * 2), hi = *(const LAS u32x2*)(vl + (32 + r32) * PITCH + (kk + 8) * 2); \
                  u32x4 vw; vw.x = lo.x; vw.y = lo.y; vw.z = hi.x; vw.w = hi.y; \
                  o1 = __builtin_amdgcn_mfma_f32_32x32x16_bf16(__builtin_bit_cast(bf16x8, vw), pb, o1, 0, 0, 0); } \
            } \
        if ((t) + 2 < nkt) *(LAS u32x4*)(lds + cur * TB + soff) = KW;                   \
        if ((t) + 1 < nkt) *(LAS u32x4*)(lds + 2 * TB + (cur ^ 1) * TB + soff) = VW;    \
        __syncthreads(); \
    } while (0)

DI void attn_unit(LAS unsigned char* lds, const bf16_t* ZQ, const bf16_t* KB, const bf16_t* VT, bf16_t* ACT4, int b, int g, int qrow0, int key0, int nkt, bool fast) {
    const int tid = tid_(), wave = tid >> 6, lane = tid & 63, r32 = lane & 31, h = lane >> 5;
    const int head = g * 4 + (wave >> 1);
    const int qrow = qrow0 + (wave & 1) * 32 + r32;
    constexpr int PITCH = 144, TB = 64 * PITCH;
    bf16x8 qf[4];
#pragma unroll
    for (int s = 0; s < 4; ++s) qf[s] = *(const bf16x8*)(ZQ + (size_t)qrow * 512 + head * 64 + 16 * s + 8 * h);
    f32x16 o0, o1;
#pragma unroll
    for (int i = 0; i < 16; ++i) { o0[i] = 0.f; o1[i] = 0.f; }
    float m_run = -1e30f, l_run = 0.f;
    const bf16_t* kbase = KB + ((size_t)(b * 2 + g) * SKV + key0) * 64;
    const bf16_t* vbase = VT + ((size_t)(b * 2 + g) * 64) * SKV + key0;
    const int srow = tid >> 3, sch = tid & 7;
    const unsigned soff = (unsigned)(srow * PITCH + sch * 16);
    u32x4 kA = *(const u32x4*)(kbase + (size_t)srow * 64 + sch * 8);
    u32x4 vA = *(const u32x4*)(vbase + (size_t)srow * SKV + sch * 8);
    u32x4 kB = *(const u32x4*)(kbase + ((size_t)64 + srow) * 64 + sch * 8);
    u32x4 vB;
    __syncthreads();
    *(LAS u32x4*)(lds + soff) = kA;
    *(LAS u32x4*)(lds + 2 * TB + soff) = vA;
    *(LAS u32x4*)(lds + TB + soff) = kB;
    if (nkt > 2) kA = *(const u32x4*)(kbase + ((size_t)128 + srow) * 64 + sch * 8);
    vA = *(const u32x4*)(vbase + (size_t)srow * SKV + 64 + sch * 8);
    vB = vA; kB = kA;
    __syncthreads();
    f32x16 pa0, pa1, pb0, pb1;
    attn_qk(pa0, pa1, lds, qf, r32, h);
#pragma unroll
    for (int i = 0; i < 16; ++i) { pb0[i] = 0.f; pb1[i] = 0.f; }
    if (fast) {
#pragma nounroll
        for (int t = 0; t < nkt; t += 2) {
            ATTN_ITER(true, t, pa0, pa1, pb0, pb1, kA, vA, kB, vB);
            ATTN_ITER(true, t + 1, pb0, pb1, pa0, pa1, kB, vB, kA, vA);
        }
    } else {
#pragma nounroll
        for (int t = 0; t < nkt; t += 2) {
            ATTN_ITER(false, t, pa0, pa1, pb0, pb1, kA, vA, kB, vB);
            ATTN_ITER(false, t + 1, pb0, pb1, pa0, pa1, kB, vB, kA, vA);
        }
    }
    const float lt = l_run + __shfl_xor(l_run, 32);
    const float inv = 1.0f / lt;
    bf16_t* orow = ACT4 + (size_t)qrow * 1280 + head * 64;
#pragma unroll
    for (int g4 = 0; g4 < 4; ++g4) {
        u32x2 w; w.x = cvtpk(o0[4 * g4] * inv, o0[4 * g4 + 1] * inv); w.y = cvtpk(o0[4 * g4 + 2] * inv, o0[4 * g4 + 3] * inv);
        *(u32x2*)(orow + 8 * g4 + 4 * h) = w;
        u32x2 w2; w2.x = cvtpk(o1[4 * g4] * inv, o1[4 * g4 + 1] * inv); w2.y = cvtpk(o1[4 * g4 + 2] * inv, o1[4 * g4 + 3] * inv);
        *(u32x2*)(orow + 32 + 8 * g4 + 4 * h) = w2;
    }
}

DI void scpool_phase(const bf16_t* ZS, const bf16_t* ZP, bf16_t* ACT4, const float* convw, int nrows, int G) {
    const int tid = tid_(), lane = tid & 63, wave = tid >> 6;
    const int gw = blockIdx.x * 8 + wave, NGW = G * 8;
    for (int r = gw; r < nrows; r += NGW) {
        int t, N; if (r < ML) { t = r & 2047; N = SEQ; } else { t = (r - ML) & 255; N = CTXL; }
        if (lane < 32) {
            const int c = lane * 8;
            float a[8];
#pragma unroll
            for (int j = 0; j < 8; ++j) a[j] = 0.f;
#pragma unroll
            for (int dt = -1; dt <= 1; ++dt) {
                if (t + dt >= 0 && t + dt < N) {
                    const bf16_t* row = ZS + (size_t)(r + dt) * 768;
                    const u32x4 gc = *(const u32x4*)(row + 256 + c), xs = *(const u32x4*)(row + 512 + c);
                    const f32x4 w0 = *(const f32x4*)(convw + (dt + 1) * 256 + c), w1 = *(const f32x4*)(convw + (dt + 1) * 256 + c + 4);
                    a[0] += w0[0] * bflo(gc.x) * bflo(xs.x); a[1] += w0[1] * bfhi(gc.x) * bfhi(xs.x);
                    a[2] += w0[2] * bflo(gc.y) * bflo(xs.y); a[3] += w0[3] * bfhi(gc.y) * bfhi(xs.y);
                    a[4] += w1[0] * bflo(gc.z) * bflo(xs.z); a[5] += w1[1] * bfhi(gc.z) * bfhi(xs.z);
                    a[6] += w1[2] * bflo(gc.w) * bflo(xs.w); a[7] += w1[3] * bfhi(gc.w) * bfhi(xs.w);
                }
            }
            const u32x4 gb = *(const u32x4*)(ZS + (size_t)r * 768 + c);
            u32x4 w; w.x = cvtpk(bflo(gb.x) * a[0], bfhi(gb.x) * a[1]); w.y = cvtpk(bflo(gb.y) * a[2], bfhi(gb.y) * a[3]);
            w.z = cvtpk(bflo(gb.z) * a[4], bfhi(gb.z) * a[5]); w.w = cvtpk(bflo(gb.w) * a[6], bfhi(gb.w) * a[7]);
            *(u32x4*)(ACT4 + (size_t)r * 1280 + 512 + c) = w;
        } else {
            const int c = (lane - 32) * 8, gi = c >> 6, wdw = 2 << gi, left = (wdw - 1) >> 1, right = wdw >> 1;
            const int lo = (t - left) > 0 ? (t - left) : 0, hi = (t + right + 1) < N ? (t + right + 1) : N;
            float a[8];
#pragma unroll
            for (int j = 0; j < 8; ++j) a[j] = 0.f;
            u32x4 pv[16];
#pragma unroll
            for (int i = 0; i < 16; ++i) { int tt = lo + i; tt = tt < hi ? tt : (hi - 1); pv[i] = *(const u32x4*)(ZP + (size_t)(r - t + tt) * 256 + c); }
#pragma unroll
            for (int i = 0; i < 16; ++i) if (lo + i < hi) {
                const u32x4 v = pv[i];
                a[0] += bflo(v.x); a[1] += bfhi(v.x); a[2] += bflo(v.y); a[3] += bfhi(v.y); a[4] += bflo(v.z); a[5] += bfhi(v.z); a[6] += bflo(v.w); a[7] += bfhi(v.w);
            }
            const float ic = 1.0f / (float)(hi - lo);
            const u32x4 x = *(const u32x4*)(ZP + (size_t)r * 256 + c);
            u32x4 w; w.x = cvtpk(a[0] * ic - bflo(x.x), a[1] * ic - bfhi(x.x)); w.y = cvtpk(a[2] * ic - bflo(x.y), a[3] * ic - bfhi(x.y));
            w.z = cvtpk(a[4] * ic - bflo(x.z), a[5] * ic - bfhi(x.z)); w.w = cvtpk(a[6] * ic - bflo(x.w), a[7] * ic - bfhi(x.w));
            *(u32x4*)(ACT4 + (size_t)r * 1280 + 1024 + c) = w;
        }
    }
}

DI void fixup_phase(const bf16_t* RAW, bf16_t* ACT, const float* wconv, int nchunks, int G) {
    const int tid = tid_();
    for (int it = blockIdx.x; it < nchunks * 2; it += G) {
        const int ch = it >> 1, which = it & 1;
        const int r = ch * 64 + (which ? 63 : 0);
        int t, N; if (r < ML) { t = r & 2047; N = SEQ; } else { t = (r - ML) & 255; N = CTXL; }
        const bf16_t *up, *mid, *dn;
        if (!which) { up = (t > 0) ? RAW + ((size_t)(ch - 1) * 4 + 1) * UPW : nullptr; mid = RAW + ((size_t)ch * 4 + 2) * UPW; dn = RAW + ((size_t)ch * 4 + 3) * UPW; }
        else { up = RAW + ((size_t)ch * 4 + 0) * UPW; mid = RAW + ((size_t)ch * 4 + 1) * UPW; dn = (t < N - 1) ? RAW + ((size_t)(ch + 1) * 4 + 2) * UPW : nullptr; }
        for (int j = tid; j < DFF; j += 512) {
            const float ua = up ? bflo(up[j]) : 0.f, ub = up ? bflo(up[DFF + j]) : 0.f;
            const float ma = bflo(mid[j]), mb = bflo(mid[DFF + j]);
            const float da = dn ? bflo(dn[j]) : 0.f, db = dn ? bflo(dn[DFF + j]) : 0.f;
            const float ca = wconv[j] * ua + wconv[UPW + j] * ma + wconv[2 * UPW + j] * da;
            const float cb = wconv[DFF + j] * ub + wconv[UPW + DFF + j] * mb + wconv[2 * UPW + DFF + j] * db;
            ACT[(size_t)r * DFF + j] = (bf16_t)(cvtpk(ca * sigmoidf_(ca) * cb, 0.f) & 0xffff);
        }
    }
}

#define XB_TMO      128
#define XB_XCNT(j)  (256  + 64 * (j))
#define XB_XSUB(j)  (1280 + 64 * (j))
#define XB_XGEN(j)  (2304 + 64 * (j))
#define XB_TOP      3328
#define XB_TOPGEN   3392
#define XCD_BAR_WORDS 3456
#define XB_SPIN_CAP (1u << 22)
DI unsigned xb_ld(unsigned* p)              { return __hip_atomic_load(p, __ATOMIC_RELAXED, __HIP_MEMORY_SCOPE_AGENT); }
DI unsigned xb_add(unsigned* p, unsigned v) { return __hip_atomic_fetch_add(p, v, __ATOMIC_RELAXED, __HIP_MEMORY_SCOPE_AGENT); }
DI unsigned xb_xcc_id() { return (unsigned)__builtin_amdgcn_s_getreg((3 << 11) | 20) & 0xFu; }
#define XB_SPIN(cond, bar) do { unsigned _sp = 0; while (cond) { __builtin_amdgcn_s_sleep(1); \
    if ((++_sp & 255u) == 0u) { if (xb_ld(&(bar)[XB_TMO])) break; if (_sp > XB_SPIN_CAP) { atomicAdd(&(bar)[XB_TMO], 1u); break; } } } } while (0)
DI void xcd_barrier_complete(unsigned* bar, unsigned x, unsigned& nloc, unsigned& nx) {
    const unsigned G = gridDim.x * gridDim.y * gridDim.z;
    unsigned sum, cnt, mine, sp = 0u;
    for (;;) {
        sum = 0u; cnt = 0u; mine = 0u;
#pragma unroll
        for (unsigned j = 0; j < 16; ++j) { const unsigned c = xb_ld(&bar[XB_XCNT(j)]); sum += c; cnt += (c > 0u) ? 1u : 0u; mine = (j == x) ? c : mine; }
        if (sum == G) break;
        __builtin_amdgcn_s_sleep(1);
        if ((++sp & 255u) == 0u) { if (xb_ld(&bar[XB_TMO])) break; if (sp > XB_SPIN_CAP) { atomicAdd(&bar[XB_TMO], 1u); break; } }
    }
    nloc = mine > 0u ? mine : 1u; nx = cnt > 0u ? cnt : 1u;
}
DI void xb_post(unsigned* bar) { if (threadIdx.x == 0) (void)xb_add(&bar[XB_XCNT(xb_xcc_id())], 1u); }
DI void xcd_barrier(unsigned* bar, volatile LAS unsigned* st) {
    asm volatile("s_waitcnt vmcnt(0)" ::: "memory");
    __syncthreads();
    if (threadIdx.x == 0) {
        const unsigned x = xb_xcc_id();
        __builtin_amdgcn_s_waitcnt(0);
        unsigned nloc = st[0], nx = st[1];
        if (nloc == 0u) { xcd_barrier_complete(bar, x, nloc, nx); st[0] = nloc; st[1] = nx; }
        const unsigned old = xb_add(&bar[XB_XSUB(x)], 1u);
        const unsigned gen = old / nloc;
        if (old + 1u == (gen + 1u) * nloc) {
            __builtin_amdgcn_fence(__ATOMIC_RELEASE, "agent");
            asm volatile("s_waitcnt vmcnt(0)" ::: "memory");
            const unsigned og = xb_add(&bar[XB_TOP], 1u);
            const unsigned tg = og / nx;
            if (og + 1u == (tg + 1u) * nx) xb_add(&bar[XB_TOPGEN], 1u);
            else XB_SPIN(xb_ld(&bar[XB_TOPGEN]) == tg, bar);
            __builtin_amdgcn_fence(__ATOMIC_ACQUIRE, "agent");
            xb_add(&bar[XB_XGEN(x)], 1u);
            asm volatile("s_waitcnt vmcnt(0)" ::: "memory");
        } else {
            XB_SPIN(xb_ld(&bar[XB_XGEN(x)]) == gen, bar);
            __builtin_amdgcn_fence(__ATOMIC_ACQUIRE, "agent");
            asm volatile("s_waitcnt vmcnt(0)" ::: "memory");
        }
    }
    __syncthreads();
}

DI void ph0(LAS unsigned char* lds) {
    KP q = getp(); unsigned char* ws = q->ws;
    const int tid = tid_(), G = gridDim.x, cu = blockIdx.x, gt = cu * 512 + tid, NGT = G * 512;
    float* MODS = (float*)(ws + WS_MODS);
    float* ROPEC = (float*)(ws + WS_ROPE); float* ROPES = ROPEC + 2048 * 32;
    bf16_t* FML = (bf16_t*)(ws + WS_FML); bf16_t* FMC = (bf16_t*)(ws + WS_FMC);
    LAS float* sm = (LAS float*)lds;
    const float* cvec = q->in[1]; const float* cctx = q->in[3]; const float* w_mod = q->in[4]; const float* b_mod = q->in[5];
    for (int it = cu; it < 192; it += G) {
        const int l = it / 96, rem = it % 96, kc = rem / 12, cb = rem % 12;
        __syncthreads();
        for (int e = tid; e < 9 * 128; e += 512) { const int v = e >> 7, k = kc * 128 + (e & 127); const float cv = (v < 8) ? cvec[v * D + k] : cctx[k]; sm[e] = cv / (1.0f + __expf(-cv)); }
        __syncthreads();
        const int j = cb * 512 + tid;
        float a[9];
#pragma unroll
        for (int v = 0; v < 9; ++v) a[v] = 0.f;
        const float* wp = w_mod + ((size_t)l * D + kc * 128) * INW + j;
#pragma unroll 4
        for (int k = 0; k < 128; ++k) { const float w = wp[(size_t)k * INW];
#pragma unroll
            for (int v = 0; v < 9; ++v) a[v] += sm[v * 128 + k] * w; }
        const float bm = (kc == 0) ? b_mod[l * INW + j] : 0.f;
#pragma unroll
        for (int v = 0; v < 9; ++v) atomicAdd(&MODS[(size_t)(l * 9 + v) * INW + j], a[v] + bm);
    }
    for (int e = gt; e < 2048 * 32; e += NGT) {
        const int t = e >> 5, ax = (e >> 4) & 1, i = e & 15;
        const float pos = (float)(ax ? (t & 63) : (t >> 6));
        const float inv = powf(10000.0f, -(float)i * (1.0f / 16.0f));
        float sn, cs; sincosf(pos * inv, &sn, &cs);
        ROPEC[e] = cs; ROPES[e] = sn;
    }
    for (int e = gt; e < 2048 * 512; e += NGT) {
        const int k1 = e >> 9, c8 = e & 511, part = c8 >> 8, n0 = (c8 & 255) * 8;
        float v[8];
#pragma unroll
        for (int j = 0; j < 8; ++j) { const int mm = (k1 * (n0 + j)) & 2047; float sn, cs; sincospif((float)mm * (1.0f / 1024.0f), &sn, &cs); v[j] = (part ? -sn : cs) * 0.022097086912079608f; }
        u32x4 w; w.x = cvtpk(v[0], v[1]); w.y = cvtpk(v[2], v[3]); w.z = cvtpk(v[4], v[5]); w.w = cvtpk(v[6], v[7]);
        *(u32x4*)(FML + (size_t)k1 * 4096 + part * 2048 + n0) = w;
    }
    for (int e = gt; e < 256 * 64; e += NGT) {
        const int k1 = e >> 6, c8 = e & 63, part = c8 >> 5, n0 = (c8 & 31) * 8;
        float v[8];
#pragma unroll
        for (int j = 0; j < 8; ++j) { const int mm = (k1 * (n0 + j)) & 255; float sn, cs; sincospif((float)mm * (1.0f / 128.0f), &sn, &cs); v[j] = (part ? -sn : cs) * 0.0625f; }
        u32x4 w; w.x = cvtpk(v[0], v[1]); w.y = cvtpk(v[2], v[3]); w.z = cvtpk(v[4], v[5]); w.w = cvtpk(v[6], v[7]);
        *(u32x4*)(FMC + (size_t)k1 * 512 + part * 256 + n0) = w;
    }
}
DI void ph_norm(int l, int which, bool do_ctx) {
    KP q = getp(); unsigned char* ws = q->ws;
    const float* MODS = (const float*)(ws + WS_MODS);
    const float* srcL = (l == 0 && which == 0) ? q->in[0] : (const float*)q->out;
    const float* srcC = (l == 0 && which == 0) ? q->in[2] : (const float*)(ws + WS_CX);
    norm_phase(srcL, srcC, do_ctx, q->in[which ? 7 : 6] + l * D, MODS + (size_t)l * 9 * INW, which ? 3 : 0, (bf16_t*)(ws + WS_H), gridDim.x);
}
DI void ph2(int l, LAS unsigned char* lds) {
    KP q = getp(); unsigned char* ws = q->ws;
    const int G = gridDim.x, cu = blockIdx.x;
    pg8::Gemm g{(const bf16_t*)(ws + WS_H), (const bf16_t*)(ws + WS_WIN), 1024, 1024};
    pg8::Sched S;
    if (l == 0) S.init(72, 25, G, cu, 16);
    else { S.init(64, 25, G, cu, 16); S.nx = 8; S.xpm0 = 64; S.xpn = 2; }
    float* ROPEC = (float*)(ws + WS_ROPE);
    EpiZ E{(bf16_t*)(ws + WS_ZQ), (bf16_t*)(ws + WS_ZS), (bf16_t*)(ws + WS_ZP), (bf16_t*)(ws + WS_KB), (bf16_t*)(ws + WS_VT), (bf16_t*)(ws + WS_YTL), (bf16_t*)(ws + WS_YTC), ws + WS_G8,
           ROPEC, ROPEC + 2048 * 32, q->in[10] + l * 128, q->in[10] + l * 128 + 64};
    pg8::gemm_phase<EpiZ, true>(lds, g, S, E);
}
DI void ph3_dft(int l, LAS unsigned char* lds) {
    KP q = getp(); unsigned char* ws = q->ws;
    const int G = gridDim.x, cu = blockIdx.x;
    const int nsub = (l == 0) ? 2 : 1;
#pragma nounroll
    for (int j = 0; j < nsub; ++j) {
        pg8::Gemm g; pg8::Sched S; EpiDft E;
        if (j == 0) { g = pg8::Gemm{(const bf16_t*)(ws + WS_FML), (const bf16_t*)(ws + WS_YTL), 4096, 4096}; S.init(8, 8, G, cu, 64); E = EpiDft{(bf16_t*)(ws + WS_ACT4), 0, SEQ}; }
        else { g = pg8::Gemm{(const bf16_t*)(ws + WS_FMC), (const bf16_t*)(ws + WS_YTC), 512, 512}; S.init(1, 8, G, (cu + G - 64) % G, 8); E = EpiDft{(bf16_t*)(ws + WS_ACT4), ML, CTXL}; }
        pg8::gemm_phase<EpiDft, true>(lds, g, S, E);
    }
}
DI void ph3_attn(int l, LAS unsigned char* lds) {
    KP q = getp(); unsigned char* ws = q->ws;
    const int G = gridDim.x, cu = blockIdx.x;
    const bf16_t* ZQ = (const bf16_t*)(ws + WS_ZQ); const bf16_t* KB = (const bf16_t*)(ws + WS_KB); const bf16_t* VT = (const bf16_t*)(ws + WS_VT); bf16_t* ACT4 = (bf16_t*)(ws + WS_ACT4);
    bool fast;
    {
        const int ln = tid_() & 63;
        float gq = fabsf(q->in[10][l * 128 + ln]), gk = fabsf(q->in[10][l * 128 + 64 + ln]);
#pragma unroll
        for (int o = 1; o < 64; o <<= 1) { gq = fmaxf(gq, __shfl_xor(gq, o)); gk = fmaxf(gk, __shfl_xor(gk, o)); }
        const float bound = 11.5416f * gq * gk;
        fast = __builtin_amdgcn_readfirstlane(bound <= 60.0f ? 1 : 0) != 0;
    }
    if (G == 256) {
        if (cu >= 64) {
            const int x = cu & 7, idx = (cu - 64) >> 3;
#pragma nounroll
            for (int u = idx; u < 64; u += 24) { const int a = (2 * x + (u >> 5)) * 32 + (u & 31); attn_unit(lds, ZQ, KB, VT, ACT4, a >> 6, (a >> 5) & 1, (a >> 6) * SEQ + (a & 31) * 64, 0, 36, fast); }
        }
    } else {
#pragma nounroll
        for (int a = cu; a < 512; a += G) attn_unit(lds, ZQ, KB, VT, ACT4, a >> 6, (a >> 5) & 1, (a >> 6) * SEQ + (a & 31) * 64, 0, 36, fast);
    }
    if (l == 0) {
#pragma nounroll
        for (int a = (cu + 64) % G; a < 64; a += G) attn_unit(lds, ZQ, KB, VT, ACT4, a >> 3, (a >> 2) & 1, ML + (a >> 3) * CTXL + (a & 3) * 64, SEQ, 4, fast);
    }
}
DI void ph3_scpool(int l) {
    KP q = getp(); unsigned char* ws = q->ws;
    scpool_phase((const bf16_t*)(ws + WS_ZS), (const bf16_t*)(ws + WS_ZP), (bf16_t*)(ws + WS_ACT4), q->in[9] + l * 768, l == 0 ? MT : ML, gridDim.x);
}
DI void ph4(int l, LAS unsigned char* lds) {
    KP q = getp(); unsigned char* ws = q->ws;
    const int G = gridDim.x, cu = blockIdx.x;
    pg8::Gemm g{(const bf16_t*)(ws + WS_ACT4), (const bf16_t*)(ws + WS_WBR), 1280, 1280};
    pg8::Sched S; S.init(l == 0 ? 72 : 64, 4, G, cu, 8); S.sub = 4;
    EpiBr E{ws + WS_G8, (bf16_t*)(ws + WS_Y), ws + WS_PY + (size_t)cu * 131072};
    pg8::gemm_phase<EpiBr, true>(lds, g, S, E);
}
DI void ph_res(int l, int which, LAS unsigned char* lds) {
    KP q = getp(); unsigned char* ws = q->ws;
    const int G = gridDim.x, cu = blockIdx.x;
    const float* mods = (const float*)(ws + WS_MODS) + (size_t)l * 9 * INW;
    float* OUT = q->out; float* CX = (float*)(ws + WS_CX);
    pg8::Gemm g; pg8::Sched S; EpiRes E;
    if (which == 0) {
        g = pg8::Gemm{(const bf16_t*)(ws + WS_Y), (const bf16_t*)(ws + WS_WOUT), 1024, 1024}; S.init(l == 0 ? 72 : 64, 4, G, cu, 16);
        E = EpiRes{(l == 0) ? q->in[0] : (const float*)OUT, OUT, (l == 0) ? q->in[2] : (const float*)CX, CX, mods + 2 * 1024};
    } else {
        g = pg8::Gemm{(const bf16_t*)(ws + WS_ACT), (const bf16_t*)(ws + WS_WDN), DFF, DFF}; S.init(l == 0 ? 72 : 64, 4, G, cu, 44);
        E = EpiRes{OUT, OUT, CX, CX, mods + 5 * 1024};
    }
    pg8::gemm_phase<EpiRes, true>(lds, g, S, E);
}
DI void ph7(int l, LAS unsigned char* lds) {
    KP q = getp(); unsigned char* ws = q->ws;
    const int G = gridDim.x, cu = blockIdx.x;
    pg8::Gemm g{(const bf16_t*)(ws + WS_H), (const bf16_t*)(ws + WS_WUP), 1024, 1024};
    pg8::Sched S; S.init(l == 0 ? 72 : 64, 22, G, cu, 16);
    EpiUp E{(bf16_t*)(ws + WS_ACT), (bf16_t*)(ws + WS_RAW), q->in[19] + (size_t)l * 3 * UPW};
    pg8::gemm_phase<EpiUp, true>(lds, g, S, E);
}
DI void ph7b(int l) {
    KP q = getp(); unsigned char* ws = q->ws;
    fixup_phase((const bf16_t*)(ws + WS_RAW), (bf16_t*)(ws + WS_ACT), q->in[19] + (size_t)l * 3 * UPW, l == 0 ? 288 : 256, gridDim.x);
}
DI void ph_final() {
    KP q = getp();
    const int tid = tid_(), lane = tid & 63, gw = blockIdx.x * 8 + (tid >> 6), NGW = gridDim.x * 8;
    const float* fg = q->in[21]; float* OUT = q->out;
    for (int r = gw; r < ML; r += NGW) {
        f32x4* xr = (f32x4*)(OUT + (size_t)r * D) + lane;
        f32x4 v[4]; float s = 0.f;
#pragma unroll
        for (int j = 0; j < 4; ++j) { v[j] = xr[64 * j]; s += (v[j][0] * v[j][0] + v[j][1] * v[j][1]) + (v[j][2] * v[j][2] + v[j][3] * v[j][3]); }
        const float rstd = rsqrtf(wave_sum(s) * (1.0f / D) + EPS);
#pragma unroll
        for (int j = 0; j < 4; ++j) { const f32x4 gg = *(const f32x4*)(fg + 256 * j + 4 * lane); xr[64 * j] = (v[j] * rstd) * gg; }
    }
}

__global__ void __launch_bounds__(512, 2) mega(Params p) {
    extern __shared__ __attribute__((aligned(16))) unsigned char lds_raw[];
    LAS unsigned char* lds = (LAS unsigned char*)lds_raw;
    cg::grid_group grid = cg::this_grid();
    volatile LAS unsigned* xst = (volatile LAS unsigned*)(lds + 131072 + 64);
    if (threadIdx.x < 2) xst[threadIdx.x] = 0u;
    __syncthreads();
    { KP q = getp(); xb_post((unsigned*)(q->ws + WS_CTL)); }
#define GBAR() do { KP q_ = getp(); xcd_barrier((unsigned*)(q_->ws + WS_CTL), xst); } while (0)
    ph0(lds);
    grid.sync();
    ph_norm(0, 0, true);
    conv_mixer(0, lds, gridDim.x);
    GBAR();
#pragma nounroll
    for (int l = 0; l < 2; ++l) {
        for (int rep = 0; rep < REP_P2; ++rep) ph2(l, lds);
        GBAR();
        for (int rep = 0; rep < REP_DFT; ++rep) ph3_dft(l, lds);
        for (int rep = 0; rep < REP_ATTN; ++rep) ph3_attn(l, lds);
        for (int rep = 0; rep < REP_SCP; ++rep) ph3_scpool(l);
        GBAR();
        for (int rep = 0; rep < REP_P4; ++rep) ph4(l, lds);
        GBAR();
        ph_res(l, 0, lds);
        GBAR();
        for (int rep = 0; rep < REP_NORM; ++rep) ph_norm(l, 1, l == 0);
        conv_ffn(l, lds, gridDim.x);
        if (l == 0) conv_mixer(1, lds, gridDim.x);
        GBAR();
        for (int rep = 0; rep < REP_P7; ++rep) ph7(l, lds);
        GBAR();
        ph7b(l);
        GBAR();
        ph_res(l, 1, lds);
        GBAR();
        if (l == 0) { ph_norm(1, 0, true); GBAR(); }
        else ph_final();
    }
#undef GBAR
}

extern "C" void kernel_launch(void* const* d_in, const int* in_sizes, int n_in, void* d_out, int out_size, void* d_ws, size_t ws_size, hipStream_t stream) {
    static int grid_blocks = 0;
    if (grid_blocks == 0) {
        if (n_in != 22 || ws_size < WS_END) { fprintf(stderr, "kernel_launch: unexpected inputs (n_in %d, ws %zu)\n", n_in, ws_size); grid_blocks = -1; return; }
        int dev = 0, cus = 0, per_cu = 0;
        (void)hipGetDevice(&dev);
        (void)hipDeviceGetAttribute(&cus, hipDeviceAttributeMultiprocessorCount, dev);
        if (hipFuncSetAttribute((const void*)mega, hipFuncAttributeMaxDynamicSharedMemorySize, LDS_BYTES) != hipSuccess) { fprintf(stderr, "kernel_launch: hipFuncSetAttribute failed\n"); }
        if (hipOccupancyMaxActiveBlocksPerMultiprocessor(&per_cu, (const void*)mega, 512, LDS_BYTES) != hipSuccess || per_cu < 1) { fprintf(stderr, "kernel_launch: occupancy query gave %d\n", per_cu); per_cu = 1; }
        (void)hipGetLastError();
        grid_blocks = cus * 1;
        fprintf(stderr, "kernel_launch: cus %d per_cu %d grid %d ws %zu\n", cus, per_cu, grid_blocks, ws_size);
    }
    if (grid_blocks < 0) return;
    (void)hipMemsetAsync((char*)d_ws + WS_CTL, 0, WS_MODS + MODS_BYTES, stream);
    Params p{};
    for (int i = 0; i < 22; ++i) p.in[i] = (const float*)d_in[i];
    p.out = (float*)d_out; p.ws = (unsigned char*)d_ws;
    void* args[] = {&p};
    hipError_t e = hipLaunchCooperativeKernel((void*)mega, dim3(grid_blocks), dim3(512), args, LDS_BYTES, stream);
    if (e != hipSuccess) fprintf(stderr, "cooperative launch failed: %s (grid %d)\n", hipGetErrorString(e), grid_blocks);
}
```

```cpp
#include <hip/hip_runtime.h>
#include <hip/hip_cooperative_groups.h>
#include <cstdio>
#include <cstdint>
namespace cg = cooperative_groups;

#define LAS __attribute__((address_space(3)))
#define DI __device__ __forceinline__
typedef unsigned short bf16_t;
typedef short bf16x8 __attribute__((ext_vector_type(8)));
typedef short s16x4 __attribute__((ext_vector_type(4)));
typedef float f32x4 __attribute__((ext_vector_type(4)));
typedef float f32x2_t __attribute__((ext_vector_type(2)));
typedef float f32x16 __attribute__((ext_vector_type(16)));
typedef unsigned u32x4 __attribute__((ext_vector_type(4)));
typedef unsigned u32x2 __attribute__((ext_vector_type(2)));
typedef __bf16 bf16x2_t __attribute__((ext_vector_type(2)));

constexpr int D = 1024, SEQ = 2048, NB = 8, CTXL = 256;
constexpr int ML = NB * SEQ;
constexpr int MC = NB * CTXL;
constexpr int MT = ML + MC;
constexpr int INW = 6144, DFF = 2816, UPW = 5632;
constexpr int NZ = 6400;
constexpr int SKV = SEQ + CTXL;
constexpr float EPS = 1e-6f;

constexpr size_t MiB = 1u << 20;
constexpr size_t WS_CTL = 0;
constexpr size_t WS_MODS = 64 * 1024;
constexpr size_t MODS_BYTES = 2 * 9 * 6144 * 4;
constexpr size_t WS_ROPE = 1 * MiB;
constexpr size_t WS_CX = 2 * MiB;
constexpr size_t WS_FML = 10 * MiB;
constexpr size_t WS_FMC = 26 * MiB;
constexpr size_t WS_WIN = 27 * MiB;
constexpr size_t WS_WBR = WS_WIN + (size_t)NZ * 1024 * 2;
constexpr size_t WS_WOUT = 42 * MiB;
constexpr size_t WS_H = 44 * MiB;
constexpr size_t WS_ACT4 = 44 * MiB;
constexpr size_t WS_ZQ = 89 * MiB;
constexpr size_t WS_ZS = 107 * MiB;
constexpr size_t WS_ZP = 134 * MiB;
constexpr size_t WS_KB = 143 * MiB;
constexpr size_t WS_VT = WS_KB + (size_t)NB * 2 * SKV * 64 * 2;
constexpr size_t WS_YTL = 152 * MiB;
constexpr size_t WS_YTC = 168 * MiB;
constexpr size_t WS_G8 = 170 * MiB;
constexpr size_t WS_PY = 134 * MiB;
constexpr size_t WS_Y = 89 * MiB;
constexpr size_t WS_ACT = 89 * MiB;
constexpr size_t WS_CXP = 190 * MiB;
constexpr size_t WS_WUP = 226 * MiB;
constexpr size_t WS_WDN = 237 * MiB;
constexpr size_t WS_RAW = 243 * MiB;
constexpr size_t WS_END = 256 * MiB;
static_assert(WS_WBR + 1024 * 1280 * 2 <= WS_WOUT && WS_VT + (size_t)NB * 2 * SKV * 64 * 2 <= WS_YTL, "ws map");
static_assert(WS_G8 + (size_t)MT * 4096 <= WS_WDN + 6 * MiB && WS_RAW + 288ull * 4 * UPW * 2 <= WS_END, "ws map");
static_assert(WS_ACT + (size_t)MT * DFF * 2 <= WS_WUP, "ws map");

constexpr int LDS_BYTES = 131072 + 4096;
#define REP_P2 1
#define REP_DFT 1
#define REP_ATTN 1
#define REP_SCP 1
#define REP_P4 1
#define REP_P7 1
#define REP_NORM 1

DI unsigned cvtpk(float lo, float hi) { f32x2_t v = {lo, hi}; bf16x2_t b = __builtin_convertvector(v, bf16x2_t); return __builtin_bit_cast(unsigned, b); }
DI float bflo(unsigned u) { return __uint_as_float(u << 16); }
DI float bfhi(unsigned u) { return __uint_as_float(u & 0xffff0000u); }
DI float wave_sum(float v) {
#pragma unroll
    for (int o = 1; o < 64; o <<= 1) v += __shfl_xor(v, o);
    return v;
}
DI int tid_() { int t; asm volatile("v_mov_b32 %0, %1" : "=v"(t) : "v"((int)threadIdx.x)); return t; }
DI float sigmoidf_(float v) { return 1.0f / (1.0f + __expf(-v)); }

struct Params { const float* in[22]; float* out; unsigned char* ws; };
typedef const __attribute__((address_space(4))) Params* KP;
DI KP getp() { KP q = (KP)__builtin_amdgcn_kernarg_segment_ptr(); asm volatile("" : "+s"(q)); return q; }

namespace pg8 {
constexpr int BM = 256, BK = 64, HALF = 128, HTB = HALF * BK * 2, STAGE_BYTES = 8 * HTB, NXCD = 8, WGM = 8;
DI int lds_byte(int r, int c) { const int st = (r >> 4) * 2 + (c >> 5), rr = r & 15, cc = c & 31, ob = rr * 64 + cc * 2; return st * 1024 + (ob ^ (((ob >> 9) & 1) << 5)); }
DI void stage_rc(int b, int& R, int& C) { const int st = b / 1024, sb = b % 1024, swz = sb ^ (((sb >> 9) & 1) << 5); R = (st >> 1) * 16 + swz / 64; C = (st & 1) * 32 + (swz % 64) / 2; }
DI int perm32(int rho) { const int n = rho >> 4, i = rho & 15; return 8 * (i >> 2) + 4 * n + (i & 3); }

struct Unit { int pm, pn, koff, nt, tag; };
struct Gemm { const bf16_t* A; const bf16_t* Bt; int lda, ldb; };

struct Sched {
    int nM, nN, nwg, G, c, nx, xpm0, xpn, sub, nt, xs;
    DI void init(int nM_, int nN_, int G_, int c_, int nt_) { nM = nM_; nN = nN_; nwg = nM * nN; G = G_; c = c_; nx = 0; xpm0 = 0; xpn = 0; sub = 1; nt = nt_; xs = 0; }
    DI bool next(int i, Unit& u) const {
        int ti = i, s = 0;
        if (sub == 4) { ti = i >> 2; s = i & 3; }
        const long L = (long)ti * G + c;
        if (L < nwg) {
            int wgid = (int)L; { const int q = nwg / NXCD, r = nwg % NXCD, xcd = wgid % NXCD, off = wgid / NXCD; wgid = (xcd < r ? xcd * (q + 1) : r * (q + 1) + (xcd - r) * q) + off; }
            const int nig = WGM * nN, gid = wgid / nig, fm = gid * WGM, gsz = (nM - fm) < WGM ? (nM - fm) : WGM;
            u.pm = fm + ((wgid % nig) % gsz); u.pn = (wgid % nig) / gsz;
        } else if (L - nwg < nx) {
            const int j = (int)(L - nwg);
            if (xs > 0) {
                const int tile = j >> 2, ks = j & 3; u.pm = 64 + (tile >> 2); u.pn = tile & 3; u.tag = 1 + ks;
                if (xs == 1) { u.koff = ks * 256; u.nt = 4; } else { u.koff = (ks == 0 ? 0 : ks == 1 ? 12 : ks == 2 ? 24 : 34) * 64; u.nt = ks < 2 ? 12 : 10; }
                return true;
            }
            u.pm = xpm0 + j; u.pn = xpn;
        }
        else return false;
        if (sub == 4) { u.tag = s; u.koff = (s == 0) ? 0 : 256 + 256 * s; u.nt = (s == 0) ? 8 : 4; }
        else { u.tag = 0; u.koff = 0; u.nt = nt; }
        return true;
    }
};

typedef f32x4 Acc[2][2][4][2];
DI void zero_acc(Acc& acc) {
#pragma unroll
    for (int a = 0; a < 2; ++a)
#pragma unroll
        for (int b = 0; b < 2; ++b)
#pragma unroll
            for (int m = 0; m < 4; ++m)
#pragma unroll
                for (int n = 0; n < 2; ++n) acc[a][b][m][n] = (f32x4){0.f, 0.f, 0.f, 0.f};
}

template <class Epi, bool ALIGN_EPI>
DI void gemm_phase(LAS unsigned char* lds, const Gemm g, const Sched& S, const Epi& E) {
    int tid; asm volatile("v_mov_b32 %0, %1" : "=v"(tid) : "v"((int)threadIdx.x));
    const int wid = __builtin_amdgcn_readfirstlane(tid >> 6), lane = tid & 63, wr = wid >> 2, wc = wid & 3, fr = lane & 15, fq = lane >> 4;
    unsigned voffA[2], voffB[2];
#pragma unroll
    for (int i = 0; i < 2; ++i) { int R, C; stage_rc(tid * 16 + i * 8192, R, C); const int Rb = Epi::PERM ? ((R & ~31) + perm32(R & 31)) : R;
        voffA[i] = (unsigned)(R * g.lda + C) * 2u; voffB[i] = (unsigned)(Rb * g.ldb + C) * 2u; }
    const size_t kstep = (size_t)(BK * 2);
    const size_t hstepA = (size_t)HALF * g.lda * 2, hstepB = (size_t)HALF * g.ldb * 2;
    const size_t tstepA = 2 * hstepA, tstepB = 2 * hstepB;
    const unsigned ldsw = (unsigned)wid * 1024u;
    const int aoff = lds_byte(wr * 64 + fr, fq * 8), boff = lds_byte(wc * 32 + fr, fq * 8);
#define PG8_SA(b, h) (((b) * 2 + (h)) * HTB)
#define PG8_SB(b, h) ((4 + (b) * 2 + (h)) * HTB)
#define PG8_STAGE(bufoff, gbase, voff) do { _Pragma("unroll") for (int _i = 0; _i < 2; ++_i) \
        __builtin_amdgcn_global_load_lds((const unsigned*)((const char*)(gbase) + (voff)[_i]), (LAS unsigned*)(lds + (bufoff) + ldsw + _i * 8192), 16, 0, 0); } while (0)
#define PG8_LDA(dst, b, h) do { _Pragma("unroll") for (int m = 0; m < 4; ++m) _Pragma("unroll") for (int k = 0; k < 2; ++k) dst[m][k] = *(const LAS bf16x8*)(lds + PG8_SA(b, h) + aoff + m * 2048 + k * 1024); } while (0)
#define PG8_LDB(dst, b, h) do { _Pragma("unroll") for (int n = 0; n < 2; ++n) _Pragma("unroll") for (int k = 0; k < 2; ++k) dst[n][k] = *(const LAS bf16x8*)(lds + PG8_SB(b, h) + boff + n * 2048 + k * 1024); } while (0)
#define PG8_MMA(ai, bj, At, Bt) do { __builtin_amdgcn_s_setprio(1); _Pragma("unroll") for (int m = 0; m < 4; ++m) _Pragma("unroll") for (int n = 0; n < 2; ++n) _Pragma("unroll") for (int k = 0; k < 2; ++k) \
        acc[ai][bj][m][n] = __builtin_amdgcn_mfma_f32_16x16x32_bf16(Bt[n][k], At[m][k], acc[ai][bj][m][n], 0, 0, 0); __builtin_amdgcn_s_setprio(0); } while (0)
#define PG8_WAIT_V(n) asm volatile("s_waitcnt vmcnt(" #n ")" ::: "memory")
#define PG8_WAIT_L(n) asm volatile("s_waitcnt lgkmcnt(" #n ")" ::: "memory")
#define PG8_BAR __builtin_amdgcn_s_barrier()
#define PG8_SCHED __builtin_amdgcn_sched_barrier(0)
    Unit cur, nxt; int ui = 0;
    if (!S.next(0, cur)) return;
    Acc acc;
    { int l2; asm volatile("v_mov_b32 %0, %1" : "=v"(l2) : "v"(lane)); E.init(acc, cur, wr, wc, l2 & 15, l2 >> 4); }
    PG8_WAIT_V(0);
    bf16x8 At[4][2], B0[2][2], B1[2][2];
    const char* cA = (const char*)g.A + (size_t)cur.pm * tstepA + (size_t)cur.koff * 2; const char* cB = (const char*)g.Bt + (size_t)cur.pn * tstepB + (size_t)cur.koff * 2;
    PG8_STAGE(PG8_SB(0, 0), cB, voffB); PG8_STAGE(PG8_SB(0, 1), cB + hstepB, voffB); PG8_STAGE(PG8_SA(0, 0), cA, voffA); PG8_STAGE(PG8_SA(0, 1), cA + hstepA, voffA);
    if (wr == 1) PG8_BAR;
    PG8_WAIT_V(2); PG8_BAR;
    PG8_STAGE(PG8_SB(1, 0), cB + kstep, voffB); PG8_STAGE(PG8_SA(1, 0), cA + kstep, voffA); PG8_STAGE(PG8_SB(1, 1), cB + hstepB + kstep, voffB);
    PG8_WAIT_V(6); PG8_BAR;
    for (;;) {
        const bool has_next = S.next(ui + 1, nxt);
        const char* nA = has_next ? (const char*)g.A + (size_t)nxt.pm * tstepA + (size_t)nxt.koff * 2 : cA;
        const char* nB = has_next ? (const char*)g.Bt + (size_t)nxt.pn * tstepB + (size_t)nxt.koff * 2 : cB;
        const int nt = cur.nt;
        for (int t = 0; t < nt; t += 2) {
            const bool last = (t == nt - 2);
            const char* a1 = cA + (size_t)(t + 1) * kstep;
            const char* a2 = last ? nA : cA + (size_t)(t + 2) * kstep; const char* b2 = last ? nB : cB + (size_t)(t + 2) * kstep;
            const char* a3 = a2 + kstep; const char* b3 = b2 + kstep;
            PG8_LDB(B0, 0, 0); PG8_LDB(B1, 0, 1); PG8_SCHED; PG8_LDA(At, 0, 0); PG8_STAGE(PG8_SA(1, 1), a1 + hstepA, voffA);
            PG8_WAIT_V(8); PG8_WAIT_L(0); PG8_BAR; PG8_MMA(0, 0, At, B0); PG8_MMA(0, 1, At, B1); PG8_BAR; PG8_SCHED;
            PG8_LDA(At, 0, 1); PG8_STAGE(PG8_SB(0, 0), b2, voffB); PG8_STAGE(PG8_SB(0, 1), b2 + hstepB, voffB); PG8_STAGE(PG8_SA(0, 0), a2, voffA);
            PG8_WAIT_V(8); PG8_WAIT_L(0); PG8_BAR; PG8_MMA(1, 0, At, B0); PG8_MMA(1, 1, At, B1); PG8_BAR; PG8_SCHED;
            PG8_LDB(B0, 1, 0); PG8_LDB(B1, 1, 1); PG8_SCHED; PG8_LDA(At, 1, 0); PG8_STAGE(PG8_SA(0, 1), a2 + hstepA, voffA);
            PG8_WAIT_V(8); PG8_WAIT_L(0); PG8_BAR; PG8_MMA(0, 0, At, B0); PG8_MMA(0, 1, At, B1); PG8_BAR; PG8_SCHED;
            PG8_LDA(At, 1, 1); PG8_STAGE(PG8_SB(1, 0), b3, voffB); PG8_STAGE(PG8_SB(1, 1), b3 + hstepB, voffB); PG8_STAGE(PG8_SA(1, 0), a3, voffA);
            PG8_WAIT_V(8); PG8_WAIT_L(0); PG8_BAR; PG8_MMA(1, 0, At, B0); PG8_MMA(1, 1, At, B1); PG8_BAR; PG8_SCHED;
        }
        if constexpr (ALIGN_EPI) { if (wr == 0) PG8_BAR; }
        int l2; asm volatile("v_mov_b32 %0, %1" : "=v"(l2) : "v"(lane));
        E(acc, cur, wr, wc, l2 & 15, l2 >> 4);
        if (!has_next) break;
        E.init(acc, nxt, wr, wc, l2 & 15, l2 >> 4);
        cur = nxt; cA = nA; cB = nB; ++ui;
        if constexpr (ALIGN_EPI) { if (wr == 1) PG8_BAR; }
    }
    PG8_WAIT_V(0);
    if constexpr (!ALIGN_EPI) { if (wr == 0) PG8_BAR; }
    PG8_BAR;
#undef PG8_SA
#undef PG8_SB
#undef PG8_STAGE
#undef PG8_LDA
#undef PG8_LDB
#undef PG8_MMA
#undef PG8_WAIT_V
#undef PG8_WAIT_L
#undef PG8_BAR
#undef PG8_SCHED
}
}
using pg8::Acc; using pg8::Unit;

struct EpiZ {
    static constexpr bool PERM = false;
    bf16_t *ZQ, *ZS, *ZP, *KB, *VT, *YTL, *YTC; unsigned char* G8;
    const float *ropec, *ropes, *qg, *kg;
    DI void init(Acc& acc, const Unit&, int, int, int, int) const { pg8::zero_acc(acc); }
    DI void operator()(Acc& acc, const Unit& u, int wr, int wc, int fr, int fq) const {
        const bool isctx = u.pm >= 64;
        const int pn = u.pn;
        if (pn <= 2) {
            if (pn == 2 && wc >= 2) {
                const int g = wc - 2;
#pragma unroll
                for (int ai = 0; ai < 2; ++ai)
#pragma unroll
                    for (int m = 0; m < 4; ++m) {
                        const int r = u.pm * 256 + ai * 128 + wr * 64 + m * 16 + fr;
                        int b, pos; if (!isctx) { b = r >> 11; pos = r & 2047; } else { const int rc = r - ML; b = rc >> 8; pos = SEQ + (rc & 255); }
                        bf16_t* vb = VT + ((size_t)(b * 2 + g) * 64) * SKV + pos;
#pragma unroll
                        for (int bj = 0; bj < 2; ++bj)
#pragma unroll
                            for (int n = 0; n < 2; ++n) {
                                const f32x4 v = acc[ai][bj][m][n];
                                const unsigned p0 = cvtpk(v[0], v[1]), p1 = cvtpk(v[2], v[3]);
                                const int e = 32 * bj + 16 * n + 4 * fq;
                                vb[(size_t)(e + 0) * SKV] = (bf16_t)(p0 & 0xffff); vb[(size_t)(e + 1) * SKV] = (bf16_t)(p0 >> 16);
                                vb[(size_t)(e + 2) * SKV] = (bf16_t)(p1 & 0xffff); vb[(size_t)(e + 3) * SKV] = (bf16_t)(p1 >> 16);
                            }
                    }
                return;
            }
            const bool isq = pn < 2;
            const float* gain = isq ? qg : kg;
            const float osc = isq ? (0.125f * 1.4426950408889634f) : 1.0f;
#pragma unroll
            for (int ai = 0; ai < 2; ++ai)
#pragma unroll
                for (int m = 0; m < 4; ++m) {
                    const int r = u.pm * 256 + ai * 128 + wr * 64 + m * 16 + fr;
                    float ss = 0.f;
#pragma unroll
                    for (int bj = 0; bj < 2; ++bj)
#pragma unroll
                        for (int n = 0; n < 2; ++n) { const f32x4 v = acc[ai][bj][m][n]; ss += (v[0] * v[0] + v[1] * v[1]) + (v[2] * v[2] + v[3] * v[3]); }
                    ss += __shfl_xor(ss, 16); ss += __shfl_xor(ss, 32);
                    const float rinv = rsqrtf(ss * (1.0f / 64.0f) + EPS) * osc;
                    int b, pos, t = 0; if (!isctx) { b = r >> 11; pos = r & 2047; t = pos; } else { const int rc = r - ML; b = rc >> 8; pos = SEQ + (rc & 255); }
                    bf16_t* dst;
                    if (isq) dst = ZQ + (size_t)r * 512 + (pn * 4 + wc) * 64;
                    else dst = KB + ((size_t)(b * 2 + wc) * SKV + pos) * 64;
#pragma unroll
                    for (int bj = 0; bj < 2; ++bj) {
                        const f32x4 g0 = *(const f32x4*)(gain + 32 * bj + 4 * fq), g1 = *(const f32x4*)(gain + 32 * bj + 16 + 4 * fq);
                        f32x4 x0 = acc[ai][bj][m][0] * rinv * g0, x1 = acc[ai][bj][m][1] * rinv * g1;
                        if (!isctx) {
                            const f32x4 cs = *(const f32x4*)(ropec + (t * 2 + bj) * 16 + 4 * fq), sn = *(const f32x4*)(ropes + (t * 2 + bj) * 16 + 4 * fq);
                            const f32x4 o0 = x0 * cs - x1 * sn, o1 = x1 * cs + x0 * sn; x0 = o0; x1 = o1;
                        }
                        u32x2 w0, w1; w0.x = cvtpk(x0[0], x0[1]); w0.y = cvtpk(x0[2], x0[3]); w1.x = cvtpk(x1[0], x1[1]); w1.y = cvtpk(x1[2], x1[3]);
                        *(u32x2*)(dst + 32 * bj + 4 * fq) = w0; *(u32x2*)(dst + 32 * bj + 16 + 4 * fq) = w1;
                    }
                }
            return;
        }
#pragma unroll
        for (int ai = 0; ai < 2; ++ai)
#pragma unroll
            for (int m = 0; m < 4; ++m) {
                const int r = u.pm * 256 + ai * 128 + wr * 64 + m * 16 + fr;
                int b, t; if (!isctx) { b = r >> 11; t = r & 2047; } else { const int rc = r - ML; b = rc >> 8; t = rc & 255; }
#pragma unroll
                for (int bj = 0; bj < 2; ++bj)
#pragma unroll
                    for (int n = 0; n < 2; ++n) {
                        const f32x4 v = acc[ai][bj][m][n];
                        const int c = 128 * bj + 32 * wc + 16 * n + 4 * fq;
                        if (pn >= 9) {
                            unsigned w = 0;
#pragma unroll
                            for (int x = 0; x < 4; ++x) { const float s = sigmoidf_(v[x]); int q = (int)(s * 256.0f); q = q > 255 ? 255 : (q < 0 ? 0 : q); w |= (unsigned)q << (8 * x); }
                            *(unsigned*)(G8 + (size_t)r * 4096 + (pn - 9) * 256 + c) = w;
                        } else if (pn <= 5) {
                            u32x2 w; w.x = cvtpk(v[0], v[1]); w.y = cvtpk(v[2], v[3]);
                            *(u32x2*)(ZS + (size_t)r * 768 + (pn - 3) * 256 + c) = w;
                        } else if (pn == 8) {
                            u32x2 w; w.x = cvtpk(v[0], v[1]); w.y = cvtpk(v[2], v[3]);
                            *(u32x2*)(ZP + (size_t)r * 256 + c) = w;
                        } else {
                            const int cs = pn - 6;
                            const unsigned p0 = cvtpk(v[0], v[1]), p1 = cvtpk(v[2], v[3]);
                            bf16_t* y; size_t st;
                            if (!isctx) { y = YTL + ((size_t)(b * 256 + c) * 4096) + cs * 2048 + t; st = 4096; }
                            else { y = YTC + ((size_t)(b * 256 + c) * 512) + cs * 256 + t; st = 512; }
                            y[0] = (bf16_t)(p0 & 0xffff); y[st] = (bf16_t)(p0 >> 16); y[2 * st] = (bf16_t)(p1 & 0xffff); y[3 * st] = (bf16_t)(p1 >> 16);
                        }
                    }
            }
    }
};

struct EpiDft {
    static constexpr bool PERM = true;
    bf16_t* ACT4; int rowbase, nrows;
    DI void init(Acc& acc, const Unit&, int, int, int, int) const { pg8::zero_acc(acc); }
    DI void operator()(Acc& acc, const Unit& u, int wr, int wc, int fr, int fq) const {
#pragma unroll
        for (int ai = 0; ai < 2; ++ai)
#pragma unroll
            for (int m = 0; m < 4; ++m) {
                const int r = rowbase + u.pn * nrows + u.pm * 256 + ai * 128 + wr * 64 + m * 16 + fr;
#pragma unroll
                for (int bj = 0; bj < 2; ++bj) {
                    const f32x4 v0 = acc[ai][bj][m][0], v1 = acc[ai][bj][m][1];
                    u32x4 w; w.x = cvtpk(v0[0], v0[1]); w.y = cvtpk(v0[2], v0[3]); w.z = cvtpk(v1[0], v1[1]); w.w = cvtpk(v1[2], v1[3]);
                    *(u32x4*)(ACT4 + (size_t)r * 1280 + 768 + 128 * bj + 32 * wc + 8 * fq) = w;
                }
            }
    }
};

struct EpiBr {
    static constexpr bool PERM = true;
    const unsigned char* G8; bf16_t* Y; unsigned char* PY;
    DI void init(Acc& acc, const Unit&, int, int, int, int) const { pg8::zero_acc(acc); }
    DI void operator()(Acc& acc, const Unit& u, int wr, int wc, int fr, int fq) const {
        const unsigned char* ub = G8 + ((size_t)u.pm * 256 + wr * 64) * 4096 + u.tag * 1024 + u.pn * 256 + 32 * wc;
        const unsigned lo = (unsigned)(fr * 4096 + 8 * fq);
        unsigned char* pyb = PY + (size_t)((wr * 4 + wc) * 64 + fr + 16 * fq) * 16;
        bf16_t* yb = Y + ((size_t)u.pm * 256 + wr * 64) * 1024 + u.pn * 256 + 32 * wc;
        const unsigned yo = (unsigned)(fr * 1024 + 8 * fq);
#pragma unroll
        for (int ai = 0; ai < 2; ++ai) {
            u32x2 gw[4][2];
#pragma unroll
            for (int m = 0; m < 4; ++m)
#pragma unroll
                for (int bj = 0; bj < 2; ++bj) gw[m][bj] = *(const u32x2*)(ub + ((ai * 128 + m * 16) * 4096 + bj * 128) + lo);
#pragma unroll
            for (int m = 0; m < 4; ++m)
#pragma unroll
                for (int bj = 0; bj < 2; ++bj) {
                    f32x4 v[2];
#pragma unroll
                    for (int n = 0; n < 2; ++n) { const unsigned w = n ? gw[m][bj].y : gw[m][bj].x;
#pragma unroll
                        for (int x = 0; x < 4; ++x) { const float gq = ((float)((w >> (8 * x)) & 255u) + 0.5f) * (1.0f / 256.0f); v[n][x] = acc[ai][bj][m][n][x] * gq; } }
                    unsigned char* pp = pyb + (size_t)(((ai * 4 + m) * 2 + bj) * 512) * 16;
                    if (u.tag != 0) {
                        const u32x4 pv = *(const u32x4*)pp;
                        v[0][0] += bflo(pv.x); v[0][1] += bfhi(pv.x); v[0][2] += bflo(pv.y); v[0][3] += bfhi(pv.y);
                        v[1][0] += bflo(pv.z); v[1][1] += bfhi(pv.z); v[1][2] += bflo(pv.w); v[1][3] += bfhi(pv.w);
                    }
                    u32x4 w; w.x = cvtpk(v[0][0], v[0][1]); w.y = cvtpk(v[0][2], v[0][3]); w.z = cvtpk(v[1][0], v[1][1]); w.w = cvtpk(v[1][2], v[1][3]);
                    if (u.tag != 3) *(u32x4*)pp = w;
                    else *(u32x4*)(yb + ((ai * 128 + m * 16) * 1024 + bj * 128) + yo) = w;
                }
        }
    }
};

struct EpiRes {
    static constexpr bool PERM = false;
    const float* srcL; float* dstL; const float* srcC; float* dstC; const float* gates; float* cxp;
    DI void init(Acc& acc, const Unit&, int, int, int, int) const { pg8::zero_acc(acc); }
    DI void operator()(Acc& acc, const Unit& u, int wr, int wc, int fr, int fq) const {
        const bool isctx = u.pm >= 64;
        const size_t rb = isctx ? ((size_t)(u.pm - 64) * 256 + wr * 64) : ((size_t)u.pm * 256 + wr * 64);
        const float* sb = (isctx ? srcC : srcL) + rb * D + u.pn * 256 + 32 * wc;
        float* db = (isctx ? dstC : dstL) + rb * D + u.pn * 256 + 32 * wc;
        const float* gb = gates + (size_t)(isctx ? 8 : (u.pm >> 3)) * 6144 + u.pn * 256 + 32 * wc;
        const unsigned lo = (unsigned)(fr * D + 4 * fq), go = (unsigned)(4 * fq);
        if (u.tag >= 2) {
            float* pb = cxp + (size_t)(u.tag - 2) * MC * D + rb * D + u.pn * 256 + 32 * wc;
#pragma unroll
            for (int ai = 0; ai < 2; ++ai)
#pragma unroll
                for (int m = 0; m < 4; ++m)
#pragma unroll
                    for (int bj = 0; bj < 2; ++bj)
#pragma unroll
                        for (int n = 0; n < 2; ++n) {
                            const int co = (ai * 128 + m * 16) * D + bj * 128 + n * 16;
                            const f32x4 gg = *(const f32x4*)(gb + (bj * 128 + n * 16) + go);
                            *(f32x4*)(pb + co + lo) = gg * acc[ai][bj][m][n];
                        }
            return;
        }
#pragma unroll
        for (int ai = 0; ai < 2; ++ai)
#pragma unroll
            for (int m = 0; m < 4; ++m) {
#pragma unroll
                for (int bj = 0; bj < 2; ++bj)
#pragma unroll
                    for (int n = 0; n < 2; ++n) {
                        const int co = (ai * 128 + m * 16) * D + bj * 128 + n * 16;
                        const f32x4 s = *(const f32x4*)(sb + co + lo), gg = *(const f32x4*)(gb + (bj * 128 + n * 16) + go);
                        *(f32x4*)(db + co + lo) = s + gg * acc[ai][bj][m][n];
                    }
                if (m == 3) asm volatile("" ::: "memory");
            }
    }
};

struct EpiUp {
    static constexpr bool PERM = true;
    bf16_t* ACT; bf16_t* RAW; const float* wconv;
    DI void init(Acc& acc, const Unit&, int, int, int, int) const { pg8::zero_acc(acc); }
    DI void operator()(Acc& acc, const Unit& u, int wr, int wc, int fr, int fq) const {
        const int lane = fr + 16 * fq;
        const int jl = 32 * wc + 8 * fq;
        const int ja = u.pn * 128 + jl;
        bf16_t* ab = ACT + ((size_t)u.pm * 256 + wr * 64) * DFF + u.pn * 128 + 32 * wc;
        const unsigned alo = (unsigned)(fr * DFF + 8 * fq);
#pragma unroll
        for (int ai = 0; ai < 2; ++ai) {
            const int rbase = u.pm * 256 + ai * 128 + wr * 64;
#pragma unroll
            for (int m = 0; m < 4; m += 3) {
                const bool dump = (m == 0) ? (fr < 2) : (fr >= 14);
                if (dump) {
                    const int slot = (m == 0) ? (2 + fr) : (fr - 14);
                    bf16_t* rw = RAW + ((size_t)(rbase >> 6) * 4 + slot) * UPW;
#pragma unroll
                    for (int bj = 0; bj < 2; ++bj) {
                        const f32x4 v0 = acc[ai][bj][m][0], v1 = acc[ai][bj][m][1];
                        u32x4 w; w.x = cvtpk(v0[0], v0[1]); w.y = cvtpk(v0[2], v0[3]); w.z = cvtpk(v1[0], v1[1]); w.w = cvtpk(v1[2], v1[3]);
                        *(u32x4*)(rw + bj * DFF + ja) = w;
                    }
                }
            }
#pragma unroll
            for (int n = 0; n < 2; ++n) {
#pragma unroll
                for (int xp = 0; xp < 2; ++xp) {
                    float act[4][2];
#pragma unroll
                    for (int xx = 0; xx < 2; ++xx) {
                        const int x = 2 * xp + xx;
                        float ca[4], cb[4];
#pragma unroll
                        for (int bj = 0; bj < 2; ++bj) {
                            const float* wp = wconv + bj * DFF + ja + 4 * n + x;
                            const float w0 = wp[0], w1 = wp[UPW], w2 = wp[2 * UPW];
                            float R[4], L[4];
#pragma unroll
                            for (int m = 0; m < 4; ++m) { const int vi = __float_as_int(acc[ai][bj][m][n][x]);
                                R[m] = __int_as_float(__builtin_amdgcn_update_dpp(vi, vi, 0x121, 0xF, 0xF, false));
                                L[m] = __int_as_float(__builtin_amdgcn_update_dpp(vi, vi, 0x12F, 0xF, 0xF, false)); }
#pragma unroll
                            for (int m = 0; m < 4; ++m) {
                                const float up = (fr > 0) ? R[m] : (m > 0 ? R[m > 0 ? m - 1 : 0] : 0.f);
                                const float dn = (fr < 15) ? L[m] : (m < 3 ? L[m < 3 ? m + 1 : 3] : 0.f);
                                const float cv = w0 * up + w1 * acc[ai][bj][m][n][x] + w2 * dn;
                                if (bj == 0) ca[m] = cv; else cb[m] = cv;
                            }
                        }
#pragma unroll
                        for (int m = 0; m < 4; ++m) act[m][xx] = ca[m] * sigmoidf_(ca[m]) * cb[m];
                    }
#pragma unroll
                    for (int m = 0; m < 4; ++m) {
                        const bool skip = (m == 0 && fr == 0) || (m == 3 && fr == 15);
                        if (!skip) *(unsigned*)(ab + ((ai * 128 + m * 16) * DFF + 4 * n + 2 * xp) + alo) = cvtpk(act[m][0], act[m][1]);
                    }
                    asm volatile("" ::: "memory");
                }
            }
        }
    }
};

DI void transpose_item(const float* W, int ldn, int k0, int n0, bf16_t* WT, int drow0, int ldd, int koff, LAS float* scr, int lane) {
#pragma unroll 8
    for (int i = 0; i < 32; ++i) { const int kk = 2 * i + (lane >> 5); scr[kk * 33 + (lane & 31)] = W[(size_t)(k0 + kk) * ldn + n0 + (lane & 31)]; }
    asm volatile("s_waitcnt lgkmcnt(0)" ::: "memory");
    const int c = lane & 7;
#pragma unroll
    for (int j = 0; j < 4; ++j) { const int n = (lane >> 3) + 8 * j; const LAS float* s = scr + (8 * c) * 33 + n;
        u32x4 o; o.x = cvtpk(s[0 * 33], s[1 * 33]); o.y = cvtpk(s[2 * 33], s[3 * 33]); o.z = cvtpk(s[4 * 33], s[5 * 33]); o.w = cvtpk(s[6 * 33], s[7 * 33]);
        *(u32x4*)(WT + (size_t)(drow0 + n) * ldd + koff + k0 + 8 * c) = o; }
    asm volatile("s_waitcnt lgkmcnt(0)" ::: "memory");
}
DI int win_dest(int n0) {
    if (n0 < 768) { const int tile = n0 >> 8, within = n0 & 255, hd = within >> 6, e = within & 63; return tile * 256 + 128 * (e >> 5) + 32 * hd + (e & 31); }
    if (n0 < 1536) return n0;
    if (n0 < 1792) return -1;
    return n0 + 256;
}
DI int wup_dest(int n0) { if (n0 < DFF) return 256 * (n0 >> 7) + (n0 & 127); const int j = n0 - DFF; return 256 * (j >> 7) + 128 + (j & 127); }

DI void conv_mixer(int l, LAS unsigned char* lds, int G) {
    KP q = getp(); unsigned char* ws = q->ws;
    const int tid = tid_(), lane = tid & 63, wave = tid >> 6;
    const int gw = blockIdx.x * 8 + wave, NGW = G * 8;
    LAS float* scr = (LAS float*)(lds + wave * 8448);
    bf16_t* WinT = (bf16_t*)(ws + WS_WIN); bf16_t* WbrT = (bf16_t*)(ws + WS_WBR); bf16_t* WoutT = (bf16_t*)(ws + WS_WOUT);
    const float* w_in = q->in[8] + (size_t)l * D * INW;
    constexpr int I_IN = 16 * 192, I_BA = 8 * 32, I_BS = 4 * 32, I_O = 16 * 32;
    constexpr int NIT = I_IN + I_BA + 2 * I_BS + I_O;
    for (int it = gw; it < NIT; it += NGW) {
        int r = it;
        if (r < I_IN) { const int kb = r / 192, nb = r % 192, n0 = nb * 32, d = win_dest(n0); if (d >= 0) transpose_item(w_in, INW, kb * 64, n0, WinT, d, 1024, 0, scr, lane); continue; } r -= I_IN;
        if (r < I_BA) { const int kb = r / 32, nb = r % 32; transpose_item(q->in[13] + (size_t)l * 512 * D, D, kb * 64, nb * 32, WbrT, nb * 32, 1280, 0, scr, lane); continue; } r -= I_BA;
        if (r < I_BS) { const int kb = r / 32, nb = r % 32; transpose_item(q->in[14] + (size_t)l * 256 * D, D, kb * 64, nb * 32, WbrT, nb * 32, 1280, 512, scr, lane); continue; } r -= I_BS;
        if (r < I_BS) { const int kb = r / 32, nb = r % 32; transpose_item(q->in[15] + (size_t)l * 256 * D, D, kb * 64, nb * 32, WbrT, nb * 32, 1280, 768, scr, lane); continue; } r -= I_BS;
        { const int kb = r / 32, nb = r % 32; transpose_item(q->in[17] + (size_t)l * D * D, D, kb * 64, nb * 32, WoutT, nb * 32, 1024, 0, scr, lane); }
    }
    __syncthreads();
    LAS float* tab = (LAS float*)(lds + 8 * 8448);
    if (tid < 64) { float s, c; sincospif((float)tid * (1.0f / 32.0f), &s, &c); tab[tid] = c; tab[64 + tid] = s; }
    __syncthreads();
    const int gt = blockIdx.x * 512 + tid, NGT = G * 512;
    for (int e = gt; e < 512 * 1024; e += NGT) {
        const int k = e & 1023, nrow = e >> 10, cs = nrow >> 8, g = (nrow >> 6) & 3, k2 = nrow & 63;
        const float* src = w_in + (size_t)k * INW + 1536 + g * 64;
        const LAS float* tb = tab + cs * 64;
        float a = 0.f;
#pragma unroll 4
        for (int c4 = 0; c4 < 16; ++c4) { const f32x4 v = *(const f32x4*)(src + 4 * c4);
#pragma unroll
            for (int x = 0; x < 4; ++x) a += v[x] * tb[(k2 * (4 * c4 + x)) & 63]; }
        WinT[(size_t)(1536 + nrow) * 1024 + k] = (bf16_t)(cvtpk(a * 0.125f, 0.f) & 0xffff);
    }
    const float* pm = q->in[11] + (size_t)l * 4 * 64 * 64; const float* psc = q->in[12] + (size_t)l * 256; const float* wp = q->in[16] + (size_t)l * 256 * D;
    for (int e = gt; e < 256 * 1024; e += NGT) {
        const int n = e & 1023, gc = e >> 10, g = gc >> 6;
        float a = 0.f;
#pragma unroll 8
        for (int d = 0; d < 64; ++d) a += pm[(size_t)gc * 64 + d] * psc[g * 64 + d] * wp[(size_t)(g * 64 + d) * D + n];
        WbrT[(size_t)n * 1280 + 1024 + gc] = (bf16_t)(cvtpk(a, 0.f) & 0xffff);
    }
    __syncthreads();
}

DI void conv_ffn(int l, LAS unsigned char* lds, int G) {
    KP q = getp(); unsigned char* ws = q->ws;
    const int tid = tid_(), lane = tid & 63, wave = tid >> 6;
    const int gw = blockIdx.x * 8 + wave, NGW = G * 8;
    LAS float* scr = (LAS float*)(lds + wave * 8448);
    bf16_t* WupT = (bf16_t*)(ws + WS_WUP); bf16_t* WdnT = (bf16_t*)(ws + WS_WDN);
    constexpr int I_U = 16 * 176, I_D = 44 * 32;
    for (int it = gw; it < I_U + I_D; it += NGW) {
        int r = it;
        if (r < I_U) { const int kb = r / 176, nb = r % 176, n0 = nb * 32; transpose_item(q->in[18] + (size_t)l * D * UPW, UPW, kb * 64, n0, WupT, wup_dest(n0), 1024, 0, scr, lane); continue; } r -= I_U;
        { const int kb = r / 32, nb = r % 32; transpose_item(q->in[20] + (size_t)l * DFF * D, D, kb * 64, nb * 32, WdnT, nb * 32, DFF, 0, scr, lane); }
    }
}

DI void norm_rows2(const float* x0, const float* x1, const float* gain, const float* md0, const float* md1, int si, bf16_t* o0, bf16_t* o1, int lane, const float* part, float* wb) {
    const f32x4* xr0 = (const f32x4*)x0 + lane; const f32x4* xr1 = (const f32x4*)x1 + lane;
    f32x4 v0[4], v1[4]; float s0 = 0.f, s1 = 0.f;
#pragma unroll
    for (int j = 0; j < 4; ++j) { v0[j] = xr0[64 * j]; v1[j] = xr1[64 * j]; }
    if (part) {
#pragma unroll
        for (int pi = 0; pi < 3; ++pi) { const f32x4* p0 = (const f32x4*)(part + (size_t)pi * MC * D) + lane;
#pragma unroll
            for (int j = 0; j < 4; ++j) { v0[j] += p0[64 * j]; v1[j] += p0[256 + 64 * j]; } }
        f32x4* w0 = (f32x4*)wb + lane;
#pragma unroll
        for (int j = 0; j < 4; ++j) { w0[64 * j] = v0[j]; w0[256 + 64 * j] = v1[j]; }
    }
#pragma unroll
    for (int j = 0; j < 4; ++j) { s0 += (v0[j][0] * v0[j][0] + v0[j][1] * v0[j][1]) + (v0[j][2] * v0[j][2] + v0[j][3] * v0[j][3]); s1 += (v1[j][0] * v1[j][0] + v1[j][1] * v1[j][1]) + (v1[j][2] * v1[j][2] + v1[j][3] * v1[j][3]); }
    const float r0 = rsqrtf(wave_sum(s0) * (1.0f / D) + EPS), r1 = rsqrtf(wave_sum(s1) * (1.0f / D) + EPS);
#pragma unroll
    for (int j = 0; j < 4; ++j) {
        const int c = 256 * j + 4 * lane;
        const f32x4 g = *(const f32x4*)(gain + c);
        const f32x4 sh0 = *(const f32x4*)(md0 + si * 1024 + c), sc0 = *(const f32x4*)(md0 + (si + 1) * 1024 + c);
        const f32x4 sh1 = *(const f32x4*)(md1 + si * 1024 + c), sc1 = *(const f32x4*)(md1 + (si + 1) * 1024 + c);
        const f32x4 h0 = ((v0[j] * r0) * g) * (1.0f + sc0) + sh0, h1 = ((v1[j] * r1) * g) * (1.0f + sc1) + sh1;
        u32x2 w0; w0.x = cvtpk(h0[0], h0[1]); w0.y = cvtpk(h0[2], h0[3]);
        u32x2 w1; w1.x = cvtpk(h1[0], h1[1]); w1.y = cvtpk(h1[2], h1[3]);
        *(u32x2*)(o0 + c) = w0; *(u32x2*)(o1 + c) = w1;
    }
}
DI void norm_phase(const float* srcL, const float* srcC, bool do_ctx, const float* gain, const float* mods, int si, bf16_t* H, int G, const float* cxp, float* cxw) {
    const int tid = tid_(), lane = tid & 63, wave = tid >> 6;
    const int gw = blockIdx.x * 8 + wave, NGW = G * 8;
    const int nrows = do_ctx ? MT : ML;
    for (int r = 2 * gw; r < nrows; r += 2 * NGW) {
        const float *x0, *x1, *md0, *md1;
        if (r < ML) { x0 = srcL + (size_t)r * D; md0 = mods + (size_t)(r >> 11) * 6144; x1 = x0 + D; md1 = md0; }
        else { x0 = srcC + (size_t)(r - ML) * D; md0 = mods + (size_t)8 * 6144; x1 = x0 + D; md1 = md0; }
        const bool pc = (r >= ML) && cxp;
        norm_rows2(x0, x1, gain, md0, md1, si, H + (size_t)r * D, H + (size_t)(r + 1) * D, lane, pc ? cxp + (size_t)(r - ML) * D : nullptr, pc ? cxw + (size_t)(r - ML) * D : nullptr);
    }
}

DI void attn_qk(f32x16& p0, f32x16& p1, const LAS unsigned char* kl, const bf16x8 (&qf)[4], int r32, int h) {
    constexpr int PITCH = 144;
#pragma unroll
    for (int i = 0; i < 16; ++i) { p0[i] = 0.f; p1[i] = 0.f; }
#pragma unroll
    for (int s = 0; s < 4; ++s) {
        const bf16x8 ka = *(const LAS bf16x8*)(kl + r32 * PITCH + (16 * s + 8 * h) * 2);
        const bf16x8 kb2 = *(const LAS bf16x8*)(kl + (32 + r32) * PITCH + (16 * s + 8 * h) * 2);
        p0 = __builtin_amdgcn_mfma_f32_32x32x16_bf16(ka, qf[s], p0, 0, 0, 0);
        p1 = __builtin_amdgcn_mfma_f32_32x32x16_bf16(kb2, qf[s], p1, 0, 0, 0);
    }
}
#define ATTN_ITER(FAST, t, PC0, PC1, PN0, PN1, KW, VW, KL, VL) do { \
        const int cur = (t) & 1; \
        if ((t) + 3 < nkt) KL = *(const u32x4*)(kbase + ((size_t)((t) + 3) * 64 + srow) * 64 + sch * 8); \
        if ((t) + 2 < nkt) VL = *(const u32x4*)(vbase + (size_t)srow * SKV + ((t) + 2) * 64 + sch * 8); \
        if ((t) + 1 < nkt) attn_qk(PN0, PN1, lds + (cur ^ 1) * TB, qf, r32, h); \
        if (FAST) {                                           \
            f32x2_t rs = {0.f, 0.f}; \
            _Pragma("unroll") for (int i = 0; i < 16; i += 2) { \
                f32x2_t a0, a1; \
                a0.x = __builtin_amdgcn_exp2f(PC0[i]); a0.y = __builtin_amdgcn_exp2f(PC0[i + 1]); a1.x = __builtin_amdgcn_exp2f(PC1[i]); a1.y = __builtin_amdgcn_exp2f(PC1[i + 1]); \
                PC0[i] = a0.x; PC0[i + 1] = a0.y; PC1[i] = a1.x; PC1[i + 1] = a1.y; rs += a0 + a1; } \
            l_run += rs.x + rs.y; \
        } else { \
        float mx0 = fmaxf(PC0[0], PC1[0]), mx1 = fmaxf(PC0[1], PC1[1]); \
        _Pragma("unroll") for (int i = 2; i < 16; i += 2) { mx0 = fmaxf(mx0, fmaxf(PC0[i], PC1[i])); mx1 = fmaxf(mx1, fmaxf(PC0[i + 1], PC1[i + 1])); } \
        float mx = fmaxf(mx0, mx1); \
        mx = fmaxf(mx, __shfl_xor(mx, 32)); \
        const float m_new = fmaxf(m_run, mx); \
        const float alpha = __builtin_amdgcn_exp2f(m_run - m_new); \
        m_run = m_new; \
        const f32x2_t mm = {m_new, m_new}; \
        f32x2_t rs = {0.f, 0.f}; \
        _Pragma("unroll") for (int i = 0; i < 16; i += 2) { \
            f32x2_t a0 = (f32x2_t){PC0[i], PC0[i + 1]} - mm, a1 = (f32x2_t){PC1[i], PC1[i + 1]} - mm; \
            a0.x = __builtin_amdgcn_exp2f(a0.x); a0.y = __builtin_amdgcn_exp2f(a0.y); a1.x = __builtin_amdgcn_exp2f(a1.x); a1.y = __builtin_amdgcn_exp2f(a1.y); \
            PC0[i] = a0.x; PC0[i + 1] = a0.y; PC1[i] = a1.x; PC1[i + 1] = a1.y; rs += a0 + a1; } \
        l_run = l_run * alpha + (rs.x + rs.y); \
        _Pragma("unroll") for (int i = 0; i < 16; ++i) { o0[i] *= alpha; o1[i] *= alpha; } \
        } \
        const LAS unsigned char* vl = lds + 2 * TB + cur * TB; \
        _Pragma("unroll") for (int kb = 0; kb < 2; ++kb) \
        _Pragma("unroll") for (int s2 = 0; s2 < 2; ++s2) { \
                u32x4 pw; \
                if (kb == 0) { pw.x = cvtpk(PC0[8 * s2 + 0], PC0[8 * s2 + 1]); pw.y = cvtpk(PC0[8 * s2 + 2], PC0[8 * s2 + 3]); pw.z = cvtpk(PC0[8 * s2 + 4], PC0[8 * s2 + 5]); pw.w = cvtpk(PC0[8 * s2 + 6], PC0[8 * s2 + 7]); } \
                else { pw.x = cvtpk(PC1[8 * s2 + 0], PC1[8 * s2 + 1]); pw.y = cvtpk(PC1[8 * s2 + 2], PC1[8 * s2 + 3]); pw.z = cvtpk(PC1[8 * s2 + 4], PC1[8 * s2 + 5]); pw.w = cvtpk(PC1[8 * s2 + 6], PC1[8 * s2 + 7]); } \
                const bf16x8 pb = __builtin_bit_cast(bf16x8, pw); \
                const int kk = 32 * kb + 16 * s2 + 4 * h; \
                { const u32x2 lo = *(const LAS u32x2*)(vl + r32 * PITCH + kk * 2), hi = *(const LAS u32x2*)(vl + r32 * PITCH + (kk + 8) * 2); \
                  u32x4 vw; vw.x = lo.x; vw.y = lo.y; vw.z = hi.x; vw.w = hi.y; \
                  o0 = __builtin_amdgcn_mfma_f32_32x32x16_bf16(__builtin_bit_cast(bf16x8, vw), pb, o0, 0, 0, 0); } \
                { const u32x2 lo = *(const LAS u32x2*)(vl + (32 + r32) * PITCH + kk * 2), hi = *(const LAS u32x2*)(vl + (32 + r32) * PITCH + (kk + 8) * 2); \
                  u32x4 vw; vw.x = lo.x; vw.y = lo.y; vw.z = hi.x; vw.w = hi.y; \
                  o1 = __builtin_amdgcn_mfma_f32_32x32x16_bf16(__builtin_bit_cast(bf16x8, vw), pb, o1, 0, 0, 0); } \
            } \
        if ((t) + 2 < nkt) *(LAS u32x4*)(lds + cur * TB + soff) = KW;                   \
        if ((t) + 1 < nkt) *(LAS u32x4*)(lds + 2 * TB + (cur ^ 1) * TB + soff) = VW;    \
        __syncthreads(); \
    } while (0)

DI void attn_unit(LAS unsigned char* lds, const bf16_t* ZQ, const bf16_t* KB, const bf16_t* VT, bf16_t* ACT4, int b, int g, int qrow0, int key0, int nkt, bool fast) {
    const int tid = tid_(), wave = tid >> 6, lane = tid & 63, r32 = lane & 31, h = lane >> 5;
    const int head = g * 4 + (wave >> 1);
    const int qrow = qrow0 + (wave & 1) * 32 + r32;
    constexpr int PITCH = 144, TB = 64 * PITCH;
    bf16x8 qf[4];
#pragma unroll
    for (int s = 0; s < 4; ++s) qf[s] = *(const bf16x8*)(ZQ + (size_t)qrow * 512 + head * 64 + 16 * s + 8 * h);
    f32x16 o0, o1;
#pragma unroll
    for (int i = 0; i < 16; ++i) { o0[i] = 0.f; o1[i] = 0.f; }
    float m_run = -1e30f, l_run = 0.f;
    const bf16_t* kbase = KB + ((size_t)(b * 2 + g) * SKV + key0) * 64;
    const bf16_t* vbase = VT + ((size_t)(b * 2 + g) * 64) * SKV + key0;
    const int srow = tid >> 3, sch = tid & 7;
    const unsigned soff = (unsigned)(srow * PITCH + sch * 16);
    u32x4 kA = *(const u32x4*)(kbase + (size_t)srow * 64 + sch * 8);
    u32x4 vA = *(const u32x4*)(vbase + (size_t)srow * SKV + sch * 8);
    u32x4 kB = *(const u32x4*)(kbase + ((size_t)64 + srow) * 64 + sch * 8);
    u32x4 vB;
    __syncthreads();
    *(LAS u32x4*)(lds + soff) = kA;
    *(LAS u32x4*)(lds + 2 * TB + soff) = vA;
    *(LAS u32x4*)(lds + TB + soff) = kB;
    if (nkt > 2) kA = *(const u32x4*)(kbase + ((size_t)128 + srow) * 64 + sch * 8);
    vA = *(const u32x4*)(vbase + (size_t)srow * SKV + 64 + sch * 8);
    vB = vA; kB = kA;
    __syncthreads();
    f32x16 pa0, pa1, pb0, pb1;
    attn_qk(pa0, pa1, lds, qf, r32, h);
#pragma unroll
    for (int i = 0; i < 16; ++i) { pb0[i] = 0.f; pb1[i] = 0.f; }
    if (fast) {
#pragma nounroll
        for (int t = 0; t < nkt; t += 2) {
            ATTN_ITER(true, t, pa0, pa1, pb0, pb1, kA, vA, kB, vB);
            ATTN_ITER(true, t + 1, pb0, pb1, pa0, pa1, kB, vB, kA, vA);
        }
    } else {
#pragma nounroll
        for (int t = 0; t < nkt; t += 2) {
            ATTN_ITER(false, t, pa0, pa1, pb0, pb1, kA, vA, kB, vB);
            ATTN_ITER(false, t + 1, pb0, pb1, pa0, pa1, kB, vB, kA, vA);
        }
    }
    const float lt = l_run + __shfl_xor(l_run, 32);
    const float inv = 1.0f / lt;
    bf16_t* orow = ACT4 + (size_t)qrow * 1280 + head * 64;
#pragma unroll
    for (int g4 = 0; g4 < 4; ++g4) {
        u32x2 w; w.x = cvtpk(o0[4 * g4] * inv, o0[4 * g4 + 1] * inv); w.y = cvtpk(o0[4 * g4 + 2] * inv, o0[4 * g4 + 3] * inv);
        *(u32x2*)(orow + 8 * g4 + 4 * h) = w;
        u32x2 w2; w2.x = cvtpk(o1[4 * g4] * inv, o1[4 * g4 + 1] * inv); w2.y = cvtpk(o1[4 * g4 + 2] * inv, o1[4 * g4 + 3] * inv);
        *(u32x2*)(orow + 32 + 8 * g4 + 4 * h) = w2;
    }
}

DI void scpool_phase(const bf16_t* ZS, const bf16_t* ZP, bf16_t* ACT4, const float* convw, int nrows, int G) {
    const int tid = tid_(), lane = tid & 63, wave = tid >> 6;
    const int gw = blockIdx.x * 8 + wave, NGW = G * 8;
    for (int r = gw; r < nrows; r += NGW) {
        int t, N; if (r < ML) { t = r & 2047; N = SEQ; } else { t = (r - ML) & 255; N = CTXL; }
        if (lane < 32) {
            const int c = lane * 8;
            float a[8];
#pragma unroll
            for (int j = 0; j < 8; ++j) a[j] = 0.f;
#pragma unroll
            for (int dt = -1; dt <= 1; ++dt) {
                if (t + dt >= 0 && t + dt < N) {
                    const bf16_t* row = ZS + (size_t)(r + dt) * 768;
                    const u32x4 gc = *(const u32x4*)(row + 256 + c), xs = *(const u32x4*)(row + 512 + c);
                    const f32x4 w0 = *(const f32x4*)(convw + (dt + 1) * 256 + c), w1 = *(const f32x4*)(convw + (dt + 1) * 256 + c + 4);
                    a[0] += w0[0] * bflo(gc.x) * bflo(xs.x); a[1] += w0[1] * bfhi(gc.x) * bfhi(xs.x);
                    a[2] += w0[2] * bflo(gc.y) * bflo(xs.y); a[3] += w0[3] * bfhi(gc.y) * bfhi(xs.y);
                    a[4] += w1[0] * bflo(gc.z) * bflo(xs.z); a[5] += w1[1] * bfhi(gc.z) * bfhi(xs.z);
                    a[6] += w1[2] * bflo(gc.w) * bflo(xs.w); a[7] += w1[3] * bfhi(gc.w) * bfhi(xs.w);
                }
            }
            const u32x4 gb = *(const u32x4*)(ZS + (size_t)r * 768 + c);
            u32x4 w; w.x = cvtpk(bflo(gb.x) * a[0], bfhi(gb.x) * a[1]); w.y = cvtpk(bflo(gb.y) * a[2], bfhi(gb.y) * a[3]);
            w.z = cvtpk(bflo(gb.z) * a[4], bfhi(gb.z) * a[5]); w.w = cvtpk(bflo(gb.w) * a[6], bfhi(gb.w) * a[7]);
            *(u32x4*)(ACT4 + (size_t)r * 1280 + 512 + c) = w;
        } else {
            const int c = (lane - 32) * 8, gi = c >> 6, wdw = 2 << gi, left = (wdw - 1) >> 1, right = wdw >> 1;
            const int lo = (t - left) > 0 ? (t - left) : 0, hi = (t + right + 1) < N ? (t + right + 1) : N;
            float a[8];
#pragma unroll
            for (int j = 0; j < 8; ++j) a[j] = 0.f;
            u32x4 pv[16];
#pragma unroll
            for (int i = 0; i < 16; ++i) { int tt = lo + i; tt = tt < hi ? tt : (hi - 1); pv[i] = *(const u32x4*)(ZP + (size_t)(r - t + tt) * 256 + c); }
#pragma unroll
            for (int i = 0; i < 16; ++i) if (lo + i < hi) {
                const u32x4 v = pv[i];
                a[0] += bflo(v.x); a[1] += bfhi(v.x); a[2] += bflo(v.y); a[3] += bfhi(v.y); a[4] += bflo(v.z); a[5] += bfhi(v.z); a[6] += bflo(v.w); a[7] += bfhi(v.w);
            }
            const float ic = 1.0f / (float)(hi - lo);
            const u32x4 x = *(const u32x4*)(ZP + (size_t)r * 256 + c);
            u32x4 w; w.x = cvtpk(a[0] * ic - bflo(x.x), a[1] * ic - bfhi(x.x)); w.y = cvtpk(a[2] * ic - bflo(x.y), a[3] * ic - bfhi(x.y));
            w.z = cvtpk(a[4] * ic - bflo(x.z), a[5] * ic - bfhi(x.z)); w.w = cvtpk(a[6] * ic - bflo(x.w), a[7] * ic - bfhi(x.w));
            *(u32x4*)(ACT4 + (size_t)r * 1280 + 1024 + c) = w;
        }
    }
}

DI void fixup_phase(const bf16_t* RAW, bf16_t* ACT, const float* wconv, int nchunks, int G) {
    const int tid = tid_();
    for (int it = blockIdx.x; it < nchunks * 2; it += G) {
        const int ch = it >> 1, which = it & 1;
        const int r = ch * 64 + (which ? 63 : 0);
        int t, N; if (r < ML) { t = r & 2047; N = SEQ; } else { t = (r - ML) & 255; N = CTXL; }
        const bf16_t *up, *mid, *dn;
        if (!which) { up = (t > 0) ? RAW + ((size_t)(ch - 1) * 4 + 1) * UPW : nullptr; mid = RAW + ((size_t)ch * 4 + 2) * UPW; dn = RAW + ((size_t)ch * 4 + 3) * UPW; }
        else { up = RAW + ((size_t)ch * 4 + 0) * UPW; mid = RAW + ((size_t)ch * 4 + 1) * UPW; dn = (t < N - 1) ? RAW + ((size_t)(ch + 1) * 4 + 2) * UPW : nullptr; }
        for (int j = tid; j < DFF; j += 512) {
            const float ua = up ? bflo(up[j]) : 0.f, ub = up ? bflo(up[DFF + j]) : 0.f;
            const float ma = bflo(mid[j]), mb = bflo(mid[DFF + j]);
            const float da = dn ? bflo(dn[j]) : 0.f, db = dn ? bflo(dn[DFF + j]) : 0.f;
            const float ca = wconv[j] * ua + wconv[UPW + j] * ma + wconv[2 * UPW + j] * da;
            const float cb = wconv[DFF + j] * ub + wconv[UPW + DFF + j] * mb + wconv[2 * UPW + DFF + j] * db;
            ACT[(size_t)r * DFF + j] = (bf16_t)(cvtpk(ca * sigmoidf_(ca) * cb, 0.f) & 0xffff);
        }
    }
}

#define XB_TMO      128
#define XB_XCNT(j)  (256  + 64 * (j))
#define XB_XSUB(j)  (1280 + 64 * (j))
#define XB_XGEN(j)  (2304 + 64 * (j))
#define XB_TOP      3328
#define XB_TOPGEN   3392
#define XCD_BAR_WORDS 3456
#define XB_SPIN_CAP (1u << 22)
DI unsigned xb_ld(unsigned* p)              { return __hip_atomic_load(p, __ATOMIC_RELAXED, __HIP_MEMORY_SCOPE_AGENT); }
DI unsigned xb_add(unsigned* p, unsigned v) { return __hip_atomic_fetch_add(p, v, __ATOMIC_RELAXED, __HIP_MEMORY_SCOPE_AGENT); }
DI unsigned xb_xcc_id() { return (unsigned)__builtin_amdgcn_s_getreg((3 << 11) | 20) & 0xFu; }
#define XB_SPIN(cond, bar) do { unsigned _sp = 0; while (cond) { __builtin_amdgcn_s_sleep(1); \
    if ((++_sp & 255u) == 0u) { if (xb_ld(&(bar)[XB_TMO])) break; if (_sp > XB_SPIN_CAP) { atomicAdd(&(bar)[XB_TMO], 1u); break; } } } } while (0)
DI void xcd_barrier_complete(unsigned* bar, unsigned x, unsigned& nloc, unsigned& nx) {
    const unsigned G = gridDim.x * gridDim.y * gridDim.z;
    unsigned sum, cnt, mine, sp = 0u;
    for (;;) {
        sum = 0u; cnt = 0u; mine = 0u;
#pragma unroll
        for (unsigned j = 0; j < 16; ++j) { const unsigned c = xb_ld(&bar[XB_XCNT(j)]); sum += c; cnt += (c > 0u) ? 1u : 0u; mine = (j == x) ? c : mine; }
        if (sum == G) break;
        __builtin_amdgcn_s_sleep(1);
        if ((++sp & 255u) == 0u) { if (xb_ld(&bar[XB_TMO])) break; if (sp > XB_SPIN_CAP) { atomicAdd(&bar[XB_TMO], 1u); break; } }
    }
    nloc = mine > 0u ? mine : 1u; nx = cnt > 0u ? cnt : 1u;
}
DI void xb_post(unsigned* bar) { if (threadIdx.x == 0) (void)xb_add(&bar[XB_XCNT(xb_xcc_id())], 1u); }
DI void xcd_barrier(unsigned* bar, volatile LAS unsigned* st) {
    asm volatile("s_waitcnt vmcnt(0)" ::: "memory");
    __syncthreads();
    if (threadIdx.x == 0) {
        const unsigned x = xb_xcc_id();
        __builtin_amdgcn_s_waitcnt(0);
        unsigned nloc = st[0], nx = st[1];
        if (nloc == 0u) { xcd_barrier_complete(bar, x, nloc, nx); st[0] = nloc; st[1] = nx; }
        const unsigned old = xb_add(&bar[XB_XSUB(x)], 1u);
        const unsigned gen = old / nloc;
        if (old + 1u == (gen + 1u) * nloc) {
            __builtin_amdgcn_fence(__ATOMIC_RELEASE, "agent");
            asm volatile("s_waitcnt vmcnt(0)" ::: "memory");
            const unsigned og = xb_add(&bar[XB_TOP], 1u);
            const unsigned tg = og / nx;
            if (og + 1u == (tg + 1u) * nx) xb_add(&bar[XB_TOPGEN], 1u);
            else XB_SPIN(xb_ld(&bar[XB_TOPGEN]) == tg, bar);
            __builtin_amdgcn_fence(__ATOMIC_ACQUIRE, "agent");
            xb_add(&bar[XB_XGEN(x)], 1u);
            asm volatile("s_waitcnt vmcnt(0)" ::: "memory");
        } else {
            XB_SPIN(xb_ld(&bar[XB_XGEN(x)]) == gen, bar);
            __builtin_amdgcn_fence(__ATOMIC_ACQUIRE, "agent");
            asm volatile("s_waitcnt vmcnt(0)" ::: "memory");
        }
    }
    __syncthreads();
}

DI void ph0(LAS unsigned char* lds) {
    KP q = getp(); unsigned char* ws = q->ws;
    const int tid = tid_(), G = gridDim.x, cu = blockIdx.x, gt = cu * 512 + tid, NGT = G * 512;
    float* MODS = (float*)(ws + WS_MODS);
    float* ROPEC = (float*)(ws + WS_ROPE); float* ROPES = ROPEC + 2048 * 32;
    bf16_t* FML = (bf16_t*)(ws + WS_FML); bf16_t* FMC = (bf16_t*)(ws + WS_FMC);
    LAS float* sm = (LAS float*)lds;
    const float* cvec = q->in[1]; const float* cctx = q->in[3]; const float* w_mod = q->in[4]; const float* b_mod = q->in[5];
    for (int it = cu; it < 192; it += G) {
        const int l = it / 96, rem = it % 96, kc = rem / 12, cb = rem % 12;
        __syncthreads();
        for (int e = tid; e < 9 * 128; e += 512) { const int v = e >> 7, k = kc * 128 + (e & 127); const float cv = (v < 8) ? cvec[v * D + k] : cctx[k]; sm[e] = cv / (1.0f + __expf(-cv)); }
        __syncthreads();
        const int j = cb * 512 + tid;
        float a[9];
#pragma unroll
        for (int v = 0; v < 9; ++v) a[v] = 0.f;
        const float* wp = w_mod + ((size_t)l * D + kc * 128) * INW + j;
#pragma unroll 4
        for (int k = 0; k < 128; ++k) { const float w = wp[(size_t)k * INW];
#pragma unroll
            for (int v = 0; v < 9; ++v) a[v] += sm[v * 128 + k] * w; }
        const float bm = (kc == 0) ? b_mod[l * INW + j] : 0.f;
#pragma unroll
        for (int v = 0; v < 9; ++v) atomicAdd(&MODS[(size_t)(l * 9 + v) * INW + j], a[v] + bm);
    }
    for (int e = gt; e < 2048 * 32; e += NGT) {
        const int t = e >> 5, ax = (e >> 4) & 1, i = e & 15;
        const float pos = (float)(ax ? (t & 63) : (t >> 6));
        const float inv = powf(10000.0f, -(float)i * (1.0f / 16.0f));
        float sn, cs; sincosf(pos * inv, &sn, &cs);
        ROPEC[e] = cs; ROPES[e] = sn;
    }
    for (int e = gt; e < 2048 * 512; e += NGT) {
        const int k1 = e >> 9, c8 = e & 511, part = c8 >> 8, n0 = (c8 & 255) * 8;
        float v[8];
#pragma unroll
        for (int j = 0; j < 8; ++j) { const int mm = (k1 * (n0 + j)) & 2047; float sn, cs; sincospif((float)mm * (1.0f / 1024.0f), &sn, &cs); v[j] = (part ? -sn : cs) * 0.022097086912079608f; }
        u32x4 w; w.x = cvtpk(v[0], v[1]); w.y = cvtpk(v[2], v[3]); w.z = cvtpk(v[4], v[5]); w.w = cvtpk(v[6], v[7]);
        *(u32x4*)(FML + (size_t)k1 * 4096 + part * 2048 + n0) = w;
    }
    for (int e = gt; e < 256 * 64; e += NGT) {
        const int k1 = e >> 6, c8 = e & 63, part = c8 >> 5, n0 = (c8 & 31) * 8;
        float v[8];
#pragma unroll
        for (int j = 0; j < 8; ++j) { const int mm = (k1 * (n0 + j)) & 255; float sn, cs; sincospif((float)mm * (1.0f / 128.0f), &sn, &cs); v[j] = (part ? -sn : cs) * 0.0625f; }
        u32x4 w; w.x = cvtpk(v[0], v[1]); w.y = cvtpk(v[2], v[3]); w.z = cvtpk(v[4], v[5]); w.w = cvtpk(v[6], v[7]);
        *(u32x4*)(FMC + (size_t)k1 * 512 + part * 256 + n0) = w;
    }
}
DI void ph_norm(int l, int which, bool do_ctx) {
    KP q = getp(); unsigned char* ws = q->ws;
    const float* MODS = (const float*)(ws + WS_MODS);
    const float* srcL = (l == 0 && which == 0) ? q->in[0] : (const float*)q->out;
    const float* srcC = (l == 0 && which == 0) ? q->in[2] : (const float*)(ws + WS_CX);
    const bool parts = !(l == 0 && which == 0);
    norm_phase(srcL, srcC, do_ctx, q->in[which ? 7 : 6] + l * D, MODS + (size_t)l * 9 * INW, which ? 3 : 0, (bf16_t*)(ws + WS_H), gridDim.x, parts ? (const float*)(ws + WS_CXP) : nullptr, (float*)(ws + WS_CX));
}
DI void ph2(int l, LAS unsigned char* lds) {
    KP q = getp(); unsigned char* ws = q->ws;
    const int G = gridDim.x, cu = blockIdx.x;
    pg8::Gemm g{(const bf16_t*)(ws + WS_H), (const bf16_t*)(ws + WS_WIN), 1024, 1024};
    pg8::Sched S;
    if (l == 0) S.init(72, 25, G, cu, 16);
    else { S.init(64, 25, G, cu, 16); S.nx = 8; S.xpm0 = 64; S.xpn = 2; }
    float* ROPEC = (float*)(ws + WS_ROPE);
    EpiZ E{(bf16_t*)(ws + WS_ZQ), (bf16_t*)(ws + WS_ZS), (bf16_t*)(ws + WS_ZP), (bf16_t*)(ws + WS_KB), (bf16_t*)(ws + WS_VT), (bf16_t*)(ws + WS_YTL), (bf16_t*)(ws + WS_YTC), ws + WS_G8,
           ROPEC, ROPEC + 2048 * 32, q->in[10] + l * 128, q->in[10] + l * 128 + 64};
    pg8::gemm_phase<EpiZ, true>(lds, g, S, E);
}
DI void ph3_dft(int l, LAS unsigned char* lds) {
    KP q = getp(); unsigned char* ws = q->ws;
    const int G = gridDim.x, cu = blockIdx.x;
    const int nsub = (l == 0) ? 2 : 1;
#pragma nounroll
    for (int j = 0; j < nsub; ++j) {
        pg8::Gemm g; pg8::Sched S; EpiDft E;
        if (j == 0) { g = pg8::Gemm{(const bf16_t*)(ws + WS_FML), (const bf16_t*)(ws + WS_YTL), 4096, 4096}; S.init(8, 8, G, cu, 64); E = EpiDft{(bf16_t*)(ws + WS_ACT4), 0, SEQ}; }
        else { g = pg8::Gemm{(const bf16_t*)(ws + WS_FMC), (const bf16_t*)(ws + WS_YTC), 512, 512}; S.init(1, 8, G, (cu + G - 64) % G, 8); E = EpiDft{(bf16_t*)(ws + WS_ACT4), ML, CTXL}; }
        pg8::gemm_phase<EpiDft, true>(lds, g, S, E);
    }
}
DI void ph3_attn(int l, LAS unsigned char* lds) {
    KP q = getp(); unsigned char* ws = q->ws;
    const int G = gridDim.x, cu = blockIdx.x;
    const bf16_t* ZQ = (const bf16_t*)(ws + WS_ZQ); const bf16_t* KB = (const bf16_t*)(ws + WS_KB); const bf16_t* VT = (const bf16_t*)(ws + WS_VT); bf16_t* ACT4 = (bf16_t*)(ws + WS_ACT4);
    bool fast;
    {
        const int ln = tid_() & 63;
        float gq = fabsf(q->in[10][l * 128 + ln]), gk = fabsf(q->in[10][l * 128 + 64 + ln]);
#pragma unroll
        for (int o = 1; o < 64; o <<= 1) { gq = fmaxf(gq, __shfl_xor(gq, o)); gk = fmaxf(gk, __shfl_xor(gk, o)); }
        const float bound = 11.5416f * gq * gk;
        fast = __builtin_amdgcn_readfirstlane(bound <= 60.0f ? 1 : 0) != 0;
    }
    if (G == 256) {
        if (cu >= 64) {
            const int x = cu & 7, idx = (cu - 64) >> 3;
#pragma nounroll
            for (int u = idx; u < 64; u += 24) { const int a = (2 * x + (u >> 5)) * 32 + (u & 31); attn_unit(lds, ZQ, KB, VT, ACT4, a >> 6, (a >> 5) & 1, (a >> 6) * SEQ + (a & 31) * 64, 0, 36, fast); }
        }
    } else {
#pragma nounroll
        for (int a = cu; a < 512; a += G) attn_unit(lds, ZQ, KB, VT, ACT4, a >> 6, (a >> 5) & 1, (a >> 6) * SEQ + (a & 31) * 64, 0, 36, fast);
    }
    if (l == 0) {
#pragma nounroll
        for (int a = (cu + 64) % G; a < 64; a += G) attn_unit(lds, ZQ, KB, VT, ACT4, a >> 3, (a >> 2) & 1, ML + (a >> 3) * CTXL + (a & 3) * 64, SEQ, 4, fast);
    }
}
DI void ph3_scpool(int l) {
    KP q = getp(); unsigned char* ws = q->ws;
    scpool_phase((const bf16_t*)(ws + WS_ZS), (const bf16_t*)(ws + WS_ZP), (bf16_t*)(ws + WS_ACT4), q->in[9] + l * 768, l == 0 ? MT : ML, gridDim.x);
}
DI void ph4(int l, LAS unsigned char* lds) {
    KP q = getp(); unsigned char* ws = q->ws;
    const int G = gridDim.x, cu = blockIdx.x;
    pg8::Gemm g{(const bf16_t*)(ws + WS_ACT4), (const bf16_t*)(ws + WS_WBR), 1280, 1280};
    pg8::Sched S; S.init(l == 0 ? 72 : 64, 4, G, cu, 8); S.sub = 4;
    EpiBr E{ws + WS_G8, (bf16_t*)(ws + WS_Y), ws + WS_PY + (size_t)cu * 131072};
    pg8::gemm_phase<EpiBr, true>(lds, g, S, E);
}
DI void ph_res(int l, int which, LAS unsigned char* lds) {
    KP q = getp(); unsigned char* ws = q->ws;
    const int G = gridDim.x, cu = blockIdx.x;
    const float* mods = (const float*)(ws + WS_MODS) + (size_t)l * 9 * INW;
    float* OUT = q->out; float* CX = (float*)(ws + WS_CX);
    pg8::Gemm g; pg8::Sched S; EpiRes E;
    if (which == 0) {
        g = pg8::Gemm{(const bf16_t*)(ws + WS_Y), (const bf16_t*)(ws + WS_WOUT), 1024, 1024}; S.init(64, 4, G, cu, 16);
        if (l == 0) { S.xs = 1; S.nx = 128; }
        E = EpiRes{(l == 0) ? q->in[0] : (const float*)OUT, OUT, (l == 0) ? q->in[2] : (const float*)CX, CX, mods + 2 * 1024, (float*)(ws + WS_CXP)};
    } else {
        g = pg8::Gemm{(const bf16_t*)(ws + WS_ACT), (const bf16_t*)(ws + WS_WDN), DFF, DFF}; S.init(64, 4, G, cu, 44);
        if (l == 0) { S.xs = 2; S.nx = 128; }
        E = EpiRes{OUT, OUT, CX, CX, mods + 5 * 1024, (float*)(ws + WS_CXP)};
    }
    pg8::gemm_phase<EpiRes, true>(lds, g, S, E);
}
DI void ph7(int l, LAS unsigned char* lds) {
    KP q = getp(); unsigned char* ws = q->ws;
    const int G = gridDim.x, cu = blockIdx.x;
    pg8::Gemm g{(const bf16_t*)(ws + WS_H), (const bf16_t*)(ws + WS_WUP), 1024, 1024};
    pg8::Sched S; S.init(l == 0 ? 72 : 64, 22, G, cu, 16);
    EpiUp E{(bf16_t*)(ws + WS_ACT), (bf16_t*)(ws + WS_RAW), q->in[19] + (size_t)l * 3 * UPW};
    pg8::gemm_phase<EpiUp, true>(lds, g, S, E);
}
DI void ph7b(int l) {
    KP q = getp(); unsigned char* ws = q->ws;
    fixup_phase((const bf16_t*)(ws + WS_RAW), (bf16_t*)(ws + WS_ACT), q->in[19] + (size_t)l * 3 * UPW, l == 0 ? 288 : 256, gridDim.x);
}
DI void ph_final() {
    KP q = getp();
    const int tid = tid_(), lane = tid & 63, gw = blockIdx.x * 8 + (tid >> 6), NGW = gridDim.x * 8;
    const float* fg = q->in[21]; float* OUT = q->out;
    for (int r = gw; r < ML; r += NGW) {
        f32x4* xr = (f32x4*)(OUT + (size_t)r * D) + lane;
        f32x4 v[4]; float s = 0.f;
#pragma unroll
        for (int j = 0; j < 4; ++j) { v[j] = xr[64 * j]; s += (v[j][0] * v[j][0] + v[j][1] * v[j][1]) + (v[j][2] * v[j][2] + v[j][3] * v[j][3]); }
        const float rstd = rsqrtf(wave_sum(s) * (1.0f / D) + EPS);
#pragma unroll
        for (int j = 0; j < 4; ++j) { const f32x4 gg = *(const f32x4*)(fg + 256 * j + 4 * lane); xr[64 * j] = (v[j] * rstd) * gg; }
    }
}

__global__ void __launch_bounds__(512, 2) mega(Params p) {
    extern __shared__ __attribute__((aligned(16))) unsigned char lds_raw[];
    LAS unsigned char* lds = (LAS unsigned char*)lds_raw;
    cg::grid_group grid = cg::this_grid();
    volatile LAS unsigned* xst = (volatile LAS unsigned*)(lds + 131072 + 64);
    if (threadIdx.x < 2) xst[threadIdx.x] = 0u;
    __syncthreads();
    { KP q = getp(); xb_post((unsigned*)(q->ws + WS_CTL)); }
#define GBAR() do { KP q_ = getp(); xcd_barrier((unsigned*)(q_->ws + WS_CTL), xst); } while (0)
    ph0(lds);
    conv_mixer(0, lds, gridDim.x);
    grid.sync();
    ph_norm(0, 0, true);
    GBAR();
#pragma nounroll
    for (int l = 0; l < 2; ++l) {
        for (int rep = 0; rep < REP_P2; ++rep) ph2(l, lds);
        GBAR();
        for (int rep = 0; rep < REP_DFT; ++rep) ph3_dft(l, lds);
        for (int rep = 0; rep < REP_ATTN; ++rep) ph3_attn(l, lds);
        for (int rep = 0; rep < REP_SCP; ++rep) ph3_scpool(l);
        GBAR();
        for (int rep = 0; rep < REP_P4; ++rep) ph4(l, lds);
        GBAR();
        ph_res(l, 0, lds);
        GBAR();
        for (int rep = 0; rep < REP_NORM; ++rep) ph_norm(l, 1, l == 0);
        conv_ffn(l, lds, gridDim.x);
        if (l == 0) conv_mixer(1, lds, gridDim.x);
        GBAR();
        for (int rep = 0; rep < REP_P7; ++rep) ph7(l, lds);
        GBAR();
        ph7b(l);
        GBAR();
        ph_res(l, 1, lds);
        GBAR();
        if (l == 0) { ph_norm(1, 0, true); GBAR(); }
        else ph_final();
    }
#undef GBAR
}

extern "C" void kernel_launch(void* const* d_in, const int* in_sizes, int n_in, void* d_out, int out_size, void* d_ws, size_t ws_size, hipStream_t stream) {
    static int grid_blocks = 0;
    if (grid_blocks == 0) {
        if (n_in != 22 || ws_size < WS_END) { fprintf(stderr, "kernel_launch: unexpected inputs (n_in %d, ws %zu)\n", n_in, ws_size); grid_blocks = -1; return; }
        int dev = 0, cus = 0, per_cu = 0;
        (void)hipGetDevice(&dev);
        (void)hipDeviceGetAttribute(&cus, hipDeviceAttributeMultiprocessorCount, dev);
        if (hipFuncSetAttribute((const void*)mega, hipFuncAttributeMaxDynamicSharedMemorySize, LDS_BYTES) != hipSuccess) { fprintf(stderr, "kernel_launch: hipFuncSetAttribute failed\n"); }
        if (hipOccupancyMaxActiveBlocksPerMultiprocessor(&per_cu, (const void*)mega, 512, LDS_BYTES) != hipSuccess || per_cu < 1) { fprintf(stderr, "kernel_launch: occupancy query gave %d\n", per_cu); per_cu = 1; }
        (void)hipGetLastError();
        grid_blocks = cus * 1;
        fprintf(stderr, "kernel_launch: cus %d per_cu %d grid %d ws %zu\n", cus, per_cu, grid_blocks, ws_size);
    }
    if (grid_blocks < 0) return;
    (void)hipMemsetAsync((char*)d_ws + WS_CTL, 0, WS_MODS + MODS_BYTES, stream);
    Params p{};
    for (int i = 0; i < 22; ++i) p.in[i] = (const float*)d_in[i];
    p.out = (float*)d_out; p.ws = (unsigned char*)d_ws;
    void* args[] = {&p};
    hipError_t e = hipLaunchCooperativeKernel((void*)mega, dim3(grid_blocks), dim3(512), args, LDS_BYTES, stream);
    if (e != hipSuccess) fprintf(stderr, "cooperative launch failed: %s (grid %d)\n", hipGetErrorString(e), grid_blocks);
}
```

```cpp
#include <hip/hip_runtime.h>
#include <hip/hip_cooperative_groups.h>
#include <cstdio>
#include <cstdint>
namespace cg = cooperative_groups;

#define LAS __attribute__((address_space(3)))
#define DI __device__ __forceinline__
typedef unsigned short bf16_t;
typedef short bf16x8 __attribute__((ext_vector_type(8)));
typedef short s16x4 __attribute__((ext_vector_type(4)));
typedef float f32x4 __attribute__((ext_vector_type(4)));
typedef float f32x2_t __attribute__((ext_vector_type(2)));
typedef float f32x16 __attribute__((ext_vector_type(16)));
typedef unsigned u32x4 __attribute__((ext_vector_type(4)));
typedef unsigned u32x2 __attribute__((ext_vector_type(2)));
typedef __bf16 bf16x2_t __attribute__((ext_vector_type(2)));

constexpr int D = 1024, SEQ = 2048, NB = 8, CTXL = 256;
constexpr int ML = NB * SEQ;
constexpr int MC = NB * CTXL;
constexpr int MT = ML + MC;
constexpr int INW = 6144, DFF = 2816, UPW = 5632;
constexpr int NZ = 6400;
constexpr int SKV = SEQ + CTXL;
constexpr float EPS = 1e-6f;

constexpr size_t MiB = 1u << 20;
constexpr size_t WS_CTL = 0;
constexpr size_t WS_MODS = 64 * 1024;
constexpr size_t MODS_BYTES = 2 * 9 * 6144 * 4;
constexpr size_t WS_ROPE = 1 * MiB;
constexpr size_t WS_CX = 2 * MiB;
constexpr size_t WS_FML = 10 * MiB;
constexpr size_t WS_FMC = 26 * MiB;
constexpr size_t WS_WIN = 27 * MiB;
constexpr size_t WS_WBR = WS_WIN + (size_t)NZ * 1024 * 2;
constexpr size_t WS_WOUT = 42 * MiB;
constexpr size_t WS_H = 44 * MiB;
constexpr size_t WS_ACT4 = 44 * MiB;
constexpr size_t WS_ZQ = 89 * MiB;
constexpr size_t WS_ZS = 107 * MiB;
constexpr size_t WS_ZP = 134 * MiB;
constexpr size_t WS_KB = 143 * MiB;
constexpr size_t WS_VT = WS_KB + (size_t)NB * 2 * SKV * 64 * 2;
constexpr size_t WS_YTL = 152 * MiB;
constexpr size_t WS_YTC = 168 * MiB;
constexpr size_t WS_G8 = 170 * MiB;
constexpr size_t WS_PY = 134 * MiB;
constexpr size_t WS_Y = 89 * MiB;
constexpr size_t WS_ACT = 89 * MiB;
constexpr size_t WS_CXP = 190 * MiB;
constexpr size_t WS_WUP = 226 * MiB;
constexpr size_t WS_WDN = 237 * MiB;
constexpr size_t WS_RAW = 243 * MiB;
constexpr size_t WS_END = 256 * MiB;
static_assert(WS_WBR + 1024 * 1280 * 2 <= WS_WOUT && WS_VT + (size_t)NB * 2 * SKV * 64 * 2 <= WS_YTL, "ws map");
static_assert(WS_G8 + (size_t)MT * 4096 <= WS_WDN + 6 * MiB && WS_RAW + 288ull * 4 * UPW * 2 <= WS_END, "ws map");
static_assert(WS_ACT + (size_t)MT * DFF * 2 <= WS_WUP, "ws map");

constexpr int LDS_BYTES = 131072 + 4096;
#define REP_P2 1
#define REP_DFT 1
#define REP_ATTN 1
#define REP_SCP 1
#define REP_P4 1
#define REP_P7 1
#define REP_NORM 1

DI unsigned cvtpk(float lo, float hi) { f32x2_t v = {lo, hi}; bf16x2_t b = __builtin_convertvector(v, bf16x2_t); return __builtin_bit_cast(unsigned, b); }
DI float bflo(unsigned u) { return __uint_as_float(u << 16); }
DI float bfhi(unsigned u) { return __uint_as_float(u & 0xffff0000u); }
DI float wave_sum(float v) {
#pragma unroll
    for (int o = 1; o < 64; o <<= 1) v += __shfl_xor(v, o);
    return v;
}
DI int tid_() { int t; asm volatile("v_mov_b32 %0, %1" : "=v"(t) : "v"((int)threadIdx.x)); return t; }
DI float sigmoidf_(float v) { return 1.0f / (1.0f + __expf(-v)); }

struct Params { const float* in[22]; float* out; unsigned char* ws; };
typedef const __attribute__((address_space(4))) Params* KP;
DI KP getp() { KP q = (KP)__builtin_amdgcn_kernarg_segment_ptr(); asm volatile("" : "+s"(q)); return q; }

namespace pg8 {
constexpr int BM = 256, BK = 64, HALF = 128, HTB = HALF * BK * 2, STAGE_BYTES = 8 * HTB, NXCD = 8, WGM = 8;
DI int lds_byte(int r, int c) { const int st = (r >> 4) * 2 + (c >> 5), rr = r & 15, cc = c & 31, ob = rr * 64 + cc * 2; return st * 1024 + (ob ^ (((ob >> 9) & 1) << 5)); }
DI void stage_rc(int b, int& R, int& C) { const int st = b / 1024, sb = b % 1024, swz = sb ^ (((sb >> 9) & 1) << 5); R = (st >> 1) * 16 + swz / 64; C = (st & 1) * 32 + (swz % 64) / 2; }
DI int perm32(int rho) { const int n = rho >> 4, i = rho & 15; return 8 * (i >> 2) + 4 * n + (i & 3); }

struct Unit { int pm, pn, koff, nt, tag; };
struct Gemm { const bf16_t* A; const bf16_t* Bt; int lda, ldb; };

struct Sched {
    int nM, nN, nwg, G, c, nx, xpm0, xpn, sub, nt, xs;
    DI void init(int nM_, int nN_, int G_, int c_, int nt_) { nM = nM_; nN = nN_; nwg = nM * nN; G = G_; c = c_; nx = 0; xpm0 = 0; xpn = 0; sub = 1; nt = nt_; xs = 0; }
    DI bool next(int i, Unit& u) const {
        int ti = i, s = 0;
        if (sub == 4) { ti = i >> 2; s = i & 3; }
        const long L = (long)ti * G + c;
        if (L < nwg) {
            int wgid = (int)L; { const int q = nwg / NXCD, r = nwg % NXCD, xcd = wgid % NXCD, off = wgid / NXCD; wgid = (xcd < r ? xcd * (q + 1) : r * (q + 1) + (xcd - r) * q) + off; }
            const int nig = WGM * nN, gid = wgid / nig, fm = gid * WGM, gsz = (nM - fm) < WGM ? (nM - fm) : WGM;
            u.pm = fm + ((wgid % nig) % gsz); u.pn = (wgid % nig) / gsz;
        } else if (L - nwg < nx) {
            const int j = (int)(L - nwg);
            if (xs == 3) { const int t = j / 24; u.pm = 64 + t; u.pn = j - 24 * t; u.tag = 0; u.koff = 0; u.nt = nt; return true; }
            if (xs == 4) { u.pm = 64 + j; u.pn = 24; u.tag = 0; u.koff = 0; u.nt = nt; return true; }
            if (xs > 0) {
                const int tile = j >> 2, ks = j & 3; u.pm = 64 + (tile >> 2); u.pn = tile & 3; u.tag = 1 + ks;
                if (xs == 1) { u.koff = ks * 256; u.nt = 4; } else { u.koff = (ks == 0 ? 0 : ks == 1 ? 12 : ks == 2 ? 24 : 34) * 64; u.nt = ks < 2 ? 12 : 10; }
                return true;
            }
            u.pm = xpm0 + j; u.pn = xpn;
        }
        else return false;
        if (sub == 4) { u.tag = s; u.koff = (s == 0) ? 0 : 256 + 256 * s; u.nt = (s == 0) ? 8 : 4; }
        else { u.tag = 0; u.koff = 0; u.nt = nt; }
        return true;
    }
};

typedef f32x4 Acc[2][2][4][2];
DI void zero_acc(Acc& acc) {
#pragma unroll
    for (int a = 0; a < 2; ++a)
#pragma unroll
        for (int b = 0; b < 2; ++b)
#pragma unroll
            for (int m = 0; m < 4; ++m)
#pragma unroll
                for (int n = 0; n < 2; ++n) acc[a][b][m][n] = (f32x4){0.f, 0.f, 0.f, 0.f};
}

template <class Epi, bool ALIGN_EPI>
DI void gemm_phase(LAS unsigned char* lds, const Gemm g, const Sched& S, const Epi& E) {
    int tid; asm volatile("v_mov_b32 %0, %1" : "=v"(tid) : "v"((int)threadIdx.x));
    const int wid = __builtin_amdgcn_readfirstlane(tid >> 6), lane = tid & 63, wr = wid >> 2, wc = wid & 3, fr = lane & 15, fq = lane >> 4;
    unsigned voffA[2], voffB[2];
#pragma unroll
    for (int i = 0; i < 2; ++i) { int R, C; stage_rc(tid * 16 + i * 8192, R, C); const int Rb = Epi::PERM ? ((R & ~31) + perm32(R & 31)) : R;
        voffA[i] = (unsigned)(R * g.lda + C) * 2u; voffB[i] = (unsigned)(Rb * g.ldb + C) * 2u; }
    const size_t kstep = (size_t)(BK * 2);
    const size_t hstepA = (size_t)HALF * g.lda * 2, hstepB = (size_t)HALF * g.ldb * 2;
    const size_t tstepA = 2 * hstepA, tstepB = 2 * hstepB;
    const unsigned ldsw = (unsigned)wid * 1024u;
    const int aoff = lds_byte(wr * 64 + fr, fq * 8), boff = lds_byte(wc * 32 + fr, fq * 8);
#define PG8_SA(b, h) (((b) * 2 + (h)) * HTB)
#define PG8_SB(b, h) ((4 + (b) * 2 + (h)) * HTB)
#define PG8_STAGE(bufoff, gbase, voff) do { _Pragma("unroll") for (int _i = 0; _i < 2; ++_i) \
        __builtin_amdgcn_global_load_lds((const unsigned*)((const char*)(gbase) + (voff)[_i]), (LAS unsigned*)(lds + (bufoff) + ldsw + _i * 8192), 16, 0, 0); } while (0)
#define PG8_LDA(dst, b, h) do { _Pragma("unroll") for (int m = 0; m < 4; ++m) _Pragma("unroll") for (int k = 0; k < 2; ++k) dst[m][k] = *(const LAS bf16x8*)(lds + PG8_SA(b, h) + aoff + m * 2048 + k * 1024); } while (0)
#define PG8_LDB(dst, b, h) do { _Pragma("unroll") for (int n = 0; n < 2; ++n) _Pragma("unroll") for (int k = 0; k < 2; ++k) dst[n][k] = *(const LAS bf16x8*)(lds + PG8_SB(b, h) + boff + n * 2048 + k * 1024); } while (0)
#define PG8_MMA(ai, bj, At, Bt) do { __builtin_amdgcn_s_setprio(1); _Pragma("unroll") for (int m = 0; m < 4; ++m) _Pragma("unroll") for (int n = 0; n < 2; ++n) _Pragma("unroll") for (int k = 0; k < 2; ++k) \
        acc[ai][bj][m][n] = __builtin_amdgcn_mfma_f32_16x16x32_bf16(Bt[n][k], At[m][k], acc[ai][bj][m][n], 0, 0, 0); __builtin_amdgcn_s_setprio(0); } while (0)
#define PG8_WAIT_V(n) asm volatile("s_waitcnt vmcnt(" #n ")" ::: "memory")
#define PG8_WAIT_L(n) asm volatile("s_waitcnt lgkmcnt(" #n ")" ::: "memory")
#define PG8_BAR __builtin_amdgcn_s_barrier()
#define PG8_SCHED __builtin_amdgcn_sched_barrier(0)
    Unit cur, nxt; int ui = 0;
    if (!S.next(0, cur)) return;
    Acc acc;
    { int l2; asm volatile("v_mov_b32 %0, %1" : "=v"(l2) : "v"(lane)); E.init(acc, cur, wr, wc, l2 & 15, l2 >> 4); }
    PG8_WAIT_V(0);
    bf16x8 At[4][2], B0[2][2], B1[2][2];
    const char* cA = (const char*)g.A + (size_t)cur.pm * tstepA + (size_t)cur.koff * 2; const char* cB = (const char*)g.Bt + (size_t)cur.pn * tstepB + (size_t)cur.koff * 2;
    PG8_STAGE(PG8_SB(0, 0), cB, voffB); PG8_STAGE(PG8_SB(0, 1), cB + hstepB, voffB); PG8_STAGE(PG8_SA(0, 0), cA, voffA); PG8_STAGE(PG8_SA(0, 1), cA + hstepA, voffA);
    if (wr == 1) PG8_BAR;
    PG8_WAIT_V(2); PG8_BAR;
    PG8_STAGE(PG8_SB(1, 0), cB + kstep, voffB); PG8_STAGE(PG8_SA(1, 0), cA + kstep, voffA); PG8_STAGE(PG8_SB(1, 1), cB + hstepB + kstep, voffB);
    PG8_WAIT_V(6); PG8_BAR;
    for (;;) {
        const bool has_next = S.next(ui + 1, nxt);
        const char* nA = has_next ? (const char*)g.A + (size_t)nxt.pm * tstepA + (size_t)nxt.koff * 2 : cA;
        const char* nB = has_next ? (const char*)g.Bt + (size_t)nxt.pn * tstepB + (size_t)nxt.koff * 2 : cB;
        const int nt = cur.nt;
        for (int t = 0; t < nt; t += 2) {
            const bool last = (t == nt - 2);
            const char* a1 = cA + (size_t)(t + 1) * kstep;
            const char* a2 = last ? nA : cA + (size_t)(t + 2) * kstep; const char* b2 = last ? nB : cB + (size_t)(t + 2) * kstep;
            const char* a3 = a2 + kstep; const char* b3 = b2 + kstep;
            PG8_LDB(B0, 0, 0); PG8_LDB(B1, 0, 1); PG8_SCHED; PG8_LDA(At, 0, 0); PG8_STAGE(PG8_SA(1, 1), a1 + hstepA, voffA);
            PG8_WAIT_V(8); PG8_WAIT_L(0); PG8_BAR; PG8_MMA(0, 0, At, B0); PG8_MMA(0, 1, At, B1); PG8_BAR; PG8_SCHED;
            PG8_LDA(At, 0, 1); PG8_STAGE(PG8_SB(0, 0), b2, voffB); PG8_STAGE(PG8_SB(0, 1), b2 + hstepB, voffB); PG8_STAGE(PG8_SA(0, 0), a2, voffA);
            PG8_WAIT_V(8); PG8_WAIT_L(0); PG8_BAR; PG8_MMA(1, 0, At, B0); PG8_MMA(1, 1, At, B1); PG8_BAR; PG8_SCHED;
            PG8_LDB(B0, 1, 0); PG8_LDB(B1, 1, 1); PG8_SCHED; PG8_LDA(At, 1, 0); PG8_STAGE(PG8_SA(0, 1), a2 + hstepA, voffA);
            PG8_WAIT_V(8); PG8_WAIT_L(0); PG8_BAR; PG8_MMA(0, 0, At, B0); PG8_MMA(0, 1, At, B1); PG8_BAR; PG8_SCHED;
            PG8_LDA(At, 1, 1); PG8_STAGE(PG8_SB(1, 0), b3, voffB); PG8_STAGE(PG8_SB(1, 1), b3 + hstepB, voffB); PG8_STAGE(PG8_SA(1, 0), a3, voffA);
            PG8_WAIT_V(8); PG8_WAIT_L(0); PG8_BAR; PG8_MMA(1, 0, At, B0); PG8_MMA(1, 1, At, B1); PG8_BAR; PG8_SCHED;
        }
        if constexpr (ALIGN_EPI) { if (wr == 0) PG8_BAR; }
        int l2; asm volatile("v_mov_b32 %0, %1" : "=v"(l2) : "v"(lane));
        E(acc, cur, wr, wc, l2 & 15, l2 >> 4);
        if (!has_next) break;
        E.init(acc, nxt, wr, wc, l2 & 15, l2 >> 4);
        cur = nxt; cA = nA; cB = nB; ++ui;
        if constexpr (ALIGN_EPI) { if (wr == 1) PG8_BAR; }
    }
    PG8_WAIT_V(0);
    if constexpr (!ALIGN_EPI) { if (wr == 0) PG8_BAR; }
    PG8_BAR;
#undef PG8_SA
#undef PG8_SB
#undef PG8_STAGE
#undef PG8_LDA
#undef PG8_LDB
#undef PG8_MMA
#undef PG8_WAIT_V
#undef PG8_WAIT_L
#undef PG8_BAR
#undef PG8_SCHED
}
}
using pg8::Acc; using pg8::Unit;

struct EpiZ {
    static constexpr bool PERM = false;
    bf16_t *ZQ, *ZS, *ZP, *KB, *VT, *YTL, *YTC; unsigned char* G8;
    const float *ropec, *ropes, *qg, *kg;
    DI void init(Acc& acc, const Unit&, int, int, int, int) const { pg8::zero_acc(acc); }
    DI void operator()(Acc& acc, const Unit& u, int wr, int wc, int fr, int fq) const {
        const bool isctx = u.pm >= 64;
        const int pn = u.pn;
        if (pn <= 2) {
            if (pn == 2 && wc >= 2) {
                const int g = wc - 2;
#pragma unroll
                for (int ai = 0; ai < 2; ++ai)
#pragma unroll
                    for (int m = 0; m < 4; ++m) {
                        const int r = u.pm * 256 + ai * 128 + wr * 64 + m * 16 + fr;
                        int b, pos; if (!isctx) { b = r >> 11; pos = r & 2047; } else { const int rc = r - ML; b = rc >> 8; pos = SEQ + (rc & 255); }
                        bf16_t* vb = VT + ((size_t)(b * 2 + g) * 64) * SKV + pos;
#pragma unroll
                        for (int bj = 0; bj < 2; ++bj)
#pragma unroll
                            for (int n = 0; n < 2; ++n) {
                                const f32x4 v = acc[ai][bj][m][n];
                                const unsigned p0 = cvtpk(v[0], v[1]), p1 = cvtpk(v[2], v[3]);
                                const int e = 32 * bj + 16 * n + 4 * fq;
                                vb[(size_t)(e + 0) * SKV] = (bf16_t)(p0 & 0xffff); vb[(size_t)(e + 1) * SKV] = (bf16_t)(p0 >> 16);
                                vb[(size_t)(e + 2) * SKV] = (bf16_t)(p1 & 0xffff); vb[(size_t)(e + 3) * SKV] = (bf16_t)(p1 >> 16);
                            }
                    }
                return;
            }
            const bool isq = pn < 2;
            const float* gain = isq ? qg : kg;
            const float osc = isq ? (0.125f * 1.4426950408889634f) : 1.0f;
#pragma unroll
            for (int ai = 0; ai < 2; ++ai)
#pragma unroll
                for (int m = 0; m < 4; ++m) {
                    const int r = u.pm * 256 + ai * 128 + wr * 64 + m * 16 + fr;
                    float ss = 0.f;
#pragma unroll
                    for (int bj = 0; bj < 2; ++bj)
#pragma unroll
                        for (int n = 0; n < 2; ++n) { const f32x4 v = acc[ai][bj][m][n]; ss += (v[0] * v[0] + v[1] * v[1]) + (v[2] * v[2] + v[3] * v[3]); }
                    ss += __shfl_xor(ss, 16); ss += __shfl_xor(ss, 32);
                    const float rinv = rsqrtf(ss * (1.0f / 64.0f) + EPS) * osc;
                    int b, pos, t = 0; if (!isctx) { b = r >> 11; pos = r & 2047; t = pos; } else { const int rc = r - ML; b = rc >> 8; pos = SEQ + (rc & 255); }
                    bf16_t* dst;
                    if (isq) dst = ZQ + (size_t)r * 512 + (pn * 4 + wc) * 64;
                    else dst = KB + ((size_t)(b * 2 + wc) * SKV + pos) * 64;
#pragma unroll
                    for (int bj = 0; bj < 2; ++bj) {
                        const f32x4 g0 = *(const f32x4*)(gain + 32 * bj + 4 * fq), g1 = *(const f32x4*)(gain + 32 * bj + 16 + 4 * fq);
                        f32x4 x0 = acc[ai][bj][m][0] * rinv * g0, x1 = acc[ai][bj][m][1] * rinv * g1;
                        if (!isctx) {
                            const f32x4 cs = *(const f32x4*)(ropec + (t * 2 + bj) * 16 + 4 * fq), sn = *(const f32x4*)(ropes + (t * 2 + bj) * 16 + 4 * fq);
                            const f32x4 o0 = x0 * cs - x1 * sn, o1 = x1 * cs + x0 * sn; x0 = o0; x1 = o1;
                        }
                        u32x2 w0, w1; w0.x = cvtpk(x0[0], x0[1]); w0.y = cvtpk(x0[2], x0[3]); w1.x = cvtpk(x1[0], x1[1]); w1.y = cvtpk(x1[2], x1[3]);
                        *(u32x2*)(dst + 32 * bj + 4 * fq) = w0; *(u32x2*)(dst + 32 * bj + 16 + 4 * fq) = w1;
                    }
                }
            return;
        }
#pragma unroll
        for (int ai = 0; ai < 2; ++ai)
#pragma unroll
            for (int m = 0; m < 4; ++m) {
                const int r = u.pm * 256 + ai * 128 + wr * 64 + m * 16 + fr;
                int b, t; if (!isctx) { b = r >> 11; t = r & 2047; } else { const int rc = r - ML; b = rc >> 8; t = rc & 255; }
#pragma unroll
                for (int bj = 0; bj < 2; ++bj)
#pragma unroll
                    for (int n = 0; n < 2; ++n) {
                        const f32x4 v = acc[ai][bj][m][n];
                        const int c = 128 * bj + 32 * wc + 16 * n + 4 * fq;
                        if (pn >= 9) {
                            unsigned w = 0;
#pragma unroll
                            for (int x = 0; x < 4; ++x) { const float s = sigmoidf_(v[x]); int q = (int)(s * 256.0f); q = q > 255 ? 255 : (q < 0 ? 0 : q); w |= (unsigned)q << (8 * x); }
                            *(unsigned*)(G8 + (size_t)r * 4096 + (pn - 9) * 256 + c) = w;
                        } else if (pn <= 5) {
                            u32x2 w; w.x = cvtpk(v[0], v[1]); w.y = cvtpk(v[2], v[3]);
                            *(u32x2*)(ZS + (size_t)r * 768 + (pn - 3) * 256 + c) = w;
                        } else if (pn == 8) {
                            u32x2 w; w.x = cvtpk(v[0], v[1]); w.y = cvtpk(v[2], v[3]);
                            *(u32x2*)(ZP + (size_t)r * 256 + c) = w;
                        } else {
                            const int cs = pn - 6;
                            const unsigned p0 = cvtpk(v[0], v[1]), p1 = cvtpk(v[2], v[3]);
                            bf16_t* y; size_t st;
                            if (!isctx) { y = YTL + ((size_t)(b * 256 + c) * 4096) + cs * 2048 + t; st = 4096; }
                            else { y = YTC + ((size_t)(b * 256 + c) * 512) + cs * 256 + t; st = 512; }
                            y[0] = (bf16_t)(p0 & 0xffff); y[st] = (bf16_t)(p0 >> 16); y[2 * st] = (bf16_t)(p1 & 0xffff); y[3 * st] = (bf16_t)(p1 >> 16);
                        }
                    }
            }
    }
};

struct EpiDft {
    static constexpr bool PERM = true;
    bf16_t* ACT4; int rowbase, nrows;
    DI void init(Acc& acc, const Unit&, int, int, int, int) const { pg8::zero_acc(acc); }
    DI void operator()(Acc& acc, const Unit& u, int wr, int wc, int fr, int fq) const {
#pragma unroll
        for (int ai = 0; ai < 2; ++ai)
#pragma unroll
            for (int m = 0; m < 4; ++m) {
                const int r = rowbase + u.pn * nrows + u.pm * 256 + ai * 128 + wr * 64 + m * 16 + fr;
#pragma unroll
                for (int bj = 0; bj < 2; ++bj) {
                    const f32x4 v0 = acc[ai][bj][m][0], v1 = acc[ai][bj][m][1];
                    u32x4 w; w.x = cvtpk(v0[0], v0[1]); w.y = cvtpk(v0[2], v0[3]); w.z = cvtpk(v1[0], v1[1]); w.w = cvtpk(v1[2], v1[3]);
                    *(u32x4*)(ACT4 + (size_t)r * 1280 + 768 + 128 * bj + 32 * wc + 8 * fq) = w;
                }
            }
    }
};

struct EpiBr {
    static constexpr bool PERM = true;
    const unsigned char* G8; bf16_t* Y; unsigned char* PY;
    DI void init(Acc& acc, const Unit&, int, int, int, int) const { pg8::zero_acc(acc); }
    DI void operator()(Acc& acc, const Unit& u, int wr, int wc, int fr, int fq) const {
        const unsigned char* ub = G8 + ((size_t)u.pm * 256 + wr * 64) * 4096 + u.tag * 1024 + u.pn * 256 + 32 * wc;
        const unsigned lo = (unsigned)(fr * 4096 + 8 * fq);
        unsigned char* pyb = PY + (size_t)((wr * 4 + wc) * 64 + fr + 16 * fq) * 16;
        bf16_t* yb = Y + ((size_t)u.pm * 256 + wr * 64) * 1024 + u.pn * 256 + 32 * wc;
        const unsigned yo = (unsigned)(fr * 1024 + 8 * fq);
#pragma unroll
        for (int ai = 0; ai < 2; ++ai) {
            u32x2 gw[4][2];
#pragma unroll
            for (int m = 0; m < 4; ++m)
#pragma unroll
                for (int bj = 0; bj < 2; ++bj) gw[m][bj] = *(const u32x2*)(ub + ((ai * 128 + m * 16) * 4096 + bj * 128) + lo);
#pragma unroll
            for (int m = 0; m < 4; ++m)
#pragma unroll
                for (int bj = 0; bj < 2; ++bj) {
                    f32x4 v[2];
#pragma unroll
                    for (int n = 0; n < 2; ++n) { const unsigned w = n ? gw[m][bj].y : gw[m][bj].x;
#pragma unroll
                        for (int x = 0; x < 4; ++x) { const float gq = ((float)((w >> (8 * x)) & 255u) + 0.5f) * (1.0f / 256.0f); v[n][x] = acc[ai][bj][m][n][x] * gq; } }
                    unsigned char* pp = pyb + (size_t)(((ai * 4 + m) * 2 + bj) * 512) * 16;
                    if (u.tag != 0) {
                        const u32x4 pv = *(const u32x4*)pp;
                        v[0][0] += bflo(pv.x); v[0][1] += bfhi(pv.x); v[0][2] += bflo(pv.y); v[0][3] += bfhi(pv.y);
                        v[1][0] += bflo(pv.z); v[1][1] += bfhi(pv.z); v[1][2] += bflo(pv.w); v[1][3] += bfhi(pv.w);
                    }
                    u32x4 w; w.x = cvtpk(v[0][0], v[0][1]); w.y = cvtpk(v[0][2], v[0][3]); w.z = cvtpk(v[1][0], v[1][1]); w.w = cvtpk(v[1][2], v[1][3]);
                    if (u.tag != 3) *(u32x4*)pp = w;
                    else *(u32x4*)(yb + ((ai * 128 + m * 16) * 1024 + bj * 128) + yo) = w;
                }
        }
    }
};

struct EpiRes {
    static constexpr bool PERM = false;
    const float* srcL; float* dstL; const float* srcC; float* dstC; const float* gates; float* cxp;
    DI void init(Acc& acc, const Unit&, int, int, int, int) const { pg8::zero_acc(acc); }
    DI void operator()(Acc& acc, const Unit& u, int wr, int wc, int fr, int fq) const {
        const bool isctx = u.pm >= 64;
        const size_t rb = isctx ? ((size_t)(u.pm - 64) * 256 + wr * 64) : ((size_t)u.pm * 256 + wr * 64);
        const float* sb = (isctx ? srcC : srcL) + rb * D + u.pn * 256 + 32 * wc;
        float* db = (isctx ? dstC : dstL) + rb * D + u.pn * 256 + 32 * wc;
        const float* gb = gates + (size_t)(isctx ? 8 : (u.pm >> 3)) * 6144 + u.pn * 256 + 32 * wc;
        const unsigned lo = (unsigned)(fr * D + 4 * fq), go = (unsigned)(4 * fq);
        if (u.tag >= 2) {
            float* pb = cxp + (size_t)(u.tag - 2) * MC * D + rb * D + u.pn * 256 + 32 * wc;
#pragma unroll
            for (int ai = 0; ai < 2; ++ai)
#pragma unroll
                for (int m = 0; m < 4; ++m)
#pragma unroll
                    for (int bj = 0; bj < 2; ++bj)
#pragma unroll
                        for (int n = 0; n < 2; ++n) {
                            const int co = (ai * 128 + m * 16) * D + bj * 128 + n * 16;
                            const f32x4 gg = *(const f32x4*)(gb + (bj * 128 + n * 16) + go);
                            *(f32x4*)(pb + co + lo) = gg * acc[ai][bj][m][n];
                        }
            return;
        }
#pragma unroll
        for (int ai = 0; ai < 2; ++ai)
#pragma unroll
            for (int m = 0; m < 4; ++m) {
#pragma unroll
                for (int bj = 0; bj < 2; ++bj)
#pragma unroll
                    for (int n = 0; n < 2; ++n) {
                        const int co = (ai * 128 + m * 16) * D + bj * 128 + n * 16;
                        const f32x4 s = *(const f32x4*)(sb + co + lo), gg = *(const f32x4*)(gb + (bj * 128 + n * 16) + go);
                        *(f32x4*)(db + co + lo) = s + gg * acc[ai][bj][m][n];
                    }
                if (m == 3) asm volatile("" ::: "memory");
            }
    }
};

struct EpiUp {
    static constexpr bool PERM = true;
    bf16_t* ACT; bf16_t* RAW; const float* wconv;
    DI void init(Acc& acc, const Unit&, int, int, int, int) const { pg8::zero_acc(acc); }
    DI void operator()(Acc& acc, const Unit& u, int wr, int wc, int fr, int fq) const {
        const int lane = fr + 16 * fq;
        const int jl = 32 * wc + 8 * fq;
        const int ja = u.pn * 128 + jl;
        bf16_t* ab = ACT + ((size_t)u.pm * 256 + wr * 64) * DFF + u.pn * 128 + 32 * wc;
        const unsigned alo = (unsigned)(fr * DFF + 8 * fq);
#pragma unroll
        for (int ai = 0; ai < 2; ++ai) {
            const int rbase = u.pm * 256 + ai * 128 + wr * 64;
#pragma unroll
            for (int m = 0; m < 4; m += 3) {
                const bool dump = (m == 0) ? (fr < 2) : (fr >= 14);
                if (dump) {
                    const int slot = (m == 0) ? (2 + fr) : (fr - 14);
                    bf16_t* rw = RAW + ((size_t)(rbase >> 6) * 4 + slot) * UPW;
#pragma unroll
                    for (int bj = 0; bj < 2; ++bj) {
                        const f32x4 v0 = acc[ai][bj][m][0], v1 = acc[ai][bj][m][1];
                        u32x4 w; w.x = cvtpk(v0[0], v0[1]); w.y = cvtpk(v0[2], v0[3]); w.z = cvtpk(v1[0], v1[1]); w.w = cvtpk(v1[2], v1[3]);
                        *(u32x4*)(rw + bj * DFF + ja) = w;
                    }
                }
            }
#pragma unroll
            for (int n = 0; n < 2; ++n) {
#pragma unroll
                for (int xp = 0; xp < 2; ++xp) {
                    float act[4][2];
#pragma unroll
                    for (int xx = 0; xx < 2; ++xx) {
                        const int x = 2 * xp + xx;
                        float ca[4], cb[4];
#pragma unroll
                        for (int bj = 0; bj < 2; ++bj) {
                            const float* wp = wconv + bj * DFF + ja + 4 * n + x;
                            const float w0 = wp[0], w1 = wp[UPW], w2 = wp[2 * UPW];
                            float R[4], L[4];
#pragma unroll
                            for (int m = 0; m < 4; ++m) { const int vi = __float_as_int(acc[ai][bj][m][n][x]);
                                R[m] = __int_as_float(__builtin_amdgcn_update_dpp(vi, vi, 0x121, 0xF, 0xF, false));
                                L[m] = __int_as_float(__builtin_amdgcn_update_dpp(vi, vi, 0x12F, 0xF, 0xF, false)); }
#pragma unroll
                            for (int m = 0; m < 4; ++m) {
                                const float up = (fr > 0) ? R[m] : (m > 0 ? R[m > 0 ? m - 1 : 0] : 0.f);
                                const float dn = (fr < 15) ? L[m] : (m < 3 ? L[m < 3 ? m + 1 : 3] : 0.f);
                                const float cv = w0 * up + w1 * acc[ai][bj][m][n][x] + w2 * dn;
                                if (bj == 0) ca[m] = cv; else cb[m] = cv;
                            }
                        }
#pragma unroll
                        for (int m = 0; m < 4; ++m) act[m][xx] = ca[m] * sigmoidf_(ca[m]) * cb[m];
                    }
#pragma unroll
                    for (int m = 0; m < 4; ++m) {
                        const bool skip = (m == 0 && fr == 0) || (m == 3 && fr == 15);
                        if (!skip) *(unsigned*)(ab + ((ai * 128 + m * 16) * DFF + 4 * n + 2 * xp) + alo) = cvtpk(act[m][0], act[m][1]);
                    }
                    asm volatile("" ::: "memory");
                }
            }
        }
    }
};

DI void transpose_item(const float* W, int ldn, int k0, int n0, bf16_t* WT, int drow0, int ldd, int koff, LAS float* scr, int lane) {
#pragma unroll 8
    for (int i = 0; i < 32; ++i) { const int kk = 2 * i + (lane >> 5); scr[kk * 33 + (lane & 31)] = W[(size_t)(k0 + kk) * ldn + n0 + (lane & 31)]; }
    asm volatile("s_waitcnt lgkmcnt(0)" ::: "memory");
    const int c = lane & 7;
#pragma unroll
    for (int j = 0; j < 4; ++j) { const int n = (lane >> 3) + 8 * j; const LAS float* s = scr + (8 * c) * 33 + n;
        u32x4 o; o.x = cvtpk(s[0 * 33], s[1 * 33]); o.y = cvtpk(s[2 * 33], s[3 * 33]); o.z = cvtpk(s[4 * 33], s[5 * 33]); o.w = cvtpk(s[6 * 33], s[7 * 33]);
        *(u32x4*)(WT + (size_t)(drow0 + n) * ldd + koff + k0 + 8 * c) = o; }
    asm volatile("s_waitcnt lgkmcnt(0)" ::: "memory");
}
DI int win_dest(int n0) {
    if (n0 < 768) { const int tile = n0 >> 8, within = n0 & 255, hd = within >> 6, e = within & 63; return tile * 256 + 128 * (e >> 5) + 32 * hd + (e & 31); }
    if (n0 < 1536) return n0;
    if (n0 < 1792) return -1;
    return n0 + 256;
}
DI int wup_dest(int n0) { if (n0 < DFF) return 256 * (n0 >> 7) + (n0 & 127); const int j = n0 - DFF; return 256 * (j >> 7) + 128 + (j & 127); }

DI void conv_mixer(int l, LAS unsigned char* lds, int G) {
    KP q = getp(); unsigned char* ws = q->ws;
    const int tid = tid_(), lane = tid & 63, wave = tid >> 6;
    const int gw = blockIdx.x * 8 + wave, NGW = G * 8;
    LAS float* scr = (LAS float*)(lds + wave * 8448);
    bf16_t* WinT = (bf16_t*)(ws + WS_WIN); bf16_t* WbrT = (bf16_t*)(ws + WS_WBR); bf16_t* WoutT = (bf16_t*)(ws + WS_WOUT);
    const float* w_in = q->in[8] + (size_t)l * D * INW;
    constexpr int I_IN = 16 * 192, I_BA = 8 * 32, I_BS = 4 * 32, I_O = 16 * 32;
    constexpr int NIT = I_IN + I_BA + 2 * I_BS + I_O;
    for (int it = gw; it < NIT; it += NGW) {
        int r = it;
        if (r < I_IN) { const int kb = r / 192, nb = r % 192, n0 = nb * 32, d = win_dest(n0); if (d >= 0) transpose_item(w_in, INW, kb * 64, n0, WinT, d, 1024, 0, scr, lane); continue; } r -= I_IN;
        if (r < I_BA) { const int kb = r / 32, nb = r % 32; transpose_item(q->in[13] + (size_t)l * 512 * D, D, kb * 64, nb * 32, WbrT, nb * 32, 1280, 0, scr, lane); continue; } r -= I_BA;
        if (r < I_BS) { const int kb = r / 32, nb = r % 32; transpose_item(q->in[14] + (size_t)l * 256 * D, D, kb * 64, nb * 32, WbrT, nb * 32, 1280, 512, scr, lane); continue; } r -= I_BS;
        if (r < I_BS) { const int kb = r / 32, nb = r % 32; transpose_item(q->in[15] + (size_t)l * 256 * D, D, kb * 64, nb * 32, WbrT, nb * 32, 1280, 768, scr, lane); continue; } r -= I_BS;
        { const int kb = r / 32, nb = r % 32; transpose_item(q->in[17] + (size_t)l * D * D, D, kb * 64, nb * 32, WoutT, nb * 32, 1024, 0, scr, lane); }
    }
    __syncthreads();
    LAS float* tab = (LAS float*)(lds + 8 * 8448);
    if (tid < 64) { float s, c; sincospif((float)tid * (1.0f / 32.0f), &s, &c); tab[tid] = c; tab[64 + tid] = s; }
    __syncthreads();
    const int gt = blockIdx.x * 512 + tid, NGT = G * 512;
    for (int e = gt; e < 512 * 1024; e += NGT) {
        const int k = e & 1023, nrow = e >> 10, cs = nrow >> 8, g = (nrow >> 6) & 3, k2 = nrow & 63;
        const float* src = w_in + (size_t)k * INW + 1536 + g * 64;
        const LAS float* tb = tab + cs * 64;
        float a = 0.f;
#pragma unroll 4
        for (int c4 = 0; c4 < 16; ++c4) { const f32x4 v = *(const f32x4*)(src + 4 * c4);
#pragma unroll
            for (int x = 0; x < 4; ++x) a += v[x] * tb[(k2 * (4 * c4 + x)) & 63]; }
        WinT[(size_t)(1536 + nrow) * 1024 + k] = (bf16_t)(cvtpk(a * 0.125f, 0.f) & 0xffff);
    }
    const float* pm = q->in[11] + (size_t)l * 4 * 64 * 64; const float* psc = q->in[12] + (size_t)l * 256; const float* wp = q->in[16] + (size_t)l * 256 * D;
    for (int e = gt; e < 256 * 1024; e += NGT) {
        const int n = e & 1023, gc = e >> 10, g = gc >> 6;
        float a = 0.f;
#pragma unroll 8
        for (int d = 0; d < 64; ++d) a += pm[(size_t)gc * 64 + d] * psc[g * 64 + d] * wp[(size_t)(g * 64 + d) * D + n];
        WbrT[(size_t)n * 1280 + 1024 + gc] = (bf16_t)(cvtpk(a, 0.f) & 0xffff);
    }
    __syncthreads();
}

DI void conv_ffn(int l, LAS unsigned char* lds, int G) {
    KP q = getp(); unsigned char* ws = q->ws;
    const int tid = tid_(), lane = tid & 63, wave = tid >> 6;
    const int gw = blockIdx.x * 8 + wave, NGW = G * 8;
    LAS float* scr = (LAS float*)(lds + wave * 8448);
    bf16_t* WupT = (bf16_t*)(ws + WS_WUP); bf16_t* WdnT = (bf16_t*)(ws + WS_WDN);
    constexpr int I_U = 16 * 176, I_D = 44 * 32;
    for (int it = gw; it < I_U + I_D; it += NGW) {
        int r = it;
        if (r < I_U) { const int kb = r / 176, nb = r % 176, n0 = nb * 32; transpose_item(q->in[18] + (size_t)l * D * UPW, UPW, kb * 64, n0, WupT, wup_dest(n0), 1024, 0, scr, lane); continue; } r -= I_U;
        { const int kb = r / 32, nb = r % 32; transpose_item(q->in[20] + (size_t)l * DFF * D, D, kb * 64, nb * 32, WdnT, nb * 32, DFF, 0, scr, lane); }
    }
}

DI void norm_rows2(const float* x0, const float* x1, const float* gain, const float* md0, const float* md1, int si, bf16_t* o0, bf16_t* o1, int lane, const float* part, float* wb) {
    const f32x4* xr0 = (const f32x4*)x0 + lane; const f32x4* xr1 = (const f32x4*)x1 + lane;
    f32x4 v0[4], v1[4]; float s0 = 0.f, s1 = 0.f;
#pragma unroll
    for (int j = 0; j < 4; ++j) { v0[j] = xr0[64 * j]; v1[j] = xr1[64 * j]; }
    if (part) {
#pragma unroll
        for (int pi = 0; pi < 3; ++pi) { const f32x4* p0 = (const f32x4*)(part + (size_t)pi * MC * D) + lane;
#pragma unroll
            for (int j = 0; j < 4; ++j) { v0[j] += p0[64 * j]; v1[j] += p0[256 + 64 * j]; } }
        f32x4* w0 = (f32x4*)wb + lane;
#pragma unroll
        for (int j = 0; j < 4; ++j) { w0[64 * j] = v0[j]; w0[256 + 64 * j] = v1[j]; }
    }
#pragma unroll
    for (int j = 0; j < 4; ++j) { s0 += (v0[j][0] * v0[j][0] + v0[j][1] * v0[j][1]) + (v0[j][2] * v0[j][2] + v0[j][3] * v0[j][3]); s1 += (v1[j][0] * v1[j][0] + v1[j][1] * v1[j][1]) + (v1[j][2] * v1[j][2] + v1[j][3] * v1[j][3]); }
    const float r0 = rsqrtf(wave_sum(s0) * (1.0f / D) + EPS), r1 = rsqrtf(wave_sum(s1) * (1.0f / D) + EPS);
#pragma unroll
    for (int j = 0; j < 4; ++j) {
        const int c = 256 * j + 4 * lane;
        const f32x4 g = *(const f32x4*)(gain + c);
        const f32x4 sh0 = *(const f32x4*)(md0 + si * 1024 + c), sc0 = *(const f32x4*)(md0 + (si + 1) * 1024 + c);
        const f32x4 sh1 = *(const f32x4*)(md1 + si * 1024 + c), sc1 = *(const f32x4*)(md1 + (si + 1) * 1024 + c);
        const f32x4 h0 = ((v0[j] * r0) * g) * (1.0f + sc0) + sh0, h1 = ((v1[j] * r1) * g) * (1.0f + sc1) + sh1;
        u32x2 w0; w0.x = cvtpk(h0[0], h0[1]); w0.y = cvtpk(h0[2], h0[3]);
        u32x2 w1; w1.x = cvtpk(h1[0], h1[1]); w1.y = cvtpk(h1[2], h1[3]);
        *(u32x2*)(o0 + c) = w0; *(u32x2*)(o1 + c) = w1;
    }
}
DI void norm_phase(const float* srcL, const float* srcC, bool do_ctx, const float* gain, const float* mods, int si, bf16_t* H, int G, const float* cxp, float* cxw) {
    const int tid = tid_(), lane = tid & 63, wave = tid >> 6;
    const int gw = blockIdx.x * 8 + wave, NGW = G * 8;
    const int nrows = do_ctx ? MT : ML;
    for (int r = 2 * gw; r < nrows; r += 2 * NGW) {
        const float *x0, *x1, *md0, *md1;
        if (r < ML) { x0 = srcL + (size_t)r * D; md0 = mods + (size_t)(r >> 11) * 6144; x1 = x0 + D; md1 = md0; }
        else { x0 = srcC + (size_t)(r - ML) * D; md0 = mods + (size_t)8 * 6144; x1 = x0 + D; md1 = md0; }
        const bool pc = (r >= ML) && cxp;
        norm_rows2(x0, x1, gain, md0, md1, si, H + (size_t)r * D, H + (size_t)(r + 1) * D, lane, pc ? cxp + (size_t)(r - ML) * D : nullptr, pc ? cxw + (size_t)(r - ML) * D : nullptr);
    }
}

DI void attn_qk(f32x16& p0, f32x16& p1, const LAS unsigned char* kl, const bf16x8 (&qf)[4], int r32, int h) {
    constexpr int PITCH = 144;
#pragma unroll
    for (int i = 0; i < 16; ++i) { p0[i] = 0.f; p1[i] = 0.f; }
#pragma unroll
    for (int s = 0; s < 4; ++s) {
        const bf16x8 ka = *(const LAS bf16x8*)(kl + r32 * PITCH + (16 * s + 8 * h) * 2);
        const bf16x8 kb2 = *(const LAS bf16x8*)(kl + (32 + r32) * PITCH + (16 * s + 8 * h) * 2);
        p0 = __builtin_amdgcn_mfma_f32_32x32x16_bf16(ka, qf[s], p0, 0, 0, 0);
        p1 = __builtin_amdgcn_mfma_f32_32x32x16_bf16(kb2, qf[s], p1, 0, 0, 0);
    }
}
#define ATTN_ITER(FAST, t, PC0, PC1, PN0, PN1, KW, VW, KL, VL) do { \
        const int cur = (t) & 1; \
        if ((t) + 3 < nkt) KL = *(const u32x4*)(kbase + ((size_t)((t) + 3) * 64 + srow) * 64 + sch * 8); \
        if ((t) + 2 < nkt) VL = *(const u32x4*)(vbase + (size_t)srow * SKV + ((t) + 2) * 64 + sch * 8); \
        if ((t) + 1 < nkt) attn_qk(PN0, PN1, lds + (cur ^ 1) * TB, qf, r32, h); \
        if (FAST) {                                           \
            f32x2_t rs = {0.f, 0.f}; \
            _Pragma("unroll") for (int i = 0; i < 16; i += 2) { \
                f32x2_t a0, a1; \
                a0.x = __builtin_amdgcn_exp2f(PC0[i]); a0.y = __builtin_amdgcn_exp2f(PC0[i + 1]); a1.x = __builtin_amdgcn_exp2f(PC1[i]); a1.y = __builtin_amdgcn_exp2f(PC1[i + 1]); \
                PC0[i] = a0.x; PC0[i + 1] = a0.y; PC1[i] = a1.x; PC1[i + 1] = a1.y; rs += a0 + a1; } \
            l_run += rs.x + rs.y; \
        } else { \
        float mx0 = fmaxf(PC0[0], PC1[0]), mx1 = fmaxf(PC0[1], PC1[1]); \
        _Pragma("unroll") for (int i = 2; i < 16; i += 2) { mx0 = fmaxf(mx0, fmaxf(PC0[i], PC1[i])); mx1 = fmaxf(mx1, fmaxf(PC0[i + 1], PC1[i + 1])); } \
        float mx = fmaxf(mx0, mx1); \
        mx = fmaxf(mx, __shfl_xor(mx, 32)); \
        const float m_new = fmaxf(m_run, mx); \
        const float alpha = __builtin_amdgcn_exp2f(m_run - m_new); \
        m_run = m_new; \
        const f32x2_t mm = {m_new, m_new}; \
        f32x2_t rs = {0.f, 0.f}; \
        _Pragma("unroll") for (int i = 0; i < 16; i += 2) { \
            f32x2_t a0 = (f32x2_t){PC0[i], PC0[i + 1]} - mm, a1 = (f32x2_t){PC1[i], PC1[i + 1]} - mm; \
            a0.x = __builtin_amdgcn_exp2f(a0.x); a0.y = __builtin_amdgcn_exp2f(a0.y); a1.x = __builtin_amdgcn_exp2f(a1.x); a1.y = __builtin_amdgcn_exp2f(a1.y); \
            PC0[i] = a0.x; PC0[i + 1] = a0.y; PC1[i] = a1.x; PC1[i + 1] = a1.y; rs += a0 + a1; } \
        l_run = l_run * alpha + (rs.x + rs.y); \
        _Pragma("unroll") for (int i = 0; i < 16; ++i) { o0[i] *= alpha; o1[i] *= alpha; } \
        } \
        const LAS unsigned char* vl = lds + 2 * TB + cur * TB; \
        _Pragma("unroll") for (int kb = 0; kb < 2; ++kb) \
        _Pragma("unroll") for (int s2 = 0; s2 < 2; ++s2) { \
                u32x4 pw; \
                if (kb == 0) { pw.x = cvtpk(PC0[8 * s2 + 0], PC0[8 * s2 + 1]); pw.y = cvtpk(PC0[8 * s2 + 2], PC0[8 * s2 + 3]); pw.z = cvtpk(PC0[8 * s2 + 4], PC0[8 * s2 + 5]); pw.w = cvtpk(PC0[8 * s2 + 6], PC0[8 * s2 + 7]); } \
                else { pw.x = cvtpk(PC1[8 * s2 + 0], PC1[8 * s2 + 1]); pw.y = cvtpk(PC1[8 * s2 + 2], PC1[8 * s2 + 3]); pw.z = cvtpk(PC1[8 * s2 + 4], PC1[8 * s2 + 5]); pw.w = cvtpk(PC1[8 * s2 + 6], PC1[8 * s2 + 7]); } \
                const bf16x8 pb = __builtin_bit_cast(bf16x8, pw); \
                const int kk = 32 * kb + 16 * s2 + 4 * h; \
                { const u32x2 lo = *(const LAS u32x2*)(vl + r32 * PITCH + kk * 2), hi = *(const LAS u32x2*)(vl + r32 * PITCH + (kk + 8) * 2); \
                  u32x4 vw; vw.x = lo.x; vw.y = lo.y; vw.z = hi.x; vw.w = hi.y; \
                  o0 = __builtin_amdgcn_mfma_f32_32x32x16_bf16(__builtin_bit_cast(bf16x8, vw), pb, o0, 0, 0, 0); } \
                { const u32x2 lo = *(const LAS u32x2*)(vl + (32 + r32) * PITCH + kk * 2), hi = *(const LAS u32x2*)(vl + (32 + r32) * PITCH + (kk + 8) * 2); \
                  u32x4 vw; vw.x = lo.x; vw.y = lo.y; vw.z = hi.x; vw.w = hi.y; \
                  o1 = __builtin_amdgcn_mfma_f32_32x32x16_bf16(__builtin_bit_cast(bf16x8, vw), pb, o1, 0, 0, 0); } \
            } \
        if ((t) + 2 < nkt) *(LAS u32x4*)(lds + cur * TB + soff) = KW;                   \
        if ((t) + 1 < nkt) *(LAS u32x4*)(lds + 2 * TB + (cur ^ 1) * TB + soff) = VW;    \
        __syncthreads(); \
    } while (0)

DI void attn_unit(LAS unsigned char* lds, const bf16_t* ZQ, const bf16_t* KB, const bf16_t* VT, bf16_t* ACT4, int b, int g, int qrow0, int key0, int nkt, bool fast) {
    const int tid = tid_(), wave = tid >> 6, lane = tid & 63, r32 = lane & 31, h = lane >> 5;
    const int head = g * 4 + (wave >> 1);
    const int qrow = qrow0 + (wave & 1) * 32 + r32;
    constexpr int PITCH = 144, TB = 64 * PITCH;
    bf16x8 qf[4];
#pragma unroll
    for (int s = 0; s < 4; ++s) qf[s] = *(const bf16x8*)(ZQ + (size_t)qrow * 512 + head * 64 + 16 * s + 8 * h);
    f32x16 o0, o1;
#pragma unroll
    for (int i = 0; i < 16; ++i) { o0[i] = 0.f; o1[i] = 0.f; }
    float m_run = -1e30f, l_run = 0.f;
    const bf16_t* kbase = KB + ((size_t)(b * 2 + g) * SKV + key0) * 64;
    const bf16_t* vbase = VT + ((size_t)(b * 2 + g) * 64) * SKV + key0;
    const int srow = tid >> 3, sch = tid & 7;
    const unsigned soff = (unsigned)(srow * PITCH + sch * 16);
    u32x4 kA = *(const u32x4*)(kbase + (size_t)srow * 64 + sch * 8);
    u32x4 vA = *(const u32x4*)(vbase + (size_t)srow * SKV + sch * 8);
    u32x4 kB = *(const u32x4*)(kbase + ((size_t)64 + srow) * 64 + sch * 8);
    u32x4 vB;
    __syncthreads();
    *(LAS u32x4*)(lds + soff) = kA;
    *(LAS u32x4*)(lds + 2 * TB + soff) = vA;
    *(LAS u32x4*)(lds + TB + soff) = kB;
    if (nkt > 2) kA = *(const u32x4*)(kbase + ((size_t)128 + srow) * 64 + sch * 8);
    vA = *(const u32x4*)(vbase + (size_t)srow * SKV + 64 + sch * 8);
    vB = vA; kB = kA;
    __syncthreads();
    f32x16 pa0, pa1, pb0, pb1;
    attn_qk(pa0, pa1, lds, qf, r32, h);
#pragma unroll
    for (int i = 0; i < 16; ++i) { pb0[i] = 0.f; pb1[i] = 0.f; }
    if (fast) {
#pragma nounroll
        for (int t = 0; t < nkt; t += 2) {
            ATTN_ITER(true, t, pa0, pa1, pb0, pb1, kA, vA, kB, vB);
            ATTN_ITER(true, t + 1, pb0, pb1, pa0, pa1, kB, vB, kA, vA);
        }
    } else {
#pragma nounroll
        for (int t = 0; t < nkt; t += 2) {
            ATTN_ITER(false, t, pa0, pa1, pb0, pb1, kA, vA, kB, vB);
            ATTN_ITER(false, t + 1, pb0, pb1, pa0, pa1, kB, vB, kA, vA);
        }
    }
    const float lt = l_run + __shfl_xor(l_run, 32);
    const float inv = 1.0f / lt;
    bf16_t* orow = ACT4 + (size_t)qrow * 1280 + head * 64;
#pragma unroll
    for (int g4 = 0; g4 < 4; ++g4) {
        u32x2 w; w.x = cvtpk(o0[4 * g4] * inv, o0[4 * g4 + 1] * inv); w.y = cvtpk(o0[4 * g4 + 2] * inv, o0[4 * g4 + 3] * inv);
        *(u32x2*)(orow + 8 * g4 + 4 * h) = w;
        u32x2 w2; w2.x = cvtpk(o1[4 * g4] * inv, o1[4 * g4 + 1] * inv); w2.y = cvtpk(o1[4 * g4 + 2] * inv, o1[4 * g4 + 3] * inv);
        *(u32x2*)(orow + 32 + 8 * g4 + 4 * h) = w2;
    }
}

DI void scpool_phase(const bf16_t* ZS, const bf16_t* ZP, bf16_t* ACT4, const float* convw, int nrows, int G) {
    const int tid = tid_(), lane = tid & 63, wave = tid >> 6;
    int gw = blockIdx.x * 8 + wave, NGW = G * 8;
    for (int r = gw; r < nrows; r += NGW) {
        int t, N; if (r < ML) { t = r & 2047; N = SEQ; } else { t = (r - ML) & 255; N = CTXL; }
        if (lane < 32) {
            const int c = lane * 8;
            float a[8];
#pragma unroll
            for (int j = 0; j < 8; ++j) a[j] = 0.f;
#pragma unroll
            for (int dt = -1; dt <= 1; ++dt) {
                if (t + dt >= 0 && t + dt < N) {
                    const bf16_t* row = ZS + (size_t)(r + dt) * 768;
                    const u32x4 gc = *(const u32x4*)(row + 256 + c), xs = *(const u32x4*)(row + 512 + c);
                    const f32x4 w0 = *(const f32x4*)(convw + (dt + 1) * 256 + c), w1 = *(const f32x4*)(convw + (dt + 1) * 256 + c + 4);
                    a[0] += w0[0] * bflo(gc.x) * bflo(xs.x); a[1] += w0[1] * bfhi(gc.x) * bfhi(xs.x);
                    a[2] += w0[2] * bflo(gc.y) * bflo(xs.y); a[3] += w0[3] * bfhi(gc.y) * bfhi(xs.y);
                    a[4] += w1[0] * bflo(gc.z) * bflo(xs.z); a[5] += w1[1] * bfhi(gc.z) * bfhi(xs.z);
                    a[6] += w1[2] * bflo(gc.w) * bflo(xs.w); a[7] += w1[3] * bfhi(gc.w) * bfhi(xs.w);
                }
            }
            const u32x4 gb = *(const u32x4*)(ZS + (size_t)r * 768 + c);
            u32x4 w; w.x = cvtpk(bflo(gb.x) * a[0], bfhi(gb.x) * a[1]); w.y = cvtpk(bflo(gb.y) * a[2], bfhi(gb.y) * a[3]);
            w.z = cvtpk(bflo(gb.z) * a[4], bfhi(gb.z) * a[5]); w.w = cvtpk(bflo(gb.w) * a[6], bfhi(gb.w) * a[7]);
            *(u32x4*)(ACT4 + (size_t)r * 1280 + 512 + c) = w;
        } else {
            const int c = (lane - 32) * 8, gi = c >> 6, wdw = 2 << gi, left = (wdw - 1) >> 1, right = wdw >> 1;
            const int lo = (t - left) > 0 ? (t - left) : 0, hi = (t + right + 1) < N ? (t + right + 1) : N;
            float a[8];
#pragma unroll
            for (int j = 0; j < 8; ++j) a[j] = 0.f;
            u32x4 pv[16];
#pragma unroll
            for (int i = 0; i < 16; ++i) { int tt = lo + i; tt = tt < hi ? tt : (hi - 1); pv[i] = *(const u32x4*)(ZP + (size_t)(r - t + tt) * 256 + c); }
#pragma unroll
            for (int i = 0; i < 16; ++i) if (lo + i < hi) {
                const u32x4 v = pv[i];
                a[0] += bflo(v.x); a[1] += bfhi(v.x); a[2] += bflo(v.y); a[3] += bfhi(v.y); a[4] += bflo(v.z); a[5] += bfhi(v.z); a[6] += bflo(v.w); a[7] += bfhi(v.w);
            }
            const float ic = 1.0f / (float)(hi - lo);
            const u32x4 x = *(const u32x4*)(ZP + (size_t)r * 256 + c);
            u32x4 w; w.x = cvtpk(a[0] * ic - bflo(x.x), a[1] * ic - bfhi(x.x)); w.y = cvtpk(a[2] * ic - bflo(x.y), a[3] * ic - bfhi(x.y));
            w.z = cvtpk(a[4] * ic - bflo(x.z), a[5] * ic - bfhi(x.z)); w.w = cvtpk(a[6] * ic - bflo(x.w), a[7] * ic - bfhi(x.w));
            *(u32x4*)(ACT4 + (size_t)r * 1280 + 1024 + c) = w;
        }
    }
}

DI void fixup_phase(const bf16_t* RAW, bf16_t* ACT, const float* wconv, int nchunks, int G) {
    const int tid = tid_();
    for (int it = blockIdx.x; it < nchunks * 2; it += G) {
        const int ch = it >> 1, which = it & 1;
        const int r = ch * 64 + (which ? 63 : 0);
        int t, N; if (r < ML) { t = r & 2047; N = SEQ; } else { t = (r - ML) & 255; N = CTXL; }
        const bf16_t *up, *mid, *dn;
        if (!which) { up = (t > 0) ? RAW + ((size_t)(ch - 1) * 4 + 1) * UPW : nullptr; mid = RAW + ((size_t)ch * 4 + 2) * UPW; dn = RAW + ((size_t)ch * 4 + 3) * UPW; }
        else { up = RAW + ((size_t)ch * 4 + 0) * UPW; mid = RAW + ((size_t)ch * 4 + 1) * UPW; dn = (t < N - 1) ? RAW + ((size_t)(ch + 1) * 4 + 2) * UPW : nullptr; }
        for (int j = tid; j < DFF; j += 512) {
            const float ua = up ? bflo(up[j]) : 0.f, ub = up ? bflo(up[DFF + j]) : 0.f;
            const float ma = bflo(mid[j]), mb = bflo(mid[DFF + j]);
            const float da = dn ? bflo(dn[j]) : 0.f, db = dn ? bflo(dn[DFF + j]) : 0.f;
            const float ca = wconv[j] * ua + wconv[UPW + j] * ma + wconv[2 * UPW + j] * da;
            const float cb = wconv[DFF + j] * ub + wconv[UPW + DFF + j] * mb + wconv[2 * UPW + DFF + j] * db;
            ACT[(size_t)r * DFF + j] = (bf16_t)(cvtpk(ca * sigmoidf_(ca) * cb, 0.f) & 0xffff);
        }
    }
}

#define XB_TMO      128
#define XB_XCNT(j)  (256  + 64 * (j))
#define XB_XSUB(j)  (1280 + 64 * (j))
#define XB_XGEN(j)  (2304 + 64 * (j))
#define XB_TOP      3328
#define XB_TOPGEN   3392
#define XCD_BAR_WORDS 3456
#define XB_SPIN_CAP (1u << 22)
DI unsigned xb_ld(unsigned* p)              { return __hip_atomic_load(p, __ATOMIC_RELAXED, __HIP_MEMORY_SCOPE_AGENT); }
DI unsigned xb_add(unsigned* p, unsigned v) { return __hip_atomic_fetch_add(p, v, __ATOMIC_RELAXED, __HIP_MEMORY_SCOPE_AGENT); }
DI unsigned xb_xcc_id() { return (unsigned)__builtin_amdgcn_s_getreg((3 << 11) | 20) & 0xFu; }
#define XB_SPIN(cond, bar) do { unsigned _sp = 0; while (cond) { __builtin_amdgcn_s_sleep(1); \
    if ((++_sp & 255u) == 0u) { if (xb_ld(&(bar)[XB_TMO])) break; if (_sp > XB_SPIN_CAP) { atomicAdd(&(bar)[XB_TMO], 1u); break; } } } } while (0)
DI void xcd_barrier_complete(unsigned* bar, unsigned x, unsigned& nloc, unsigned& nx) {
    const unsigned G = gridDim.x * gridDim.y * gridDim.z;
    unsigned sum, cnt, mine, sp = 0u;
    for (;;) {
        sum = 0u; cnt = 0u; mine = 0u;
#pragma unroll
        for (unsigned j = 0; j < 16; ++j) { const unsigned c = xb_ld(&bar[XB_XCNT(j)]); sum += c; cnt += (c > 0u) ? 1u : 0u; mine = (j == x) ? c : mine; }
        if (sum == G) break;
        __builtin_amdgcn_s_sleep(1);
        if ((++sp & 255u) == 0u) { if (xb_ld(&bar[XB_TMO])) break; if (sp > XB_SPIN_CAP) { atomicAdd(&bar[XB_TMO], 1u); break; } }
    }
    nloc = mine > 0u ? mine : 1u; nx = cnt > 0u ? cnt : 1u;
}
DI void xb_post(unsigned* bar) { if (threadIdx.x == 0) (void)xb_add(&bar[XB_XCNT(xb_xcc_id())], 1u); }
DI void xcd_barrier(unsigned* bar, volatile LAS unsigned* st) {
    asm volatile("s_waitcnt vmcnt(0)" ::: "memory");
    __syncthreads();
    if (threadIdx.x == 0) {
        const unsigned x = xb_xcc_id();
        __builtin_amdgcn_s_waitcnt(0);
        unsigned nloc = st[0], nx = st[1];
        if (nloc == 0u) { xcd_barrier_complete(bar, x, nloc, nx); st[0] = nloc; st[1] = nx; }
        const unsigned old = xb_add(&bar[XB_XSUB(x)], 1u);
        const unsigned gen = old / nloc;
        if (old + 1u == (gen + 1u) * nloc) {
            __builtin_amdgcn_fence(__ATOMIC_RELEASE, "agent");
            asm volatile("s_waitcnt vmcnt(0)" ::: "memory");
            const unsigned og = xb_add(&bar[XB_TOP], 1u);
            const unsigned tg = og / nx;
            if (og + 1u == (tg + 1u) * nx) xb_add(&bar[XB_TOPGEN], 1u);
            else XB_SPIN(xb_ld(&bar[XB_TOPGEN]) == tg, bar);
            __builtin_amdgcn_fence(__ATOMIC_ACQUIRE, "agent");
            xb_add(&bar[XB_XGEN(x)], 1u);
            asm volatile("s_waitcnt vmcnt(0)" ::: "memory");
        } else {
            XB_SPIN(xb_ld(&bar[XB_XGEN(x)]) == gen, bar);
            __builtin_amdgcn_fence(__ATOMIC_ACQUIRE, "agent");
            asm volatile("s_waitcnt vmcnt(0)" ::: "memory");
        }
    }
    __syncthreads();
}

DI void ph0(LAS unsigned char* lds) {
    KP q = getp(); unsigned char* ws = q->ws;
    const int tid = tid_(), G = gridDim.x, cu = blockIdx.x, gt = cu * 512 + tid, NGT = G * 512;
    float* MODS = (float*)(ws + WS_MODS);
    float* ROPEC = (float*)(ws + WS_ROPE); float* ROPES = ROPEC + 2048 * 32;
    bf16_t* FML = (bf16_t*)(ws + WS_FML); bf16_t* FMC = (bf16_t*)(ws + WS_FMC);
    LAS float* sm = (LAS float*)lds;
    const float* cvec = q->in[1]; const float* cctx = q->in[3]; const float* w_mod = q->in[4]; const float* b_mod = q->in[5];
    for (int it = cu; it < 192; it += G) {
        const int l = it / 96, rem = it % 96, kc = rem / 12, cb = rem % 12;
        __syncthreads();
        for (int e = tid; e < 9 * 128; e += 512) { const int v = e >> 7, k = kc * 128 + (e & 127); const float cv = (v < 8) ? cvec[v * D + k] : cctx[k]; sm[e] = cv / (1.0f + __expf(-cv)); }
        __syncthreads();
        const int j = cb * 512 + tid;
        float a[9];
#pragma unroll
        for (int v = 0; v < 9; ++v) a[v] = 0.f;
        const float* wp = w_mod + ((size_t)l * D + kc * 128) * INW + j;
#pragma unroll 4
        for (int k = 0; k < 128; ++k) { const float w = wp[(size_t)k * INW];
#pragma unroll
            for (int v = 0; v < 9; ++v) a[v] += sm[v * 128 + k] * w; }
        const float bm = (kc == 0) ? b_mod[l * INW + j] : 0.f;
#pragma unroll
        for (int v = 0; v < 9; ++v) atomicAdd(&MODS[(size_t)(l * 9 + v) * INW + j], a[v] + bm);
    }
    for (int e = gt; e < 2048 * 32; e += NGT) {
        const int t = e >> 5, ax = (e >> 4) & 1, i = e & 15;
        const float pos = (float)(ax ? (t & 63) : (t >> 6));
        const float inv = powf(10000.0f, -(float)i * (1.0f / 16.0f));
        float sn, cs; sincosf(pos * inv, &sn, &cs);
        ROPEC[e] = cs; ROPES[e] = sn;
    }
    for (int e = gt; e < 2048 * 512; e += NGT) {
        const int k1 = e >> 9, c8 = e & 511, part = c8 >> 8, n0 = (c8 & 255) * 8;
        float v[8];
#pragma unroll
        for (int j = 0; j < 8; ++j) { const int mm = (k1 * (n0 + j)) & 2047; float sn, cs; sincospif((float)mm * (1.0f / 1024.0f), &sn, &cs); v[j] = (part ? -sn : cs) * 0.022097086912079608f; }
        u32x4 w; w.x = cvtpk(v[0], v[1]); w.y = cvtpk(v[2], v[3]); w.z = cvtpk(v[4], v[5]); w.w = cvtpk(v[6], v[7]);
        *(u32x4*)(FML + (size_t)k1 * 4096 + part * 2048 + n0) = w;
    }
    for (int e = gt; e < 256 * 64; e += NGT) {
        const int k1 = e >> 6, c8 = e & 63, part = c8 >> 5, n0 = (c8 & 31) * 8;
        float v[8];
#pragma unroll
        for (int j = 0; j < 8; ++j) { const int mm = (k1 * (n0 + j)) & 255; float sn, cs; sincospif((float)mm * (1.0f / 128.0f), &sn, &cs); v[j] = (part ? -sn : cs) * 0.0625f; }
        u32x4 w; w.x = cvtpk(v[0], v[1]); w.y = cvtpk(v[2], v[3]); w.z = cvtpk(v[4], v[5]); w.w = cvtpk(v[6], v[7]);
        *(u32x4*)(FMC + (size_t)k1 * 512 + part * 256 + n0) = w;
    }
}
DI void ph_norm(int l, int which, bool do_ctx) {
    KP q = getp(); unsigned char* ws = q->ws;
    const float* MODS = (const float*)(ws + WS_MODS);
    const float* srcL = (l == 0 && which == 0) ? q->in[0] : (const float*)q->out;
    const float* srcC = (l == 0 && which == 0) ? q->in[2] : (const float*)(ws + WS_CX);
    const bool parts = !(l == 0 && which == 0);
    norm_phase(srcL, srcC, do_ctx, q->in[which ? 7 : 6] + l * D, MODS + (size_t)l * 9 * INW, which ? 3 : 0, (bf16_t*)(ws + WS_H), gridDim.x, parts ? (const float*)(ws + WS_CXP) : nullptr, (float*)(ws + WS_CX));
}
DI void ph2(int l, LAS unsigned char* lds, bool tail) {
    KP q = getp(); unsigned char* ws = q->ws;
    const int G = gridDim.x, cu = blockIdx.x;
    pg8::Gemm g{(const bf16_t*)(ws + WS_H), (const bf16_t*)(ws + WS_WIN), 1024, 1024};
    pg8::Sched S;
    if (tail) { S.init(0, 25, G, (cu + G - 192) % G, 16); S.xs = 4; S.nx = 8; }
    else if (l == 0) { S.init(64, 25, G, cu, 16); S.xs = 3; S.nx = 192; }
    else { S.init(64, 25, G, cu, 16); S.nx = 8; S.xpm0 = 64; S.xpn = 2; }
    float* ROPEC = (float*)(ws + WS_ROPE);
    EpiZ E{(bf16_t*)(ws + WS_ZQ), (bf16_t*)(ws + WS_ZS), (bf16_t*)(ws + WS_ZP), (bf16_t*)(ws + WS_KB), (bf16_t*)(ws + WS_VT), (bf16_t*)(ws + WS_YTL), (bf16_t*)(ws + WS_YTC), ws + WS_G8,
           ROPEC, ROPEC + 2048 * 32, q->in[10] + l * 128, q->in[10] + l * 128 + 64};
    pg8::gemm_phase<EpiZ, true>(lds, g, S, E);
}
DI void ph3_dft(int l, LAS unsigned char* lds) {
    KP q = getp(); unsigned char* ws = q->ws;
    const int G = gridDim.x, cu = blockIdx.x;
    const int nsub = (l == 0) ? 2 : 1;
#pragma nounroll
    for (int j = 0; j < nsub; ++j) {
        pg8::Gemm g; pg8::Sched S; EpiDft E;
        if (j == 0) { g = pg8::Gemm{(const bf16_t*)(ws + WS_FML), (const bf16_t*)(ws + WS_YTL), 4096, 4096}; S.init(8, 8, G, cu, 64); E = EpiDft{(bf16_t*)(ws + WS_ACT4), 0, SEQ}; }
        else { g = pg8::Gemm{(const bf16_t*)(ws + WS_FMC), (const bf16_t*)(ws + WS_YTC), 512, 512}; S.init(1, 8, G, (cu + G - 64) % G, 8); E = EpiDft{(bf16_t*)(ws + WS_ACT4), ML, CTXL}; }
        pg8::gemm_phase<EpiDft, true>(lds, g, S, E);
    }
}
DI void ph3_attn(int l, LAS unsigned char* lds) {
    KP q = getp(); unsigned char* ws = q->ws;
    const int G = gridDim.x, cu = blockIdx.x;
    const bf16_t* ZQ = (const bf16_t*)(ws + WS_ZQ); const bf16_t* KB = (const bf16_t*)(ws + WS_KB); const bf16_t* VT = (const bf16_t*)(ws + WS_VT); bf16_t* ACT4 = (bf16_t*)(ws + WS_ACT4);
    bool fast;
    {
        const int ln = tid_() & 63;
        float gq = fabsf(q->in[10][l * 128 + ln]), gk = fabsf(q->in[10][l * 128 + 64 + ln]);
#pragma unroll
        for (int o = 1; o < 64; o <<= 1) { gq = fmaxf(gq, __shfl_xor(gq, o)); gk = fmaxf(gk, __shfl_xor(gk, o)); }
        const float bound = 11.5416f * gq * gk;
        fast = __builtin_amdgcn_readfirstlane(bound <= 60.0f ? 1 : 0) != 0;
    }
    if (G == 256) {
        if (cu >= 64) {
            const int x = cu & 7, idx = (cu - 64) >> 3;
#pragma nounroll
            for (int u = idx; u < 64; u += 24) { const int a = (2 * x + (u >> 5)) * 32 + (u & 31); attn_unit(lds, ZQ, KB, VT, ACT4, a >> 6, (a >> 5) & 1, (a >> 6) * SEQ + (a & 31) * 64, 0, 36, fast); }
        }
    } else {
#pragma nounroll
        for (int a = cu; a < 512; a += G) attn_unit(lds, ZQ, KB, VT, ACT4, a >> 6, (a >> 5) & 1, (a >> 6) * SEQ + (a & 31) * 64, 0, 36, fast);
    }
    if (l == 0) {
#pragma nounroll
        for (int a = (cu + 64) % G; a < 64; a += G) attn_unit(lds, ZQ, KB, VT, ACT4, a >> 3, (a >> 2) & 1, ML + (a >> 3) * CTXL + (a & 3) * 64, SEQ, 4, fast);
    }
}
DI void ph3_scpool(int l) {
    KP q = getp(); unsigned char* ws = q->ws;
    scpool_phase((const bf16_t*)(ws + WS_ZS), (const bf16_t*)(ws + WS_ZP), (bf16_t*)(ws + WS_ACT4), q->in[9] + l * 768, l == 0 ? MT : ML, gridDim.x);
}
DI void ph4(int l, LAS unsigned char* lds) {
    KP q = getp(); unsigned char* ws = q->ws;
    const int G = gridDim.x, cu = blockIdx.x;
    pg8::Gemm g{(const bf16_t*)(ws + WS_ACT4), (const bf16_t*)(ws + WS_WBR), 1280, 1280};
    pg8::Sched S; S.init(l == 0 ? 72 : 64, 4, G, cu, 8); S.sub = 4;
    EpiBr E{ws + WS_G8, (bf16_t*)(ws + WS_Y), ws + WS_PY + (size_t)cu * 131072};
    pg8::gemm_phase<EpiBr, true>(lds, g, S, E);
}
DI void ph_res(int l, int which, LAS unsigned char* lds) {
    KP q = getp(); unsigned char* ws = q->ws;
    const int G = gridDim.x, cu = blockIdx.x;
    const float* mods = (const float*)(ws + WS_MODS) + (size_t)l * 9 * INW;
    float* OUT = q->out; float* CX = (float*)(ws + WS_CX);
    pg8::Gemm g; pg8::Sched S; EpiRes E;
    if (which == 0) {
        g = pg8::Gemm{(const bf16_t*)(ws + WS_Y), (const bf16_t*)(ws + WS_WOUT), 1024, 1024}; S.init(64, 4, G, cu, 16);
        if (l == 0) { S.xs = 1; S.nx = 128; }
        E = EpiRes{(l == 0) ? q->in[0] : (const float*)OUT, OUT, (l == 0) ? q->in[2] : (const float*)CX, CX, mods + 2 * 1024, (float*)(ws + WS_CXP)};
    } else {
        g = pg8::Gemm{(const bf16_t*)(ws + WS_ACT), (const bf16_t*)(ws + WS_WDN), DFF, DFF}; S.init(64, 4, G, cu, 44);
        if (l == 0) { S.xs = 2; S.nx = 128; }
        E = EpiRes{OUT, OUT, CX, CX, mods + 5 * 1024, (float*)(ws + WS_CXP)};
    }
    pg8::gemm_phase<EpiRes, true>(lds, g, S, E);
}
DI void ph7(int l, LAS unsigned char* lds) {
    KP q = getp(); unsigned char* ws = q->ws;
    const int G = gridDim.x, cu = blockIdx.x;
    pg8::Gemm g{(const bf16_t*)(ws + WS_H), (const bf16_t*)(ws + WS_WUP), 1024, 1024};
    pg8::Sched S; S.init(l == 0 ? 72 : 64, 22, G, cu, 16);
    EpiUp E{(bf16_t*)(ws + WS_ACT), (bf16_t*)(ws + WS_RAW), q->in[19] + (size_t)l * 3 * UPW};
    pg8::gemm_phase<EpiUp, true>(lds, g, S, E);
}
DI void ph7b(int l) {
    KP q = getp(); unsigned char* ws = q->ws;
    fixup_phase((const bf16_t*)(ws + WS_RAW), (bf16_t*)(ws + WS_ACT), q->in[19] + (size_t)l * 3 * UPW, l == 0 ? 288 : 256, gridDim.x);
}
DI void ph_final() {
    KP q = getp();
    const int tid = tid_(), lane = tid & 63, gw = blockIdx.x * 8 + (tid >> 6), NGW = gridDim.x * 8;
    const float* fg = q->in[21]; float* OUT = q->out;
    for (int r = gw; r < ML; r += NGW) {
        f32x4* xr = (f32x4*)(OUT + (size_t)r * D) + lane;
        f32x4 v[4]; float s = 0.f;
#pragma unroll
        for (int j = 0; j < 4; ++j) { v[j] = xr[64 * j]; s += (v[j][0] * v[j][0] + v[j][1] * v[j][1]) + (v[j][2] * v[j][2] + v[j][3] * v[j][3]); }
        const float rstd = rsqrtf(wave_sum(s) * (1.0f / D) + EPS);
#pragma unroll
        for (int j = 0; j < 4; ++j) { const f32x4 gg = *(const f32x4*)(fg + 256 * j + 4 * lane); xr[64 * j] = (v[j] * rstd) * gg; }
    }
}

__global__ void __launch_bounds__(512, 2) mega(Params p) {
    extern __shared__ __attribute__((aligned(16))) unsigned char lds_raw[];
    LAS unsigned char* lds = (LAS unsigned char*)lds_raw;
    cg::grid_group grid = cg::this_grid();
    volatile LAS unsigned* xst = (volatile LAS unsigned*)(lds + 131072 + 64);
    if (threadIdx.x < 2) xst[threadIdx.x] = 0u;
    __syncthreads();
    { KP q = getp(); xb_post((unsigned*)(q->ws + WS_CTL)); }
#define GBAR() do { KP q_ = getp(); xcd_barrier((unsigned*)(q_->ws + WS_CTL), xst); } while (0)
    ph0(lds);
    conv_mixer(0, lds, gridDim.x);
    grid.sync();
    ph_norm(0, 0, true);
    GBAR();
#pragma nounroll
    for (int l = 0; l < 2; ++l) {
        for (int rep = 0; rep < REP_P2; ++rep) ph2(l, lds, false);
        GBAR();
        for (int rep = 0; rep < REP_DFT; ++rep) ph3_dft(l, lds);
        for (int rep = 0; rep < REP_ATTN; ++rep) ph3_attn(l, lds);
        if (l == 0) ph2(0, lds, true);
        for (int rep = 0; rep < REP_SCP; ++rep) ph3_scpool(l);
        GBAR();
        for (int rep = 0; rep < REP_P4; ++rep) ph4(l, lds);
        GBAR();
        ph_res(l, 0, lds);
        GBAR();
        for (int rep = 0; rep < REP_NORM; ++rep) ph_norm(l, 1, l == 0);
        conv_ffn(l, lds, gridDim.x);
        if (l == 0) conv_mixer(1, lds, gridDim.x);
        GBAR();
        for (int rep = 0; rep < REP_P7; ++rep) ph7(l, lds);
        GBAR();
        ph7b(l);
        GBAR();
        ph_res(l, 1, lds);
        GBAR();
        if (l == 0) { ph_norm(1, 0, true); GBAR(); }
        else ph_final();
    }
#undef GBAR
}

extern "C" void kernel_launch(void* const* d_in, const int* in_sizes, int n_in, void* d_out, int out_size, void* d_ws, size_t ws_size, hipStream_t stream) {
    static int grid_blocks = 0;
    if (grid_blocks == 0) {
        if (n_in != 22 || ws_size < WS_END) { fprintf(stderr, "kernel_launch: unexpected inputs (n_in %d, ws %zu)\n", n_in, ws_size); grid_blocks = -1; return; }
        int dev = 0, cus = 0, per_cu = 0;
        (void)hipGetDevice(&dev);
        (void)hipDeviceGetAttribute(&cus, hipDeviceAttributeMultiprocessorCount, dev);
        if (hipFuncSetAttribute((const void*)mega, hipFuncAttributeMaxDynamicSharedMemorySize, LDS_BYTES) != hipSuccess) { fprintf(stderr, "kernel_launch: hipFuncSetAttribute failed\n"); }
        if (hipOccupancyMaxActiveBlocksPerMultiprocessor(&per_cu, (const void*)mega, 512, LDS_BYTES) != hipSuccess || per_cu < 1) { fprintf(stderr, "kernel_launch: occupancy query gave %d\n", per_cu); per_cu = 1; }
        (void)hipGetLastError();
        grid_blocks = cus * 1;
        fprintf(stderr, "kernel_launch: cus %d per_cu %d grid %d ws %zu\n", cus, per_cu, grid_blocks, ws_size);
    }
    if (grid_blocks < 0) return;
    (void)hipMemsetAsync((char*)d_ws + WS_CTL, 0, WS_MODS + MODS_BYTES, stream);
    Params p{};
    for (int i = 0; i < 22; ++i) p.in[i] = (const float*)d_in[i];
    p.out = (float*)d_out; p.ws = (unsigned char*)d_ws;
    void* args[] = {&p};
    hipError_t e = hipLaunchCooperativeKernel((void*)mega, dim3(grid_blocks), dim3(512), args, LDS_BYTES, stream);
    if (e != hipSuccess) fprintf(stderr, "cooperative launch failed: %s (grid %d)\n", hipGetErrorString(e), grid_blocks);
}
```

```cpp
#include <hip/hip_runtime.h>
#include <hip/hip_cooperative_groups.h>
#include <cstdio>
#include <cstdint>
namespace cg = cooperative_groups;

#define LAS __attribute__((address_space(3)))
#define DI __device__ __forceinline__
typedef unsigned short bf16_t;
typedef short bf16x8 __attribute__((ext_vector_type(8)));
typedef short s16x4 __attribute__((ext_vector_type(4)));
typedef float f32x4 __attribute__((ext_vector_type(4)));
typedef float f32x2_t __attribute__((ext_vector_type(2)));
typedef float f32x16 __attribute__((ext_vector_type(16)));
typedef unsigned u32x4 __attribute__((ext_vector_type(4)));
typedef unsigned u32x2 __attribute__((ext_vector_type(2)));
typedef __bf16 bf16x2_t __attribute__((ext_vector_type(2)));

constexpr int D = 1024, SEQ = 2048, NB = 8, CTXL = 256;
constexpr int ML = NB * SEQ;
constexpr int MC = NB * CTXL;
constexpr int MT = ML + MC;
constexpr int INW = 6144, DFF = 2816, UPW = 5632;
constexpr int NZ = 6400;
constexpr int SKV = SEQ + CTXL;
constexpr float EPS = 1e-6f;

constexpr size_t MiB = 1u << 20;
constexpr size_t WS_CTL = 0;
constexpr size_t WS_MODS = 64 * 1024;
constexpr size_t MODS_BYTES = 2 * 9 * 6144 * 4;
constexpr size_t WS_ROPE = 1 * MiB;
constexpr size_t WS_CX = 2 * MiB;
constexpr size_t WS_FML = 10 * MiB;
constexpr size_t WS_FMC = 26 * MiB;
constexpr size_t WS_WIN = 27 * MiB;
constexpr size_t WS_WBR = WS_WIN + (size_t)NZ * 1024 * 2;
constexpr size_t WS_WOUT = 42 * MiB;
constexpr size_t WS_H = 44 * MiB;
constexpr size_t WS_ACT4 = 44 * MiB;
constexpr size_t WS_ZQ = 89 * MiB;
constexpr size_t WS_ZS = 107 * MiB;
constexpr size_t WS_ZP = 134 * MiB;
constexpr size_t WS_KB = 143 * MiB;
constexpr size_t WS_VT = WS_KB + (size_t)NB * 2 * SKV * 64 * 2;
constexpr size_t WS_YTL = 152 * MiB;
constexpr size_t WS_YTC = 168 * MiB;
constexpr size_t WS_G8 = 170 * MiB;
constexpr size_t WS_PY = 134 * MiB;
constexpr size_t WS_Y = 89 * MiB;
constexpr size_t WS_ACT = 89 * MiB;
constexpr size_t WS_CXP = 190 * MiB;
constexpr size_t WS_WUP = 226 * MiB;
constexpr size_t WS_WDN = 237 * MiB;
constexpr size_t WS_RAW = 243 * MiB;
constexpr size_t WS_END = 256 * MiB;
static_assert(WS_WBR + 1024 * 1280 * 2 <= WS_WOUT && WS_VT + (size_t)NB * 2 * SKV * 64 * 2 <= WS_YTL, "ws map");
static_assert(WS_G8 + (size_t)MT * 4096 <= WS_WDN + 6 * MiB && WS_RAW + 288ull * 4 * UPW * 2 <= WS_END, "ws map");
static_assert(WS_ACT + (size_t)MT * DFF * 2 <= WS_WUP, "ws map");

constexpr int LDS_BYTES = 131072 + 4096;
#define REP_P2 1
#define REP_DFT 1
#define REP_ATTN 1
#define REP_SCP 1
#define REP_P4 1
#define REP_P7 1
#define REP_NORM 1

DI unsigned cvtpk(float lo, float hi) { f32x2_t v = {lo, hi}; bf16x2_t b = __builtin_convertvector(v, bf16x2_t); return __builtin_bit_cast(unsigned, b); }
DI float bflo(unsigned u) { return __uint_as_float(u << 16); }
DI float bfhi(unsigned u) { return __uint_as_float(u & 0xffff0000u); }
DI float wave_sum(float v) {
#pragma unroll
    for (int o = 1; o < 64; o <<= 1) v += __shfl_xor(v, o);
    return v;
}
DI int tid_() { int t; asm volatile("v_mov_b32 %0, %1" : "=v"(t) : "v"((int)threadIdx.x)); return t; }
DI float sigmoidf_(float v) { return __builtin_amdgcn_rcpf(1.0f + __builtin_amdgcn_exp2f(v * -1.4426950408889634f)); }

struct Params { const float* in[22]; float* out; unsigned char* ws; };
typedef const __attribute__((address_space(4))) Params* KP;
DI KP getp() { KP q = (KP)__builtin_amdgcn_kernarg_segment_ptr(); asm volatile("" : "+s"(q)); return q; }

namespace pg8 {
constexpr int BM = 256, BK = 64, HALF = 128, HTB = HALF * BK * 2, STAGE_BYTES = 8 * HTB, NXCD = 8, WGM = 8;
DI int lds_byte(int r, int c) { const int st = (r >> 4) * 2 + (c >> 5), rr = r & 15, cc = c & 31, ob = rr * 64 + cc * 2; return st * 1024 + (ob ^ (((ob >> 9) & 1) << 5)); }
DI void stage_rc(int b, int& R, int& C) { const int st = b / 1024, sb = b % 1024, swz = sb ^ (((sb >> 9) & 1) << 5); R = (st >> 1) * 16 + swz / 64; C = (st & 1) * 32 + (swz % 64) / 2; }
DI int perm32(int rho) { const int n = rho >> 4, i = rho & 15; return 8 * (i >> 2) + 4 * n + (i & 3); }

struct Unit { int pm, pn, koff, nt, tag; };
struct Gemm { const bf16_t* A; const bf16_t* Bt; int lda, ldb; };

struct Sched {
    int nM, nN, nwg, G, c, nx, xpm0, xpn, sub, nt, xs;
    DI void init(int nM_, int nN_, int G_, int c_, int nt_) { nM = nM_; nN = nN_; nwg = nM * nN; G = G_; c = c_; nx = 0; xpm0 = 0; xpn = 0; sub = 1; nt = nt_; xs = 0; }
    DI bool next(int i, Unit& u) const {
        int ti = i, s = 0;
        if (sub == 4) { ti = i >> 2; s = i & 3; }
        const long L = (long)ti * G + c;
        if (L < nwg) {
            int wgid = (int)L; { const int q = nwg / NXCD, r = nwg % NXCD, xcd = wgid % NXCD, off = wgid / NXCD; wgid = (xcd < r ? xcd * (q + 1) : r * (q + 1) + (xcd - r) * q) + off; }
            const int nig = WGM * nN, gid = wgid / nig, fm = gid * WGM, gsz = (nM - fm) < WGM ? (nM - fm) : WGM;
            u.pm = fm + ((wgid % nig) % gsz); u.pn = (wgid % nig) / gsz;
        } else if (L - nwg < nx) {
            const int j = (int)(L - nwg);
            if (xs == 3) { const int t = j / 24; u.pm = 64 + t; u.pn = j - 24 * t; u.tag = 0; u.koff = 0; u.nt = nt; return true; }
            if (xs == 4) { u.pm = 64 + j; u.pn = 24; u.tag = 0; u.koff = 0; u.nt = nt; return true; }
            if (xs > 0) {
                const int tile = j >> 2, ks = j & 3; u.pm = 64 + (tile >> 2); u.pn = tile & 3; u.tag = 1 + ks;
                if (xs == 1) { u.koff = ks * 256; u.nt = 4; } else { u.koff = (ks == 0 ? 0 : ks == 1 ? 12 : ks == 2 ? 24 : 34) * 64; u.nt = ks < 2 ? 12 : 10; }
                return true;
            }
            u.pm = xpm0 + j; u.pn = xpn;
        }
        else return false;
        if (sub == 4) { u.tag = s; u.koff = (s == 0) ? 0 : 256 + 256 * s; u.nt = (s == 0) ? 8 : 4; }
        else { u.tag = 0; u.koff = 0; u.nt = nt; }
        return true;
    }
};

typedef f32x4 Acc[2][2][4][2];
DI void zero_acc(Acc& acc) {
#pragma unroll
    for (int a = 0; a < 2; ++a)
#pragma unroll
        for (int b = 0; b < 2; ++b)
#pragma unroll
            for (int m = 0; m < 4; ++m)
#pragma unroll
                for (int n = 0; n < 2; ++n) acc[a][b][m][n] = (f32x4){0.f, 0.f, 0.f, 0.f};
}

template <class Epi, bool ALIGN_EPI>
DI void gemm_phase(LAS unsigned char* lds, const Gemm g, const Sched& S, const Epi& E) {
    int tid; asm volatile("v_mov_b32 %0, %1" : "=v"(tid) : "v"((int)threadIdx.x));
    const int wid = __builtin_amdgcn_readfirstlane(tid >> 6), lane = tid & 63, wr = wid >> 2, wc = wid & 3, fr = lane & 15, fq = lane >> 4;
    unsigned voffA[2], voffB[2];
#pragma unroll
    for (int i = 0; i < 2; ++i) { int R, C; stage_rc(tid * 16 + i * 8192, R, C); const int Rb = Epi::PERM ? ((R & ~31) + perm32(R & 31)) : R;
        voffA[i] = (unsigned)(R * g.lda + C) * 2u; voffB[i] = (unsigned)(Rb * g.ldb + C) * 2u; }
    const size_t kstep = (size_t)(BK * 2);
    const size_t hstepA = (size_t)HALF * g.lda * 2, hstepB = (size_t)HALF * g.ldb * 2;
    const size_t tstepA = 2 * hstepA, tstepB = 2 * hstepB;
    const unsigned ldsw = (unsigned)wid * 1024u;
    int aoff = lds_byte(wr * 64 + fr, fq * 8), boff = lds_byte(wc * 32 + fr, fq * 8);
#define PG8_SA(b, h) (((b) * 2 + (h)) * HTB)
#define PG8_SB(b, h) ((4 + (b) * 2 + (h)) * HTB)
#define PG8_STAGE(bufoff, gbase, voff) do { _Pragma("unroll") for (int _i = 0; _i < 2; ++_i) \
        __builtin_amdgcn_global_load_lds((const unsigned*)((const char*)(gbase) + (voff)[_i]), (LAS unsigned*)(lds + (bufoff) + ldsw + _i * 8192), 16, 0, 0); } while (0)
#define PG8_LDA(dst, b, h) do { _Pragma("unroll") for (int m = 0; m < 4; ++m) _Pragma("unroll") for (int k = 0; k < 2; ++k) dst[m][k] = *(const LAS bf16x8*)(lds + PG8_SA(b, h) + aoff + m * 2048 + k * 1024); } while (0)
#define PG8_LDB(dst, b, h) do { _Pragma("unroll") for (int n = 0; n < 2; ++n) _Pragma("unroll") for (int k = 0; k < 2; ++k) dst[n][k] = *(const LAS bf16x8*)(lds + PG8_SB(b, h) + boff + n * 2048 + k * 1024); } while (0)
#define PG8_MMA(ai, bj, At, Bt) do { __builtin_amdgcn_s_setprio(1); _Pragma("unroll") for (int m = 0; m < 4; ++m) _Pragma("unroll") for (int n = 0; n < 2; ++n) _Pragma("unroll") for (int k = 0; k < 2; ++k) \
        acc[ai][bj][m][n] = __builtin_amdgcn_mfma_f32_16x16x32_bf16(Bt[n][k], At[m][k], acc[ai][bj][m][n], 0, 0, 0); __builtin_amdgcn_s_setprio(0); } while (0)
#define PG8_WAIT_V(n) asm volatile("s_waitcnt vmcnt(" #n ")" ::: "memory")
#define PG8_WAIT_L(n) asm volatile("s_waitcnt lgkmcnt(" #n ")" ::: "memory")
#define PG8_BAR __builtin_amdgcn_s_barrier()
#define PG8_SCHED __builtin_amdgcn_sched_barrier(0)
    Unit cur, nxt; int ui = 0;
    if (!S.next(0, cur)) return;
    Acc acc;
    { int l2; asm volatile("v_mov_b32 %0, %1" : "=v"(l2) : "v"(lane)); E.init(acc, cur, wr, wc, l2 & 15, l2 >> 4); }
    PG8_WAIT_V(0);
    bf16x8 At[4][2], B0[2][2], B1[2][2];
    const char* cA = (const char*)g.A + (size_t)cur.pm * tstepA + (size_t)cur.koff * 2; const char* cB = (const char*)g.Bt + (size_t)cur.pn * tstepB + (size_t)cur.koff * 2;
    PG8_STAGE(PG8_SB(0, 0), cB, voffB); PG8_STAGE(PG8_SB(0, 1), cB + hstepB, voffB); PG8_STAGE(PG8_SA(0, 0), cA, voffA); PG8_STAGE(PG8_SA(0, 1), cA + hstepA, voffA);
    if (wr == 1) PG8_BAR;
    PG8_WAIT_V(2); PG8_BAR;
    PG8_STAGE(PG8_SB(1, 0), cB + kstep, voffB); PG8_STAGE(PG8_SA(1, 0), cA + kstep, voffA); PG8_STAGE(PG8_SB(1, 1), cB + hstepB + kstep, voffB);
    PG8_WAIT_V(6); PG8_BAR;
    for (;;) {
        {
            int t2; asm volatile("v_mov_b32 %0, %1" : "=v"(t2) : "v"(tid));
#pragma unroll
            for (int i = 0; i < 2; ++i) { int R, C; stage_rc(t2 * 16 + i * 8192, R, C); const int Rb = Epi::PERM ? ((R & ~31) + perm32(R & 31)) : R;
                voffA[i] = (unsigned)(R * g.lda + C) * 2u; voffB[i] = (unsigned)(Rb * g.ldb + C) * 2u; }
            const int l3 = t2 & 63;
            aoff = lds_byte(wr * 64 + (l3 & 15), (l3 >> 4) * 8); boff = lds_byte(wc * 32 + (l3 & 15), (l3 >> 4) * 8);
        }
        const bool has_next = S.next(ui + 1, nxt);
        const char* nA = has_next ? (const char*)g.A + (size_t)nxt.pm * tstepA + (size_t)nxt.koff * 2 : cA;
        const char* nB = has_next ? (const char*)g.Bt + (size_t)nxt.pn * tstepB + (size_t)nxt.koff * 2 : cB;
        const int nt = cur.nt;
        for (int t = 0; t < nt; t += 2) {
            const bool last = (t == nt - 2);
            const char* a1 = cA + (size_t)(t + 1) * kstep;
            const char* a2 = last ? nA : cA + (size_t)(t + 2) * kstep; const char* b2 = last ? nB : cB + (size_t)(t + 2) * kstep;
            const char* a3 = a2 + kstep; const char* b3 = b2 + kstep;
            PG8_LDB(B0, 0, 0); PG8_LDB(B1, 0, 1); PG8_SCHED; PG8_LDA(At, 0, 0); PG8_STAGE(PG8_SA(1, 1), a1 + hstepA, voffA);
            PG8_WAIT_V(8); PG8_WAIT_L(0); PG8_BAR; PG8_MMA(0, 0, At, B0); PG8_MMA(0, 1, At, B1); PG8_BAR; PG8_SCHED;
            PG8_LDA(At, 0, 1); PG8_STAGE(PG8_SB(0, 0), b2, voffB); PG8_STAGE(PG8_SB(0, 1), b2 + hstepB, voffB); PG8_STAGE(PG8_SA(0, 0), a2, voffA);
            PG8_WAIT_V(8); PG8_WAIT_L(0); PG8_BAR; PG8_MMA(1, 0, At, B0); PG8_MMA(1, 1, At, B1); PG8_BAR; PG8_SCHED;
            PG8_LDB(B0, 1, 0); PG8_LDB(B1, 1, 1); PG8_SCHED; PG8_LDA(At, 1, 0); PG8_STAGE(PG8_SA(0, 1), a2 + hstepA, voffA);
            PG8_WAIT_V(8); PG8_WAIT_L(0); PG8_BAR; PG8_MMA(0, 0, At, B0); PG8_MMA(0, 1, At, B1); PG8_BAR; PG8_SCHED;
            PG8_LDA(At, 1, 1); PG8_STAGE(PG8_SB(1, 0), b3, voffB); PG8_STAGE(PG8_SB(1, 1), b3 + hstepB, voffB); PG8_STAGE(PG8_SA(1, 0), a3, voffA);
            PG8_WAIT_V(8); PG8_WAIT_L(0); PG8_BAR; PG8_MMA(1, 0, At, B0); PG8_MMA(1, 1, At, B1); PG8_BAR; PG8_SCHED;
        }
        if constexpr (ALIGN_EPI) { if (wr == 0) PG8_BAR; }
        int l2; asm volatile("v_mov_b32 %0, %1" : "=v"(l2) : "v"(lane));
        E(acc, cur, wr, wc, l2 & 15, l2 >> 4);
        if (!has_next) break;
        E.init(acc, nxt, wr, wc, l2 & 15, l2 >> 4);
        cur = nxt; cA = nA; cB = nB; ++ui;
        if constexpr (ALIGN_EPI) { if (wr == 1) PG8_BAR; }
    }
    PG8_WAIT_V(0);
    if constexpr (!ALIGN_EPI) { if (wr == 0) PG8_BAR; }
    PG8_BAR;
#undef PG8_SA
#undef PG8_SB
#undef PG8_STAGE
#undef PG8_LDA
#undef PG8_LDB
#undef PG8_MMA
#undef PG8_WAIT_V
#undef PG8_WAIT_L
#undef PG8_BAR
#undef PG8_SCHED
}
}
using pg8::Acc; using pg8::Unit;

struct EpiZ {
    static constexpr bool PERM = false;
    bf16_t *ZQ, *ZS, *ZP, *KB, *VT, *YTL, *YTC; unsigned char* G8;
    const float *ropec, *ropes, *qg, *kg;
    DI void init(Acc& acc, const Unit&, int, int, int, int) const { pg8::zero_acc(acc); }
    DI void operator()(Acc& acc, const Unit& u, int wr, int wc, int fr, int fq) const {
        const bool isctx = u.pm >= 64;
        const int pn = u.pn;
        if (pn <= 2) {
            if (pn == 2 && wc >= 2) {
                const int g = wc - 2;
#pragma unroll
                for (int ai = 0; ai < 2; ++ai)
#pragma unroll
                    for (int m = 0; m < 4; ++m) {
                        const int r = u.pm * 256 + ai * 128 + wr * 64 + m * 16 + fr;
                        int b, pos; if (!isctx) { b = r >> 11; pos = r & 2047; } else { const int rc = r - ML; b = rc >> 8; pos = SEQ + (rc & 255); }
                        bf16_t* vb = VT + ((size_t)(b * 2 + g) * 64) * SKV + pos;
#pragma unroll
                        for (int bj = 0; bj < 2; ++bj)
#pragma unroll
                            for (int n = 0; n < 2; ++n) {
                                const f32x4 v = acc[ai][bj][m][n];
                                const unsigned p0 = cvtpk(v[0], v[1]), p1 = cvtpk(v[2], v[3]);
                                const int e = 32 * bj + 16 * n + 4 * fq;
                                vb[(size_t)(e + 0) * SKV] = (bf16_t)(p0 & 0xffff); vb[(size_t)(e + 1) * SKV] = (bf16_t)(p0 >> 16);
                                vb[(size_t)(e + 2) * SKV] = (bf16_t)(p1 & 0xffff); vb[(size_t)(e + 3) * SKV] = (bf16_t)(p1 >> 16);
                            }
                    }
                return;
            }
            const bool isq = pn < 2;
            const float* gain = isq ? qg : kg;
            const float osc = isq ? (0.125f * 1.4426950408889634f) : 1.0f;
#pragma unroll
            for (int ai = 0; ai < 2; ++ai)
#pragma unroll
                for (int m = 0; m < 4; ++m) {
                    const int r = u.pm * 256 + ai * 128 + wr * 64 + m * 16 + fr;
                    float ss = 0.f;
#pragma unroll
                    for (int bj = 0; bj < 2; ++bj)
#pragma unroll
                        for (int n = 0; n < 2; ++n) { const f32x4 v = acc[ai][bj][m][n]; ss += (v[0] * v[0] + v[1] * v[1]) + (v[2] * v[2] + v[3] * v[3]); }
                    ss += __shfl_xor(ss, 16); ss += __shfl_xor(ss, 32);
                    const float rinv = rsqrtf(ss * (1.0f / 64.0f) + EPS) * osc;
                    int b, pos, t = 0; if (!isctx) { b = r >> 11; pos = r & 2047; t = pos; } else { const int rc = r - ML; b = rc >> 8; pos = SEQ + (rc & 255); }
                    bf16_t* dst;
                    if (isq) dst = ZQ + (size_t)r * 512 + (pn * 4 + wc) * 64;
                    else dst = KB + ((size_t)(b * 2 + wc) * SKV + pos) * 64;
#pragma unroll
                    for (int bj = 0; bj < 2; ++bj) {
                        const f32x4 g0 = *(const f32x4*)(gain + 32 * bj + 4 * fq), g1 = *(const f32x4*)(gain + 32 * bj + 16 + 4 * fq);
                        f32x4 x0 = acc[ai][bj][m][0] * rinv * g0, x1 = acc[ai][bj][m][1] * rinv * g1;
                        if (!isctx) {
                            const f32x4 cs = *(const f32x4*)(ropec + (t * 2 + bj) * 16 + 4 * fq), sn = *(const f32x4*)(ropes + (t * 2 + bj) * 16 + 4 * fq);
                            const f32x4 o0 = x0 * cs - x1 * sn, o1 = x1 * cs + x0 * sn; x0 = o0; x1 = o1;
                        }
                        u32x2 w0, w1; w0.x = cvtpk(x0[0], x0[1]); w0.y = cvtpk(x0[2], x0[3]); w1.x = cvtpk(x1[0], x1[1]); w1.y = cvtpk(x1[2], x1[3]);
                        *(u32x2*)(dst + 32 * bj + 4 * fq) = w0; *(u32x2*)(dst + 32 * bj + 16 + 4 * fq) = w1;
                    }
                }
            return;
        }
#pragma unroll
        for (int ai = 0; ai < 2; ++ai)
#pragma unroll
            for (int m = 0; m < 4; ++m) {
                const int r = u.pm * 256 + ai * 128 + wr * 64 + m * 16 + fr;
                int b, t; if (!isctx) { b = r >> 11; t = r & 2047; } else { const int rc = r - ML; b = rc >> 8; t = rc & 255; }
#pragma unroll
                for (int bj = 0; bj < 2; ++bj)
#pragma unroll
                    for (int n = 0; n < 2; ++n) {
                        const f32x4 v = acc[ai][bj][m][n];
                        const int c = 128 * bj + 32 * wc + 16 * n + 4 * fq;
                        if (pn >= 9) {
                            unsigned w = 0;
#pragma unroll
                            for (int x = 0; x < 4; ++x) { const float s = sigmoidf_(v[x]); int q = (int)(s * 256.0f); q = q > 255 ? 255 : (q < 0 ? 0 : q); w |= (unsigned)q << (8 * x); }
                            *(unsigned*)(G8 + (size_t)r * 4096 + (pn - 9) * 256 + c) = w;
                        } else if (pn <= 5) {
                            u32x2 w; w.x = cvtpk(v[0], v[1]); w.y = cvtpk(v[2], v[3]);
                            *(u32x2*)(ZS + (size_t)r * 768 + (pn - 3) * 256 + c) = w;
                        } else if (pn == 8) {
                            u32x2 w; w.x = cvtpk(v[0], v[1]); w.y = cvtpk(v[2], v[3]);
                            *(u32x2*)(ZP + (size_t)r * 256 + c) = w;
                        } else {
                            const int cs = pn - 6;
                            const unsigned p0 = cvtpk(v[0], v[1]), p1 = cvtpk(v[2], v[3]);
                            bf16_t* y; size_t st;
                            if (!isctx) { y = YTL + ((size_t)(b * 256 + c) * 4096) + cs * 2048 + t; st = 4096; }
                            else { y = YTC + ((size_t)(b * 256 + c) * 512) + cs * 256 + t; st = 512; }
                            y[0] = (bf16_t)(p0 & 0xffff); y[st] = (bf16_t)(p0 >> 16); y[2 * st] = (bf16_t)(p1 & 0xffff); y[3 * st] = (bf16_t)(p1 >> 16);
                        }
                    }
            }
    }
};

struct EpiDft {
    static constexpr bool PERM = true;
    bf16_t* ACT4; int rowbase, nrows;
    DI void init(Acc& acc, const Unit&, int, int, int, int) const { pg8::zero_acc(acc); }
    DI void operator()(Acc& acc, const Unit& u, int wr, int wc, int fr, int fq) const {
#pragma unroll
        for (int ai = 0; ai < 2; ++ai)
#pragma unroll
            for (int m = 0; m < 4; ++m) {
                const int r = rowbase + u.pn * nrows + u.pm * 256 + ai * 128 + wr * 64 + m * 16 + fr;
#pragma unroll
                for (int bj = 0; bj < 2; ++bj) {
                    const f32x4 v0 = acc[ai][bj][m][0], v1 = acc[ai][bj][m][1];
                    u32x4 w; w.x = cvtpk(v0[0], v0[1]); w.y = cvtpk(v0[2], v0[3]); w.z = cvtpk(v1[0], v1[1]); w.w = cvtpk(v1[2], v1[3]);
                    *(u32x4*)(ACT4 + (size_t)r * 1280 + 768 + 128 * bj + 32 * wc + 8 * fq) = w;
                }
            }
    }
};

struct EpiBr {
    static constexpr bool PERM = true;
    const unsigned char* G8; bf16_t* Y; unsigned char* PY;
    DI void init(Acc& acc, const Unit&, int, int, int, int) const { pg8::zero_acc(acc); }
    DI void operator()(Acc& acc, const Unit& u, int wr, int wc, int fr, int fq) const {
        const unsigned char* ub = G8 + ((size_t)u.pm * 256 + wr * 64) * 4096 + u.tag * 1024 + u.pn * 256 + 32 * wc;
        const unsigned lo = (unsigned)(fr * 4096 + 8 * fq);
        unsigned char* pyb = PY + (size_t)((wr * 4 + wc) * 64 + fr + 16 * fq) * 16;
        bf16_t* yb = Y + ((size_t)u.pm * 256 + wr * 64) * 1024 + u.pn * 256 + 32 * wc;
        const unsigned yo = (unsigned)(fr * 1024 + 8 * fq);
#pragma unroll
        for (int ai = 0; ai < 2; ++ai) {
            u32x2 gw[4][2]; u32x4 pv[4][2];
#pragma unroll
            for (int m = 0; m < 4; ++m)
#pragma unroll
                for (int bj = 0; bj < 2; ++bj) {
                    gw[m][bj] = *(const u32x2*)(ub + ((ai * 128 + m * 16) * 4096 + bj * 128) + lo);
                    if (u.tag != 0) pv[m][bj] = *(const u32x4*)(pyb + (size_t)(((ai * 4 + m) * 2 + bj) * 512) * 16);
                }
#pragma unroll
            for (int m = 0; m < 4; ++m)
#pragma unroll
                for (int bj = 0; bj < 2; ++bj) {
                    f32x4 v[2];
#pragma unroll
                    for (int n = 0; n < 2; ++n) { const unsigned w = n ? gw[m][bj].y : gw[m][bj].x;
#pragma unroll
                        for (int x = 0; x < 4; ++x) { const float gq = ((float)((w >> (8 * x)) & 255u) + 0.5f) * (1.0f / 256.0f); v[n][x] = acc[ai][bj][m][n][x] * gq; } }
                    unsigned char* pp = pyb + (size_t)(((ai * 4 + m) * 2 + bj) * 512) * 16;
                    if (u.tag != 0) {
                        const u32x4 p4 = pv[m][bj];
                        v[0][0] += bflo(p4.x); v[0][1] += bfhi(p4.x); v[0][2] += bflo(p4.y); v[0][3] += bfhi(p4.y);
                        v[1][0] += bflo(p4.z); v[1][1] += bfhi(p4.z); v[1][2] += bflo(p4.w); v[1][3] += bfhi(p4.w);
                    }
                    u32x4 w; w.x = cvtpk(v[0][0], v[0][1]); w.y = cvtpk(v[0][2], v[0][3]); w.z = cvtpk(v[1][0], v[1][1]); w.w = cvtpk(v[1][2], v[1][3]);
                    if (u.tag != 3) *(u32x4*)pp = w;
                    else *(u32x4*)(yb + ((ai * 128 + m * 16) * 1024 + bj * 128) + yo) = w;
                }
        }
    }
};

struct EpiRes {
    static constexpr bool PERM = false;
    const float* srcL; float* dstL; const float* srcC; float* dstC; const float* gates; float* cxp;
    DI void init(Acc& acc, const Unit&, int, int, int, int) const { pg8::zero_acc(acc); }
    DI void operator()(Acc& acc, const Unit& u, int wr, int wc, int fr, int fq) const {
        const bool isctx = u.pm >= 64;
        const size_t rb = isctx ? ((size_t)(u.pm - 64) * 256 + wr * 64) : ((size_t)u.pm * 256 + wr * 64);
        const float* sb = (isctx ? srcC : srcL) + rb * D + u.pn * 256 + 32 * wc;
        float* db = (isctx ? dstC : dstL) + rb * D + u.pn * 256 + 32 * wc;
        const float* gb = gates + (size_t)(isctx ? 8 : (u.pm >> 3)) * 6144 + u.pn * 256 + 32 * wc;
        const unsigned lo = (unsigned)(fr * D + 4 * fq), go = (unsigned)(4 * fq);
        if (u.tag >= 2) {
            float* pb = cxp + (size_t)(u.tag - 2) * MC * D + rb * D + u.pn * 256 + 32 * wc;
#pragma unroll
            for (int ai = 0; ai < 2; ++ai)
#pragma unroll
                for (int m = 0; m < 4; ++m)
#pragma unroll
                    for (int bj = 0; bj < 2; ++bj)
#pragma unroll
                        for (int n = 0; n < 2; ++n) {
                            const int co = (ai * 128 + m * 16) * D + bj * 128 + n * 16;
                            const f32x4 gg = *(const f32x4*)(gb + (bj * 128 + n * 16) + go);
                            *(f32x4*)(pb + co + lo) = gg * acc[ai][bj][m][n];
                        }
            return;
        }
#pragma unroll
        for (int ai = 0; ai < 2; ++ai)
#pragma unroll
            for (int m = 0; m < 4; ++m) {
#pragma unroll
                for (int bj = 0; bj < 2; ++bj)
#pragma unroll
                    for (int n = 0; n < 2; ++n) {
                        const int co = (ai * 128 + m * 16) * D + bj * 128 + n * 16;
                        const f32x4 s = *(const f32x4*)(sb + co + lo), gg = *(const f32x4*)(gb + (bj * 128 + n * 16) + go);
                        *(f32x4*)(db + co + lo) = s + gg * acc[ai][bj][m][n];
                    }
                if (m == 3) asm volatile("" ::: "memory");
            }
    }
};

struct EpiUp {
    static constexpr bool PERM = true;
    bf16_t* ACT; bf16_t* RAW; const float* wconv;
    DI void init(Acc& acc, const Unit&, int, int, int, int) const { pg8::zero_acc(acc); }
    DI void operator()(Acc& acc, const Unit& u, int wr, int wc, int fr, int fq) const {
        const int lane = fr + 16 * fq;
        const int jl = 32 * wc + 8 * fq;
        const int ja = u.pn * 128 + jl;
        bf16_t* ab = ACT + ((size_t)u.pm * 256 + wr * 64) * DFF + u.pn * 128 + 32 * wc;
        const unsigned alo = (unsigned)(fr * DFF + 8 * fq);
#pragma unroll
        for (int ai = 0; ai < 2; ++ai) {
            const int rbase = u.pm * 256 + ai * 128 + wr * 64;
#pragma unroll
            for (int m = 0; m < 4; m += 3) {
                const bool dump = (m == 0) ? (fr < 2) : (fr >= 14);
                if (dump) {
                    const int slot = (m == 0) ? (2 + fr) : (fr - 14);
                    bf16_t* rw = RAW + ((size_t)(rbase >> 6) * 4 + slot) * UPW;
#pragma unroll
                    for (int bj = 0; bj < 2; ++bj) {
                        const f32x4 v0 = acc[ai][bj][m][0], v1 = acc[ai][bj][m][1];
                        u32x4 w; w.x = cvtpk(v0[0], v0[1]); w.y = cvtpk(v0[2], v0[3]); w.z = cvtpk(v1[0], v1[1]); w.w = cvtpk(v1[2], v1[3]);
                        *(u32x4*)(rw + bj * DFF + ja) = w;
                    }
                }
            }
#pragma unroll
            for (int n = 0; n < 2; ++n) {
                float act[4][4];
#pragma unroll
                for (int xp = 0; xp < 2; ++xp) {
#pragma unroll
                    for (int xx = 0; xx < 2; ++xx) {
                        const int x = 2 * xp + xx;
                        float ca[4], cb[4];
#pragma unroll
                        for (int bj = 0; bj < 2; ++bj) {
                            const float* wp = wconv + bj * DFF + ja + 4 * n + x;
                            const float w0 = wp[0], w1 = wp[UPW], w2 = wp[2 * UPW];
                            float R[4], L[4];
#pragma unroll
                            for (int m = 0; m < 4; ++m) { const int vi = __float_as_int(acc[ai][bj][m][n][x]);
                                R[m] = __int_as_float(__builtin_amdgcn_update_dpp(vi, vi, 0x121, 0xF, 0xF, false));
                                L[m] = __int_as_float(__builtin_amdgcn_update_dpp(vi, vi, 0x12F, 0xF, 0xF, false)); }
#pragma unroll
                            for (int m = 0; m < 4; ++m) {
                                const float up = (fr > 0) ? R[m] : (m > 0 ? R[m > 0 ? m - 1 : 0] : 0.f);
                                const float dn = (fr < 15) ? L[m] : (m < 3 ? L[m < 3 ? m + 1 : 3] : 0.f);
                                const float cv = w0 * up + w1 * acc[ai][bj][m][n][x] + w2 * dn;
                                if (bj == 0) ca[m] = cv; else cb[m] = cv;
                            }
                        }
#pragma unroll
                        for (int m = 0; m < 4; ++m) act[m][x] = ca[m] * sigmoidf_(ca[m]) * cb[m];
                    }
                    asm volatile("" ::: "memory");
                }
#pragma unroll
                for (int m = 0; m < 4; ++m) {
                    const bool skip = (m == 0 && fr == 0) || (m == 3 && fr == 15);
                    if (!skip) { u32x2 w; w.x = cvtpk(act[m][0], act[m][1]); w.y = cvtpk(act[m][2], act[m][3]);
                        *(u32x2*)(ab + ((ai * 128 + m * 16) * DFF + 4 * n) + alo) = w; }
                }
                asm volatile("" ::: "memory");
            }
        }
    }
};

DI void transpose_item(const float* W, int ldn, int k0, int n0, bf16_t* WT, int drow0, int ldd, int koff, LAS float* scr, int lane) {
#pragma unroll 8
    for (int i = 0; i < 32; ++i) { const int kk = 2 * i + (lane >> 5); scr[kk * 33 + (lane & 31)] = W[(size_t)(k0 + kk) * ldn + n0 + (lane & 31)]; }
    asm volatile("s_waitcnt lgkmcnt(0)" ::: "memory");
    const int c = lane & 7;
#pragma unroll
    for (int j = 0; j < 4; ++j) { const int n = (lane >> 3) + 8 * j; const LAS float* s = scr + (8 * c) * 33 + n;
        u32x4 o; o.x = cvtpk(s[0 * 33], s[1 * 33]); o.y = cvtpk(s[2 * 33], s[3 * 33]); o.z = cvtpk(s[4 * 33], s[5 * 33]); o.w = cvtpk(s[6 * 33], s[7 * 33]);
        *(u32x4*)(WT + (size_t)(drow0 + n) * ldd + koff + k0 + 8 * c) = o; }
    asm volatile("s_waitcnt lgkmcnt(0)" ::: "memory");
}
DI int win_dest(int n0) {
    if (n0 < 768) { const int tile = n0 >> 8, within = n0 & 255, hd = within >> 6, e = within & 63; return tile * 256 + 128 * (e >> 5) + 32 * hd + (e & 31); }
    if (n0 < 1536) return n0;
    if (n0 < 1792) return -1;
    return n0 + 256;
}
DI int wup_dest(int n0) { if (n0 < DFF) return 256 * (n0 >> 7) + (n0 & 127); const int j = n0 - DFF; return 256 * (j >> 7) + 128 + (j & 127); }

DI void conv_mixer(int l, LAS unsigned char* lds, int G) {
    KP q = getp(); unsigned char* ws = q->ws;
    const int tid = tid_(), lane = tid & 63, wave = tid >> 6;
    const int gw = blockIdx.x * 8 + wave, NGW = G * 8;
    LAS float* scr = (LAS float*)(lds + wave * 8448);
    bf16_t* WinT = (bf16_t*)(ws + WS_WIN); bf16_t* WbrT = (bf16_t*)(ws + WS_WBR); bf16_t* WoutT = (bf16_t*)(ws + WS_WOUT);
    const float* w_in = q->in[8] + (size_t)l * D * INW;
    constexpr int I_IN = 16 * 192, I_BA = 8 * 32, I_BS = 4 * 32, I_O = 16 * 32;
    constexpr int NIT = I_IN + I_BA + 2 * I_BS + I_O;
    for (int it = gw; it < NIT; it += NGW) {
        int r = it;
        if (r < I_IN) { const int kb = r / 192, nb = r % 192, n0 = nb * 32, d = win_dest(n0); if (d >= 0) transpose_item(w_in, INW, kb * 64, n0, WinT, d, 1024, 0, scr, lane); continue; } r -= I_IN;
        if (r < I_BA) { const int kb = r / 32, nb = r % 32; transpose_item(q->in[13] + (size_t)l * 512 * D, D, kb * 64, nb * 32, WbrT, nb * 32, 1280, 0, scr, lane); continue; } r -= I_BA;
        if (r < I_BS) { const int kb = r / 32, nb = r % 32; transpose_item(q->in[14] + (size_t)l * 256 * D, D, kb * 64, nb * 32, WbrT, nb * 32, 1280, 512, scr, lane); continue; } r -= I_BS;
        if (r < I_BS) { const int kb = r / 32, nb = r % 32; transpose_item(q->in[15] + (size_t)l * 256 * D, D, kb * 64, nb * 32, WbrT, nb * 32, 1280, 768, scr, lane); continue; } r -= I_BS;
        { const int kb = r / 32, nb = r % 32; transpose_item(q->in[17] + (size_t)l * D * D, D, kb * 64, nb * 32, WoutT, nb * 32, 1024, 0, scr, lane); }
    }
    __syncthreads();
    LAS float* tab = (LAS float*)(lds + 8 * 8448);
    if (tid < 64) { float s, c; sincospif((float)tid * (1.0f / 32.0f), &s, &c); tab[tid] = c; tab[64 + tid] = s; }
    __syncthreads();
    const int gt = blockIdx.x * 512 + tid, NGT = G * 512;
    for (int e = gt; e < 512 * 1024; e += NGT) {
        const int k = e & 1023, nrow = e >> 10, cs = nrow >> 8, g = (nrow >> 6) & 3, k2 = nrow & 63;
        const float* src = w_in + (size_t)k * INW + 1536 + g * 64;
        const LAS float* tb = tab + cs * 64;
        float a = 0.f;
#pragma unroll 4
        for (int c4 = 0; c4 < 16; ++c4) { const f32x4 v = *(const f32x4*)(src + 4 * c4);
#pragma unroll
            for (int x = 0; x < 4; ++x) a += v[x] * tb[(k2 * (4 * c4 + x)) & 63]; }
        WinT[(size_t)(1536 + nrow) * 1024 + k] = (bf16_t)(cvtpk(a * 0.125f, 0.f) & 0xffff);
    }
    const float* pm = q->in[11] + (size_t)l * 4 * 64 * 64; const float* psc = q->in[12] + (size_t)l * 256; const float* wp = q->in[16] + (size_t)l * 256 * D;
    for (int e = gt; e < 256 * 1024; e += NGT) {
        const int n = e & 1023, gc = e >> 10, g = gc >> 6;
        float a = 0.f;
#pragma unroll 8
        for (int d = 0; d < 64; ++d) a += pm[(size_t)gc * 64 + d] * psc[g * 64 + d] * wp[(size_t)(g * 64 + d) * D + n];
        WbrT[(size_t)n * 1280 + 1024 + gc] = (bf16_t)(cvtpk(a, 0.f) & 0xffff);
    }
    __syncthreads();
}

DI void conv_ffn(int l, LAS unsigned char* lds, int G) {
    KP q = getp(); unsigned char* ws = q->ws;
    const int tid = tid_(), lane = tid & 63, wave = tid >> 6;
    const int gw = blockIdx.x * 8 + wave, NGW = G * 8;
    LAS float* scr = (LAS float*)(lds + wave * 8448);
    bf16_t* WupT = (bf16_t*)(ws + WS_WUP); bf16_t* WdnT = (bf16_t*)(ws + WS_WDN);
    constexpr int I_U = 16 * 176, I_D = 44 * 32;
    for (int it = gw; it < I_U + I_D; it += NGW) {
        int r = it;
        if (r < I_U) { const int kb = r / 176, nb = r % 176, n0 = nb * 32; transpose_item(q->in[18] + (size_t)l * D * UPW, UPW, kb * 64, n0, WupT, wup_dest(n0), 1024, 0, scr, lane); continue; } r -= I_U;
        { const int kb = r / 32, nb = r % 32; transpose_item(q->in[20] + (size_t)l * DFF * D, D, kb * 64, nb * 32, WdnT, nb * 32, DFF, 0, scr, lane); }
    }
}

template <int NR>
DI void norm_rowsN(const float* x, const float* gain, const float* md, int si, bf16_t* o, int lane, const float* part, float* wb) {
    f32x4 v[NR][4];
#pragma unroll
    for (int i = 0; i < NR; ++i)
#pragma unroll
        for (int j = 0; j < 4; ++j) v[i][j] = ((const f32x4*)(x + (size_t)i * D))[lane + 64 * j];
    if (part) {
#pragma unroll
        for (int pi = 0; pi < 3; ++pi)
#pragma unroll
            for (int i = 0; i < NR; ++i)
#pragma unroll
                for (int j = 0; j < 4; ++j) v[i][j] += ((const f32x4*)(part + (size_t)pi * MC * D + (size_t)i * D))[lane + 64 * j];
#pragma unroll
        for (int i = 0; i < NR; ++i)
#pragma unroll
            for (int j = 0; j < 4; ++j) ((f32x4*)(wb + (size_t)i * D))[lane + 64 * j] = v[i][j];
    }
    float rs[NR];
#pragma unroll
    for (int i = 0; i < NR; ++i) { float t = 0.f;
#pragma unroll
        for (int j = 0; j < 4; ++j) t += (v[i][j][0] * v[i][j][0] + v[i][j][1] * v[i][j][1]) + (v[i][j][2] * v[i][j][2] + v[i][j][3] * v[i][j][3]);
        rs[i] = rsqrtf(wave_sum(t) * (1.0f / D) + EPS); }
#pragma unroll
    for (int j = 0; j < 4; ++j) {
        const int c = 256 * j + 4 * lane;
        const f32x4 g = *(const f32x4*)(gain + c), sh = *(const f32x4*)(md + si * 1024 + c), sc = *(const f32x4*)(md + (si + 1) * 1024 + c);
#pragma unroll
        for (int i = 0; i < NR; ++i) {
            const f32x4 h = ((v[i][j] * rs[i]) * g) * (1.0f + sc) + sh;
            u32x2 w; w.x = cvtpk(h[0], h[1]); w.y = cvtpk(h[2], h[3]);
            *(u32x2*)(o + (size_t)i * D + c) = w;
        }
    }
}
DI void norm_phase(const float* srcL, const float* srcC, bool do_ctx, const float* gain, const float* mods, int si, bf16_t* H, int G, const float* cxp, float* cxw) {
    const int tid = tid_(), lane = tid & 63, wave = tid >> 6;
    const int gw = blockIdx.x * 8 + wave, NGW = G * 8;
    const int nrows = do_ctx ? MT : ML;
    for (int r = 4 * gw; r < nrows; r += 4 * NGW) {
        const float *x0, *md0;
        if (r < ML) { x0 = srcL + (size_t)r * D; md0 = mods + (size_t)(r >> 11) * 6144; }
        else { x0 = srcC + (size_t)(r - ML) * D; md0 = mods + (size_t)8 * 6144; }
        const bool pc = (r >= ML) && cxp;
        norm_rowsN<4>(x0, gain, md0, si, H + (size_t)r * D, lane, pc ? cxp + (size_t)(r - ML) * D : nullptr, pc ? cxw + (size_t)(r - ML) * D : nullptr);
    }
}

DI void attn_qk(f32x16& p0, f32x16& p1, const LAS unsigned char* kl, const bf16x8 (&qf)[4], int r32, int h) {
    constexpr int PITCH = 144;
#pragma unroll
    for (int i = 0; i < 16; ++i) { p0[i] = 0.f; p1[i] = 0.f; }
#pragma unroll
    for (int s = 0; s < 4; ++s) {
        const bf16x8 ka = *(const LAS bf16x8*)(kl + r32 * PITCH + (16 * s + 8 * h) * 2);
        const bf16x8 kb2 = *(const LAS bf16x8*)(kl + (32 + r32) * PITCH + (16 * s + 8 * h) * 2);
        p0 = __builtin_amdgcn_mfma_f32_32x32x16_bf16(ka, qf[s], p0, 0, 0, 0);
        p1 = __builtin_amdgcn_mfma_f32_32x32x16_bf16(kb2, qf[s], p1, 0, 0, 0);
    }
}
#define ATTN_ITER(FAST, t, PC0, PC1, PN0, PN1, KW, VW, KL, VL) do { \
        const int cur = (t) & 1; \
        if ((t) + 3 < nkt) KL = *(const u32x4*)(kbase + ((size_t)((t) + 3) * 64 + srow) * 64 + sch * 8); \
        if ((t) + 2 < nkt) VL = *(const u32x4*)(vbase + (size_t)srow * SKV + ((t) + 2) * 64 + sch * 8); \
        if ((t) + 1 < nkt) attn_qk(PN0, PN1, lds + (cur ^ 1) * TB, qf, r32, h); \
        if (FAST) {                                           \
            f32x2_t rs = {0.f, 0.f}; \
            _Pragma("unroll") for (int i = 0; i < 16; i += 2) { \
                f32x2_t a0, a1; \
                a0.x = __builtin_amdgcn_exp2f(PC0[i]); a0.y = __builtin_amdgcn_exp2f(PC0[i + 1]); a1.x = __builtin_amdgcn_exp2f(PC1[i]); a1.y = __builtin_amdgcn_exp2f(PC1[i + 1]); \
                PC0[i] = a0.x; PC0[i + 1] = a0.y; PC1[i] = a1.x; PC1[i + 1] = a1.y; rs += a0 + a1; } \
            l_run += rs.x + rs.y; \
        } else { \
        float mx0 = fmaxf(PC0[0], PC1[0]), mx1 = fmaxf(PC0[1], PC1[1]); \
        _Pragma("unroll") for (int i = 2; i < 16; i += 2) { mx0 = fmaxf(mx0, fmaxf(PC0[i], PC1[i])); mx1 = fmaxf(mx1, fmaxf(PC0[i + 1], PC1[i + 1])); } \
        float mx = fmaxf(mx0, mx1); \
        mx = fmaxf(mx, __shfl_xor(mx, 32)); \
        const float m_new = fmaxf(m_run, mx); \
        const float alpha = __builtin_amdgcn_exp2f(m_run - m_new); \
        m_run = m_new; \
        const f32x2_t mm = {m_new, m_new}; \
        f32x2_t rs = {0.f, 0.f}; \
        _Pragma("unroll") for (int i = 0; i < 16; i += 2) { \
            f32x2_t a0 = (f32x2_t){PC0[i], PC0[i + 1]} - mm, a1 = (f32x2_t){PC1[i], PC1[i + 1]} - mm; \
            a0.x = __builtin_amdgcn_exp2f(a0.x); a0.y = __builtin_amdgcn_exp2f(a0.y); a1.x = __builtin_amdgcn_exp2f(a1.x); a1.y = __builtin_amdgcn_exp2f(a1.y); \
            PC0[i] = a0.x; PC0[i + 1] = a0.y; PC1[i] = a1.x; PC1[i + 1] = a1.y; rs += a0 + a1; } \
        l_run = l_run * alpha + (rs.x + rs.y); \
        _Pragma("unroll") for (int i = 0; i < 16; ++i) { o0[i] *= alpha; o1[i] *= alpha; } \
        } \
        const LAS unsigned char* vl = lds + 2 * TB + cur * TB; \
        _Pragma("unroll") for (int kb = 0; kb < 2; ++kb) \
        _Pragma("unroll") for (int s2 = 0; s2 < 2; ++s2) { \
                u32x4 pw; \
                if (kb == 0) { pw.x = cvtpk(PC0[8 * s2 + 0], PC0[8 * s2 + 1]); pw.y = cvtpk(PC0[8 * s2 + 2], PC0[8 * s2 + 3]); pw.z = cvtpk(PC0[8 * s2 + 4], PC0[8 * s2 + 5]); pw.w = cvtpk(PC0[8 * s2 + 6], PC0[8 * s2 + 7]); } \
                else { pw.x = cvtpk(PC1[8 * s2 + 0], PC1[8 * s2 + 1]); pw.y = cvtpk(PC1[8 * s2 + 2], PC1[8 * s2 + 3]); pw.z = cvtpk(PC1[8 * s2 + 4], PC1[8 * s2 + 5]); pw.w = cvtpk(PC1[8 * s2 + 6], PC1[8 * s2 + 7]); } \
                const bf16x8 pb = __builtin_bit_cast(bf16x8, pw); \
                const int kk = 32 * kb + 16 * s2 + 4 * h; \
                { const u32x2 lo = *(const LAS u32x2*)(vl + r32 * PITCH + kk * 2), hi = *(const LAS u32x2*)(vl + r32 * PITCH + (kk + 8) * 2); \
                  u32x4 vw; vw.x = lo.x; vw.y = lo.y; vw.z = hi.x; vw.w = hi.y; \
                  o0 = __builtin_amdgcn_mfma_f32_32x32x16_bf16(__builtin_bit_cast(bf16x8, vw), pb, o0, 0, 0, 0); } \
                { const u32x2 lo = *(const LAS u32x2*)(vl + (32 + r32) * PITCH + kk * 2), hi = *(const LAS u32x2*)(vl + (32 + r32) * PITCH + (kk + 8) * 2); \
                  u32x4 vw; vw.x = lo.x; vw.y = lo.y; vw.z = hi.x; vw.w = hi.y; \
                  o1 = __builtin_amdgcn_mfma_f32_32x32x16_bf16(__builtin_bit_cast(bf16x8, vw), pb, o1, 0, 0, 0); } \
            } \
        if ((t) + 2 < nkt) *(LAS u32x4*)(lds + cur * TB + soff) = KW;                   \
        if ((t) + 1 < nkt) *(LAS u32x4*)(lds + 2 * TB + (cur ^ 1) * TB + soff) = VW;    \
        __syncthreads(); \
    } while (0)

DI void attn_unit(LAS unsigned char* lds, const bf16_t* ZQ, const bf16_t* KB, const bf16_t* VT, bf16_t* ACT4, int b, int g, int qrow0, int key0, int nkt, bool fast) {
    const int tid = tid_(), wave = tid >> 6, lane = tid & 63, r32 = lane & 31, h = lane >> 5;
    const int head = g * 4 + (wave >> 1);
    const int qrow = qrow0 + (wave & 1) * 32 + r32;
    constexpr int PITCH = 144, TB = 64 * PITCH;
    bf16x8 qf[4];
#pragma unroll
    for (int s = 0; s < 4; ++s) qf[s] = *(const bf16x8*)(ZQ + (size_t)qrow * 512 + head * 64 + 16 * s + 8 * h);
    f32x16 o0, o1;
#pragma unroll
    for (int i = 0; i < 16; ++i) { o0[i] = 0.f; o1[i] = 0.f; }
    float m_run = -1e30f, l_run = 0.f;
    const bf16_t* kbase = KB + ((size_t)(b * 2 + g) * SKV + key0) * 64;
    const bf16_t* vbase = VT + ((size_t)(b * 2 + g) * 64) * SKV + key0;
    const int srow = tid >> 3, sch = tid & 7;
    const unsigned soff = (unsigned)(srow * PITCH + sch * 16);
    u32x4 kA = *(const u32x4*)(kbase + (size_t)srow * 64 + sch * 8);
    u32x4 vA = *(const u32x4*)(vbase + (size_t)srow * SKV + sch * 8);
    u32x4 kB = *(const u32x4*)(kbase + ((size_t)64 + srow) * 64 + sch * 8);
    u32x4 vB;
    __syncthreads();
    *(LAS u32x4*)(lds + soff) = kA;
    *(LAS u32x4*)(lds + 2 * TB + soff) = vA;
    *(LAS u32x4*)(lds + TB + soff) = kB;
    if (nkt > 2) kA = *(const u32x4*)(kbase + ((size_t)128 + srow) * 64 + sch * 8);
    vA = *(const u32x4*)(vbase + (size_t)srow * SKV + 64 + sch * 8);
    vB = vA; kB = kA;
    __syncthreads();
    f32x16 pa0, pa1, pb0, pb1;
    attn_qk(pa0, pa1, lds, qf, r32, h);
#pragma unroll
    for (int i = 0; i < 16; ++i) { pb0[i] = 0.f; pb1[i] = 0.f; }
    if (fast) {
#pragma nounroll
        for (int t = 0; t < nkt; t += 2) {
            ATTN_ITER(true, t, pa0, pa1, pb0, pb1, kA, vA, kB, vB);
            ATTN_ITER(true, t + 1, pb0, pb1, pa0, pa1, kB, vB, kA, vA);
        }
    } else {
#pragma nounroll
        for (int t = 0; t < nkt; t += 2) {
            ATTN_ITER(false, t, pa0, pa1, pb0, pb1, kA, vA, kB, vB);
            ATTN_ITER(false, t + 1, pb0, pb1, pa0, pa1, kB, vB, kA, vA);
        }
    }
    const float lt = l_run + __shfl_xor(l_run, 32);
    const float inv = __builtin_amdgcn_rcpf(lt);
    bf16_t* orow = ACT4 + (size_t)qrow * 1280 + head * 64;
#pragma unroll
    for (int g4 = 0; g4 < 4; ++g4) {
        u32x2 w; w.x = cvtpk(o0[4 * g4] * inv, o0[4 * g4 + 1] * inv); w.y = cvtpk(o0[4 * g4 + 2] * inv, o0[4 * g4 + 3] * inv);
        *(u32x2*)(orow + 8 * g4 + 4 * h) = w;
        u32x2 w2; w2.x = cvtpk(o1[4 * g4] * inv, o1[4 * g4 + 1] * inv); w2.y = cvtpk(o1[4 * g4 + 2] * inv, o1[4 * g4 + 3] * inv);
        *(u32x2*)(orow + 32 + 8 * g4 + 4 * h) = w2;
    }
}

DI void bf8_to_f(const u32x4 v, float (&f)[8]) { f[0] = bflo(v.x); f[1] = bfhi(v.x); f[2] = bflo(v.y); f[3] = bfhi(v.y); f[4] = bflo(v.z); f[5] = bfhi(v.z); f[6] = bflo(v.w); f[7] = bfhi(v.w); }
DI void scpool_phase(const bf16_t* ZS, const bf16_t* ZP, bf16_t* ACT4, const float* convw, int nrows, int G) {
    const int tid = tid_(), lane = tid & 63, wave = tid >> 6;
    const int gw = blockIdx.x * 8 + wave, NGW = G * 8;
    for (int r = 2 * gw; r < nrows; r += 2 * NGW) {
        int t, N; if (r < ML) { t = r & 2047; N = SEQ; } else { t = (r - ML) & 255; N = CTXL; }
        if (lane < 32) {
            const int c = lane * 8;
            u32x4 gcv[4], xsv[4];
#pragma unroll
            for (int i = 0; i < 4; ++i) {
                int dt = i - 1; const bool ok = (t + dt >= 0) && (t + dt < N); if (!ok) dt = 0;
                const bf16_t* row = ZS + (size_t)(r + dt) * 768;
                gcv[i] = *(const u32x4*)(row + 256 + c); xsv[i] = *(const u32x4*)(row + 512 + c);
            }
            const u32x4 gb0 = *(const u32x4*)(ZS + (size_t)r * 768 + c), gb1 = *(const u32x4*)(ZS + (size_t)(r + 1) * 768 + c);
            float w[3][8];
#pragma unroll
            for (int k = 0; k < 3; ++k) { const f32x4 a = *(const f32x4*)(convw + k * 256 + c), b2 = *(const f32x4*)(convw + k * 256 + c + 4);
#pragma unroll
                for (int x = 0; x < 4; ++x) { w[k][x] = a[x]; w[k][4 + x] = b2[x]; } }
            float pr[4][8];
#pragma unroll
            for (int i = 0; i < 4; ++i) { float g8[8], x8[8]; bf8_to_f(gcv[i], g8); bf8_to_f(xsv[i], x8); const bool ok = (t + i - 1 >= 0) && (t + i - 1 < N);
#pragma unroll
                for (int j = 0; j < 8; ++j) pr[i][j] = ok ? g8[j] * x8[j] : 0.f; }
            float b0[8], b1[8]; bf8_to_f(gb0, b0); bf8_to_f(gb1, b1);
            float o0[8], o1[8];
#pragma unroll
            for (int j = 0; j < 8; ++j) { o0[j] = b0[j] * (w[0][j] * pr[0][j] + w[1][j] * pr[1][j] + w[2][j] * pr[2][j]); o1[j] = b1[j] * (w[0][j] * pr[1][j] + w[1][j] * pr[2][j] + w[2][j] * pr[3][j]); }
            u32x4 w0; w0.x = cvtpk(o0[0], o0[1]); w0.y = cvtpk(o0[2], o0[3]); w0.z = cvtpk(o0[4], o0[5]); w0.w = cvtpk(o0[6], o0[7]);
            u32x4 w1; w1.x = cvtpk(o1[0], o1[1]); w1.y = cvtpk(o1[2], o1[3]); w1.z = cvtpk(o1[4], o1[5]); w1.w = cvtpk(o1[6], o1[7]);
            *(u32x4*)(ACT4 + (size_t)r * 1280 + 512 + c) = w0; *(u32x4*)(ACT4 + (size_t)(r + 1) * 1280 + 512 + c) = w1;
        } else {
            const int c = (lane - 32) * 8, gi = c >> 6, wdw = 2 << gi, left = (wdw - 1) >> 1, right = wdw >> 1;
            u32x4 pv[17];
#pragma unroll
            for (int i = 0; i < 17; ++i) { int tt = t - left + i; tt = tt < 0 ? 0 : (tt > N - 1 ? N - 1 : tt); pv[i] = *(const u32x4*)(ZP + (size_t)(r - t + tt) * 256 + c); }
            const u32x4 x0v = *(const u32x4*)(ZP + (size_t)r * 256 + c), x1v = *(const u32x4*)(ZP + (size_t)(r + 1) * 256 + c);
            float a0[8], a1[8];
#pragma unroll
            for (int j = 0; j < 8; ++j) { a0[j] = 0.f; a1[j] = 0.f; }
#pragma unroll
            for (int i = 0; i < 17; ++i) {
                const int tt = t - left + i; const bool ok = (tt >= 0) && (tt < N);
                float f[8]; bf8_to_f(pv[i], f);
                const bool in0 = ok && (i < wdw), in1 = ok && (i >= 1) && (i <= wdw);
#pragma unroll
                for (int j = 0; j < 8; ++j) { a0[j] += in0 ? f[j] : 0.f; a1[j] += in1 ? f[j] : 0.f; }
            }
            const int lo0 = (t - left) > 0 ? (t - left) : 0, hi0 = (t + right + 1) < N ? (t + right + 1) : N;
            const int lo1 = (t + 1 - left) > 0 ? (t + 1 - left) : 0, hi1 = (t + right + 2) < N ? (t + right + 2) : N;
            const float ic0 = __builtin_amdgcn_rcpf((float)(hi0 - lo0)), ic1 = __builtin_amdgcn_rcpf((float)(hi1 - lo1));
            float x0[8], x1[8]; bf8_to_f(x0v, x0); bf8_to_f(x1v, x1);
            u32x4 w0; w0.x = cvtpk(a0[0] * ic0 - x0[0], a0[1] * ic0 - x0[1]); w0.y = cvtpk(a0[2] * ic0 - x0[2], a0[3] * ic0 - x0[3]); w0.z = cvtpk(a0[4] * ic0 - x0[4], a0[5] * ic0 - x0[5]); w0.w = cvtpk(a0[6] * ic0 - x0[6], a0[7] * ic0 - x0[7]);
            u32x4 w1; w1.x = cvtpk(a1[0] * ic1 - x1[0], a1[1] * ic1 - x1[1]); w1.y = cvtpk(a1[2] * ic1 - x1[2], a1[3] * ic1 - x1[3]); w1.z = cvtpk(a1[4] * ic1 - x1[4], a1[5] * ic1 - x1[5]); w1.w = cvtpk(a1[6] * ic1 - x1[6], a1[7] * ic1 - x1[7]);
            *(u32x4*)(ACT4 + (size_t)r * 1280 + 1024 + c) = w0; *(u32x4*)(ACT4 + (size_t)(r + 1) * 1280 + 1024 + c) = w1;
        }
    }
}

DI void fixup_phase(const bf16_t* RAW, bf16_t* ACT, const float* wconv, int nchunks, int G) {
    const int tid = tid_();
    for (int it = blockIdx.x; it < nchunks * 2; it += G) {
        const int ch = it >> 1, which = it & 1;
        const int r = ch * 64 + (which ? 63 : 0);
        int t, N; if (r < ML) { t = r & 2047; N = SEQ; } else { t = (r - ML) & 255; N = CTXL; }
        const bf16_t *up, *mid, *dn;
        if (!which) { up = (t > 0) ? RAW + ((size_t)(ch - 1) * 4 + 1) * UPW : nullptr; mid = RAW + ((size_t)ch * 4 + 2) * UPW; dn = RAW + ((size_t)ch * 4 + 3) * UPW; }
        else { up = RAW + ((size_t)ch * 4 + 0) * UPW; mid = RAW + ((size_t)ch * 4 + 1) * UPW; dn = (t < N - 1) ? RAW + ((size_t)(ch + 1) * 4 + 2) * UPW : nullptr; }
        for (int j = tid; j < DFF; j += 512) {
            const float ua = up ? bflo(up[j]) : 0.f, ub = up ? bflo(up[DFF + j]) : 0.f;
            const float ma = bflo(mid[j]), mb = bflo(mid[DFF + j]);
            const float da = dn ? bflo(dn[j]) : 0.f, db = dn ? bflo(dn[DFF + j]) : 0.f;
            const float ca = wconv[j] * ua + wconv[UPW + j] * ma + wconv[2 * UPW + j] * da;
            const float cb = wconv[DFF + j] * ub + wconv[UPW + DFF + j] * mb + wconv[2 * UPW + DFF + j] * db;
            ACT[(size_t)r * DFF + j] = (bf16_t)(cvtpk(ca * sigmoidf_(ca) * cb, 0.f) & 0xffff);
        }
    }
}

#define XB_TMO      128
#define XB_XCNT(j)  (256  + 64 * (j))
#define XB_XSUB(j)  (1280 + 64 * (j))
#define XB_XGEN(j)  (2304 + 64 * (j))
#define XB_TOP      3328
#define XB_TOPGEN   3392
#define XCD_BAR_WORDS 3456
#define XB_SPIN_CAP (1u << 22)
DI unsigned xb_ld(unsigned* p)              { return __hip_atomic_load(p, __ATOMIC_RELAXED, __HIP_MEMORY_SCOPE_AGENT); }
DI unsigned xb_add(unsigned* p, unsigned v) { return __hip_atomic_fetch_add(p, v, __ATOMIC_RELAXED, __HIP_MEMORY_SCOPE_AGENT); }
DI unsigned xb_xcc_id() { return (unsigned)__builtin_amdgcn_s_getreg((3 << 11) | 20) & 0xFu; }
#define XB_SPIN(cond, bar) do { unsigned _sp = 0; while (cond) { __builtin_amdgcn_s_sleep(1); \
    if ((++_sp & 255u) == 0u) { if (xb_ld(&(bar)[XB_TMO])) break; if (_sp > XB_SPIN_CAP) { atomicAdd(&(bar)[XB_TMO], 1u); break; } } } } while (0)
DI void xcd_barrier_complete(unsigned* bar, unsigned x, unsigned& nloc, unsigned& nx) {
    const unsigned G = gridDim.x * gridDim.y * gridDim.z;
    unsigned sum, cnt, mine, sp = 0u;
    for (;;) {
        sum = 0u; cnt = 0u; mine = 0u;
#pragma unroll
        for (unsigned j = 0; j < 16; ++j) { const unsigned c = xb_ld(&bar[XB_XCNT(j)]); sum += c; cnt += (c > 0u) ? 1u : 0u; mine = (j == x) ? c : mine; }
        if (sum == G) break;
        __builtin_amdgcn_s_sleep(1);
        if ((++sp & 255u) == 0u) { if (xb_ld(&bar[XB_TMO])) break; if (sp > XB_SPIN_CAP) { atomicAdd(&bar[XB_TMO], 1u); break; } }
    }
    nloc = mine > 0u ? mine : 1u; nx = cnt > 0u ? cnt : 1u;
}
DI void xb_post(unsigned* bar) { if (threadIdx.x == 0) (void)xb_add(&bar[XB_XCNT(xb_xcc_id())], 1u); }
DI void xcd_barrier(unsigned* bar, volatile LAS unsigned* st) {
    asm volatile("s_waitcnt vmcnt(0)" ::: "memory");
    __syncthreads();
    if (threadIdx.x == 0) {
        const unsigned x = xb_xcc_id();
        __builtin_amdgcn_s_waitcnt(0);
        unsigned nloc = st[0], nx = st[1];
        if (nloc == 0u) { xcd_barrier_complete(bar, x, nloc, nx); st[0] = nloc; st[1] = nx; }
        const unsigned old = xb_add(&bar[XB_XSUB(x)], 1u);
        const unsigned gen = old / nloc;
        if (old + 1u == (gen + 1u) * nloc) {
            __builtin_amdgcn_fence(__ATOMIC_RELEASE, "agent");
            asm volatile("s_waitcnt vmcnt(0)" ::: "memory");
            const unsigned og = xb_add(&bar[XB_TOP], 1u);
            const unsigned tg = og / nx;
            if (og + 1u == (tg + 1u) * nx) xb_add(&bar[XB_TOPGEN], 1u);
            else XB_SPIN(xb_ld(&bar[XB_TOPGEN]) == tg, bar);
            __builtin_amdgcn_fence(__ATOMIC_ACQUIRE, "agent");
            xb_add(&bar[XB_XGEN(x)], 1u);
            asm volatile("s_waitcnt vmcnt(0)" ::: "memory");
        } else {
            XB_SPIN(xb_ld(&bar[XB_XGEN(x)]) == gen, bar);
            __builtin_amdgcn_fence(__ATOMIC_ACQUIRE, "agent");
            asm volatile("s_waitcnt vmcnt(0)" ::: "memory");
        }
    }
    __syncthreads();
}

DI void ph0(LAS unsigned char* lds) {
    KP q = getp(); unsigned char* ws = q->ws;
    const int tid = tid_(), G = gridDim.x, cu = blockIdx.x, gt = cu * 512 + tid, NGT = G * 512;
    float* MODS = (float*)(ws + WS_MODS);
    float* ROPEC = (float*)(ws + WS_ROPE); float* ROPES = ROPEC + 2048 * 32;
    bf16_t* FML = (bf16_t*)(ws + WS_FML); bf16_t* FMC = (bf16_t*)(ws + WS_FMC);
    LAS float* sm = (LAS float*)lds;
    const float* cvec = q->in[1]; const float* cctx = q->in[3]; const float* w_mod = q->in[4]; const float* b_mod = q->in[5];
    for (int it = cu; it < 192; it += G) {
        const int l = it / 96, rem = it % 96, kc = rem / 12, cb = rem % 12;
        __syncthreads();
        for (int e = tid; e < 9 * 128; e += 512) { const int v = e >> 7, k = kc * 128 + (e & 127); const float cv = (v < 8) ? cvec[v * D + k] : cctx[k]; sm[e] = cv * sigmoidf_(cv); }
        __syncthreads();
        const int j = cb * 512 + tid;
        float a[9];
#pragma unroll
        for (int v = 0; v < 9; ++v) a[v] = 0.f;
        const float* wp = w_mod + ((size_t)l * D + kc * 128) * INW + j;
#pragma unroll 4
        for (int k = 0; k < 128; ++k) { const float w = wp[(size_t)k * INW];
#pragma unroll
            for (int v = 0; v < 9; ++v) a[v] += sm[v * 128 + k] * w; }
        const float bm = (kc == 0) ? b_mod[l * INW + j] : 0.f;
#pragma unroll
        for (int v = 0; v < 9; ++v) atomicAdd(&MODS[(size_t)(l * 9 + v) * INW + j], a[v] + bm);
    }
    for (int e = gt; e < 2048 * 32; e += NGT) {
        const int t = e >> 5, ax = (e >> 4) & 1, i = e & 15;
        const float pos = (float)(ax ? (t & 63) : (t >> 6));
        const float inv = powf(10000.0f, -(float)i * (1.0f / 16.0f));
        float sn, cs; sincosf(pos * inv, &sn, &cs);
        ROPEC[e] = cs; ROPES[e] = sn;
    }
    for (int e = gt; e < 2048 * 512; e += NGT) {
        const int k1 = e >> 9, c8 = e & 511, part = c8 >> 8, n0 = (c8 & 255) * 8;
        float v[8];
#pragma unroll
        for (int j = 0; j < 8; ++j) { const int mm = (k1 * (n0 + j)) & 2047; float sn, cs; sincospif((float)mm * (1.0f / 1024.0f), &sn, &cs); v[j] = (part ? -sn : cs) * 0.022097086912079608f; }
        u32x4 w; w.x = cvtpk(v[0], v[1]); w.y = cvtpk(v[2], v[3]); w.z = cvtpk(v[4], v[5]); w.w = cvtpk(v[6], v[7]);
        *(u32x4*)(FML + (size_t)k1 * 4096 + part * 2048 + n0) = w;
    }
    for (int e = gt; e < 256 * 64; e += NGT) {
        const int k1 = e >> 6, c8 = e & 63, part = c8 >> 5, n0 = (c8 & 31) * 8;
        float v[8];
#pragma unroll
        for (int j = 0; j < 8; ++j) { const int mm = (k1 * (n0 + j)) & 255; float sn, cs; sincospif((float)mm * (1.0f / 128.0f), &sn, &cs); v[j] = (part ? -sn : cs) * 0.0625f; }
        u32x4 w; w.x = cvtpk(v[0], v[1]); w.y = cvtpk(v[2], v[3]); w.z = cvtpk(v[4], v[5]); w.w = cvtpk(v[6], v[7]);
        *(u32x4*)(FMC + (size_t)k1 * 512 + part * 256 + n0) = w;
    }
}
DI void ph_norm(int l, int which, bool do_ctx) {
    KP q = getp(); unsigned char* ws = q->ws;
    const float* MODS = (const float*)(ws + WS_MODS);
    const float* srcL = (l == 0 && which == 0) ? q->in[0] : (const float*)q->out;
    const float* srcC = (l == 0 && which == 0) ? q->in[2] : (const float*)(ws + WS_CX);
    const bool parts = !(l == 0 && which == 0);
    norm_phase(srcL, srcC, do_ctx, q->in[which ? 7 : 6] + l * D, MODS + (size_t)l * 9 * INW, which ? 3 : 0, (bf16_t*)(ws + WS_H), gridDim.x, parts ? (const float*)(ws + WS_CXP) : nullptr, (float*)(ws + WS_CX));
}
DI void ph2(int l, LAS unsigned char* lds, bool tail) {
    KP q = getp(); unsigned char* ws = q->ws;
    const int G = gridDim.x, cu = blockIdx.x;
    pg8::Gemm g{(const bf16_t*)(ws + WS_H), (const bf16_t*)(ws + WS_WIN), 1024, 1024};
    pg8::Sched S;
    if (tail) { S.init(0, 25, G, (cu + G - 192) % G, 16); S.xs = 4; S.nx = 8; }
    else if (l == 0) { S.init(64, 25, G, cu, 16); S.xs = 3; S.nx = 192; }
    else { S.init(64, 25, G, cu, 16); S.nx = 8; S.xpm0 = 64; S.xpn = 2; }
    float* ROPEC = (float*)(ws + WS_ROPE);
    EpiZ E{(bf16_t*)(ws + WS_ZQ), (bf16_t*)(ws + WS_ZS), (bf16_t*)(ws + WS_ZP), (bf16_t*)(ws + WS_KB), (bf16_t*)(ws + WS_VT), (bf16_t*)(ws + WS_YTL), (bf16_t*)(ws + WS_YTC), ws + WS_G8,
           ROPEC, ROPEC + 2048 * 32, q->in[10] + l * 128, q->in[10] + l * 128 + 64};
    pg8::gemm_phase<EpiZ, true>(lds, g, S, E);
}
DI void ph3_dft(int l, LAS unsigned char* lds) {
    KP q = getp(); unsigned char* ws = q->ws;
    const int G = gridDim.x, cu = blockIdx.x;
    const int nsub = (l == 0) ? 2 : 1;
#pragma nounroll
    for (int j = 0; j < nsub; ++j) {
        pg8::Gemm g; pg8::Sched S; EpiDft E;
        if (j == 0) { g = pg8::Gemm{(const bf16_t*)(ws + WS_FML), (const bf16_t*)(ws + WS_YTL), 4096, 4096}; S.init(8, 8, G, cu, 64); E = EpiDft{(bf16_t*)(ws + WS_ACT4), 0, SEQ}; }
        else { g = pg8::Gemm{(const bf16_t*)(ws + WS_FMC), (const bf16_t*)(ws + WS_YTC), 512, 512}; S.init(1, 8, G, (cu + G - 64) % G, 8); E = EpiDft{(bf16_t*)(ws + WS_ACT4), ML, CTXL}; }
        pg8::gemm_phase<EpiDft, true>(lds, g, S, E);
    }
}
DI void ph3_attn(int l, LAS unsigned char* lds) {
    KP q = getp(); unsigned char* ws = q->ws;
    const int G = gridDim.x, cu = blockIdx.x;
    const bf16_t* ZQ = (const bf16_t*)(ws + WS_ZQ); const bf16_t* KB = (const bf16_t*)(ws + WS_KB); const bf16_t* VT = (const bf16_t*)(ws + WS_VT); bf16_t* ACT4 = (bf16_t*)(ws + WS_ACT4);
    bool fast;
    {
        const int ln = tid_() & 63;
        float gq = fabsf(q->in[10][l * 128 + ln]), gk = fabsf(q->in[10][l * 128 + 64 + ln]);
#pragma unroll
        for (int o = 1; o < 64; o <<= 1) { gq = fmaxf(gq, __shfl_xor(gq, o)); gk = fmaxf(gk, __shfl_xor(gk, o)); }
        const float bound = 11.5416f * gq * gk;
        fast = __builtin_amdgcn_readfirstlane(bound <= 60.0f ? 1 : 0) != 0;
    }
    if (G == 256) {
        if (cu >= 64) {
            const int x = cu & 7, idx = (cu - 64) >> 3;
#pragma nounroll
            for (int u = idx; u < 64; u += 24) { const int a = (2 * x + (u >> 5)) * 32 + (u & 31); attn_unit(lds, ZQ, KB, VT, ACT4, a >> 6, (a >> 5) & 1, (a >> 6) * SEQ + (a & 31) * 64, 0, 36, fast); }
        }
    } else {
#pragma nounroll
        for (int a = cu; a < 512; a += G) attn_unit(lds, ZQ, KB, VT, ACT4, a >> 6, (a >> 5) & 1, (a >> 6) * SEQ + (a & 31) * 64, 0, 36, fast);
    }
    if (l == 0) {
#pragma nounroll
        for (int a = (cu + 64) % G; a < 64; a += G) attn_unit(lds, ZQ, KB, VT, ACT4, a >> 3, (a >> 2) & 1, ML + (a >> 3) * CTXL + (a & 3) * 64, SEQ, 4, fast);
    }
}
DI void ph3_scpool(int l) {
    KP q = getp(); unsigned char* ws = q->ws;
    scpool_phase((const bf16_t*)(ws + WS_ZS), (const bf16_t*)(ws + WS_ZP), (bf16_t*)(ws + WS_ACT4), q->in[9] + l * 768, l == 0 ? MT : ML, gridDim.x);
}
DI void ph4(int l, LAS unsigned char* lds) {
    KP q = getp(); unsigned char* ws = q->ws;
    const int G = gridDim.x, cu = blockIdx.x;
    pg8::Gemm g{(const bf16_t*)(ws + WS_ACT4), (const bf16_t*)(ws + WS_WBR), 1280, 1280};
    pg8::Sched S; S.init(l == 0 ? 72 : 64, 4, G, cu, 8); S.sub = 4;
    EpiBr E{ws + WS_G8, (bf16_t*)(ws + WS_Y), ws + WS_PY + (size_t)cu * 131072};
    pg8::gemm_phase<EpiBr, true>(lds, g, S, E);
}
DI void ph_res(int l, int which, LAS unsigned char* lds) {
    KP q = getp(); unsigned char* ws = q->ws;
    const int G = gridDim.x, cu = blockIdx.x;
    const float* mods = (const float*)(ws + WS_MODS) + (size_t)l * 9 * INW;
    float* OUT = q->out; float* CX = (float*)(ws + WS_CX);
    pg8::Gemm g; pg8::Sched S; EpiRes E;
    if (which == 0) {
        g = pg8::Gemm{(const bf16_t*)(ws + WS_Y), (const bf16_t*)(ws + WS_WOUT), 1024, 1024}; S.init(64, 4, G, cu, 16);
        if (l == 0) { S.xs = 1; S.nx = 128; }
        E = EpiRes{(l == 0) ? q->in[0] : (const float*)OUT, OUT, (l == 0) ? q->in[2] : (const float*)CX, CX, mods + 2 * 1024, (float*)(ws + WS_CXP)};
    } else {
        g = pg8::Gemm{(const bf16_t*)(ws + WS_ACT), (const bf16_t*)(ws + WS_WDN), DFF, DFF}; S.init(64, 4, G, cu, 44);
        if (l == 0) { S.xs = 2; S.nx = 128; }
        E = EpiRes{OUT, OUT, CX, CX, mods + 5 * 1024, (float*)(ws + WS_CXP)};
    }
    pg8::gemm_phase<EpiRes, true>(lds, g, S, E);
}
DI void ph7(int l, LAS unsigned char* lds) {
    KP q = getp(); unsigned char* ws = q->ws;
    const int G = gridDim.x, cu = blockIdx.x;
    pg8::Gemm g{(const bf16_t*)(ws + WS_H), (const bf16_t*)(ws + WS_WUP), 1024, 1024};
    pg8::Sched S; S.init(l == 0 ? 72 : 64, 22, G, cu, 16);
    EpiUp E{(bf16_t*)(ws + WS_ACT), (bf16_t*)(ws + WS_RAW), q->in[19] + (size_t)l * 3 * UPW};
    pg8::gemm_phase<EpiUp, true>(lds, g, S, E);
}
DI void ph7b(int l) {
    KP q = getp(); unsigned char* ws = q->ws;
    fixup_phase((const bf16_t*)(ws + WS_RAW), (bf16_t*)(ws + WS_ACT), q->in[19] + (size_t)l * 3 * UPW, l == 0 ? 288 : 256, gridDim.x);
}
DI void ph_final() {
    KP q = getp();
    const int tid = tid_(), lane = tid & 63, gw = blockIdx.x * 8 + (tid >> 6), NGW = gridDim.x * 8;
    const float* fg = q->in[21]; float* OUT = q->out;
    for (int r = 4 * gw; r < ML; r += 4 * NGW) {
        f32x4 v[4][4];
#pragma unroll
        for (int i = 0; i < 4; ++i)
#pragma unroll
            for (int j = 0; j < 4; ++j) v[i][j] = ((const f32x4*)(OUT + (size_t)(r + i) * D))[lane + 64 * j];
        float rs[4];
#pragma unroll
        for (int i = 0; i < 4; ++i) { float t = 0.f;
#pragma unroll
            for (int j = 0; j < 4; ++j) t += (v[i][j][0] * v[i][j][0] + v[i][j][1] * v[i][j][1]) + (v[i][j][2] * v[i][j][2] + v[i][j][3] * v[i][j][3]);
            rs[i] = rsqrtf(wave_sum(t) * (1.0f / D) + EPS); }
#pragma unroll
        for (int j = 0; j < 4; ++j) { const f32x4 gg = *(const f32x4*)(fg + 256 * j + 4 * lane);
#pragma unroll
            for (int i = 0; i < 4; ++i) ((f32x4*)(OUT + (size_t)(r + i) * D))[lane + 64 * j] = (v[i][j] * rs[i]) * gg; }
    }
}

__global__ void __launch_bounds__(512, 2) mega(Params p) {
    extern __shared__ __attribute__((aligned(16))) unsigned char lds_raw[];
    LAS unsigned char* lds = (LAS unsigned char*)lds_raw;
    cg::grid_group grid = cg::this_grid();
    volatile LAS unsigned* xst = (volatile LAS unsigned*)(lds + 131072 + 64);
    if (threadIdx.x < 2) xst[threadIdx.x] = 0u;
    __syncthreads();
    { KP q = getp(); xb_post((unsigned*)(q->ws + WS_CTL)); }
#define GBAR() do { KP q_ = getp(); xcd_barrier((unsigned*)(q_->ws + WS_CTL), xst); } while (0)
    ph0(lds);
    conv_mixer(0, lds, gridDim.x);
    grid.sync();
    ph_norm(0, 0, true);
    GBAR();
#pragma nounroll
    for (int l = 0; l < 2; ++l) {
        for (int rep = 0; rep < REP_P2; ++rep) ph2(l, lds, false);
        GBAR();
        for (int rep = 0; rep < REP_DFT; ++rep) ph3_dft(l, lds);
        for (int rep = 0; rep < REP_ATTN; ++rep) ph3_attn(l, lds);
        if (l == 0) ph2(0, lds, true);
        for (int rep = 0; rep < REP_SCP; ++rep) ph3_scpool(l);
        GBAR();
        for (int rep = 0; rep < REP_P4; ++rep) ph4(l, lds);
        GBAR();
        ph_res(l, 0, lds);
        GBAR();
        for (int rep = 0; rep < REP_NORM; ++rep) ph_norm(l, 1, l == 0);
        conv_ffn(l, lds, gridDim.x);
        if (l == 0) conv_mixer(1, lds, gridDim.x);
        GBAR();
        for (int rep = 0; rep < REP_P7; ++rep) ph7(l, lds);
        GBAR();
        ph7b(l);
        GBAR();
        ph_res(l, 1, lds);
        GBAR();
        if (l == 0) { ph_norm(1, 0, true); GBAR(); }
        else ph_final();
    }
#undef GBAR
}

extern "C" void kernel_launch(void* const* d_in, const int* in_sizes, int n_in, void* d_out, int out_size, void* d_ws, size_t ws_size, hipStream_t stream) {
    static int grid_blocks = 0;
    if (grid_blocks == 0) {
        if (n_in != 22 || ws_size < WS_END) { fprintf(stderr, "kernel_launch: unexpected inputs (n_in %d, ws %zu)\n", n_in, ws_size); grid_blocks = -1; return; }
        int dev = 0, cus = 0, per_cu = 0;
        (void)hipGetDevice(&dev);
        (void)hipDeviceGetAttribute(&cus, hipDeviceAttributeMultiprocessorCount, dev);
        if (hipFuncSetAttribute((const void*)mega, hipFuncAttributeMaxDynamicSharedMemorySize, LDS_BYTES) != hipSuccess) { fprintf(stderr, "kernel_launch: hipFuncSetAttribute failed\n"); }
        if (hipOccupancyMaxActiveBlocksPerMultiprocessor(&per_cu, (const void*)mega, 512, LDS_BYTES) != hipSuccess || per_cu < 1) { fprintf(stderr, "kernel_launch: occupancy query gave %d\n", per_cu); per_cu = 1; }
        (void)hipGetLastError();
        grid_blocks = cus * 1;
        fprintf(stderr, "kernel_launch: cus %d per_cu %d grid %d ws %zu\n", cus, per_cu, grid_blocks, ws_size);
    }
    if (grid_blocks < 0) return;
    (void)hipMemsetAsync((char*)d_ws + WS_CTL, 0, WS_MODS + MODS_BYTES, stream);
    Params p{};
    for (int i = 0; i < 22; ++i) p.in[i] = (const float*)d_in[i];
    p.out = (float*)d_out; p.ws = (unsigned char*)d_ws;
    void* args[] = {&p};
    hipError_t e = hipLaunchCooperativeKernel((void*)mega, dim3(grid_blocks), dim3(512), args, LDS_BYTES, stream);
    if (e != hipSuccess) fprintf(stderr, "cooperative launch failed: %s (grid %d)\n", hipGetErrorString(e), grid_blocks);
}
```
